# Optimizing an MI355X kernel written in HIP

```python
import math
import jax
import jax.numpy as jnp
from jax import lax
import numpy as np

D_MODEL = 1024
BATCH = 16
SEQ = 4096
DEPTH = 2

CTX_LEN = 256
GRID_W = 64

SWA_HEADS = 4
SWA_KV_HEADS = 2
SWA_HEAD_DIM = 64
SWA_WINDOW = 128
SWA_BLOCK = 128
DN_HEADS = 4
DN_HEAD_DIM = 64
DN_CONV = 5
DN_CHUNK = 64
RET_HEADS = 4
RET_QK_DIM = 32
RET_V_DIM = 64
RET_CHUNK = 64
MLA_HEADS = 4
MLA_Q_RANK = 256
MLA_KV_RANK = 128
MLA_NOPE_DIM = 64
MLA_ROPE_DIM = 32
MLA_V_DIM = 64
MLA_BLOCK = 128

D_FF = 4 * D_MODEL
ROPE_BASE = 10000.0
NORM_EPS = 1e-6
LN_EPS = 1e-5
DEEPNORM_ALPHA = (2 * DEPTH) ** 0.25
DEEPNORM_BETA = (8 * DEPTH) ** -0.25

SWA_Q = SWA_HEADS * SWA_HEAD_DIM
SWA_KV = SWA_KV_HEADS * SWA_HEAD_DIM
DN_W = DN_HEADS * DN_HEAD_DIM
RET_QK = RET_HEADS * RET_QK_DIM
RET_V = RET_HEADS * RET_V_DIM
MLA_OUT = MLA_HEADS * MLA_V_DIM
MIX_WIDTH = SWA_Q + DN_W + RET_V + MLA_OUT
IN_SPLITS = (SWA_Q, SWA_KV, SWA_KV, 3 * DN_W, DN_W, 4 * DN_HEADS, RET_QK, RET_QK, RET_V, RET_V,
             MLA_Q_RANK, MLA_KV_RANK, MLA_ROPE_DIM)
IN_WIDTH = sum(IN_SPLITS)

kernel_name = 'hybrid_parallel_group_dit_block'

F32 = jnp.float32


def layer_norm(x, g, b):
    xf = x.astype(F32)
    mu = jnp.mean(xf, axis=-1, keepdims=True)
    var = jnp.mean(jnp.square(xf - mu), axis=-1, keepdims=True)
    return ((xf - mu) * lax.rsqrt(var + LN_EPS) * g.astype(F32) + b.astype(F32)).astype(x.dtype)


def rms_norm(x, g):
    xf = x.astype(F32)
    return (xf * lax.rsqrt(jnp.mean(xf * xf, axis=-1, keepdims=True) + NORM_EPS) * g.astype(F32)).astype(x.dtype)


def head_layer_norm(o, g):
    b_, t_, h_, d_ = o.shape
    mu = jnp.mean(o, axis=-1, keepdims=True)
    var = jnp.mean(jnp.square(o - mu), axis=-1, keepdims=True)
    return ((o - mu) * lax.rsqrt(var + NORM_EPS)).reshape(b_, t_, h_ * d_) * g.astype(F32)


def l2norm(t):
    return t * lax.rsqrt(jnp.sum(t * t, axis=-1, keepdims=True) + NORM_EPS)


def rope_freqs(dim):
    return ROPE_BASE ** (-jnp.arange(0, dim, 2, dtype=F32) / dim)


def axial_rope(rows, rot_dim):
    row = jnp.broadcast_to(jnp.arange(rows, dtype=F32)[:, None], (rows, GRID_W)).reshape(-1)
    col = jnp.broadcast_to(jnp.arange(GRID_W, dtype=F32)[None, :], (rows, GRID_W)).reshape(-1)
    inv = rope_freqs(rot_dim // 2)
    ang = jnp.concatenate([row[:, None] * inv, col[:, None] * inv], axis=-1)
    return jnp.cos(ang), jnp.sin(ang)


def sequence_rope(n_tok, rot_dim):
    ang = jnp.arange(n_tok, dtype=F32)[:, None] * rope_freqs(rot_dim)
    return jnp.cos(ang), jnp.sin(ang)


def apply_rope(x, cos, sin):
    xf = x.astype(F32)
    x1, x2 = jnp.split(xf, 2, axis=-1)
    c = cos[:, None, :]
    s = sin[:, None, :]
    return jnp.concatenate([x1 * c - x2 * s, x1 * s + x2 * c], axis=-1).astype(x.dtype)


def _flip_t(t):
    return jnp.flip(t, axis=2)


def _split_columns(z):
    idx = np.cumsum(np.array(IN_SPLITS))[:-1].tolist()
    return jnp.split(z, idx, axis=-1)


def short_conv(x, w):
    k_width, ch = w.shape
    pad = k_width // 2
    return lax.conv_general_dilated(x, w[:, None, :].astype(x.dtype), window_strides=(1,),
                                    padding=[(pad, pad)], dimension_numbers=('NWC', 'WIO', 'NWC'),
                                    feature_group_count=ch)


def swa_group(q, k, v, qc, kc, vc, sink, cos, sin, with_ctx_out):
    b_, s_, _ = q.shape
    l_ = kc.shape[1]
    grp = SWA_HEADS // SWA_KV_HEADS
    w_ = SWA_BLOCK
    nb = s_ // w_
    d = SWA_HEAD_DIM
    scale = d ** -0.5
    q = apply_rope(q.reshape(b_, s_, SWA_HEADS, d), cos, sin).reshape(b_, nb, w_, SWA_KV_HEADS, grp, d)
    k = apply_rope(k.reshape(b_, s_, SWA_KV_HEADS, d), cos, sin)
    v = v.reshape(b_, s_, SWA_KV_HEADS, d)
    kc = kc.reshape(b_, l_, SWA_KV_HEADS, d)
    vc = vc.reshape(b_, l_, SWA_KV_HEADS, d)

    def band(t):
        tp = jnp.pad(t, ((0, 0), (w_, w_), (0, 0), (0, 0))).reshape(b_, nb + 2, w_, SWA_KV_HEADS, d)
        return jnp.concatenate([tp[:, :-2], tp[:, 1:-1], tp[:, 2:]], axis=2)

    kb, vb = band(k), band(v)
    qpos = jnp.arange(s_).reshape(nb, w_)
    kpos = (jnp.arange(nb) * w_ - w_)[:, None] + jnp.arange(3 * w_)[None, :]
    rel = kpos[:, None, :] - qpos[:, :, None]
    valid = (jnp.abs(rel) <= SWA_WINDOW) & (kpos >= 0)[:, None, :] & (kpos < s_)[:, None, :]
    sink_hg = sink.astype(F32).reshape(SWA_KV_HEADS, grp)
    s_loc = jnp.where(valid, jnp.einsum('bnqhgd,bnkhd->bhgnqk', q, kb).astype(F32) * scale, -jnp.inf)
    s_ctx = jnp.einsum('bnqhgd,bkhd->bhgnqk', q, kc).astype(F32) * scale
    s_sink = jnp.broadcast_to(sink_hg[None, :, :, None, None, None], s_ctx.shape[:-1] + (1,))
    p = jax.nn.softmax(jnp.concatenate([s_loc, s_ctx, s_sink], axis=-1), axis=-1).astype(v.dtype)
    y = (jnp.einsum('bhgnqk,bnkhd->bnqhgd', p[..., :3 * w_], vb)
         + jnp.einsum('bhgnqk,bkhd->bnqhgd', p[..., 3 * w_:3 * w_ + l_], vc)).reshape(b_, s_, SWA_Q)
    yc = None
    if with_ctx_out:
        qcg = qc.reshape(b_, l_, SWA_KV_HEADS, grp, d)
        sc = jnp.einsum('bqhgd,bkhd->bhgqk', qcg, kc).astype(F32) * scale
        ss = jnp.broadcast_to(sink_hg[None, :, :, None, None], sc.shape[:-1] + (1,))
        pc = jax.nn.softmax(jnp.concatenate([sc, ss], axis=-1), axis=-1).astype(vc.dtype)
        yc = jnp.einsum('bhgqk,bkhd->bqhgd', pc[..., :l_], vc).reshape(b_, l_, SWA_Q)
    return y, yc


def _delta_update(s, w_i, u_i, kt_i, gl_i):
    v_new = u_i - jnp.einsum('bhcd,bhde->bhce', w_i, s)
    s_new = s * jnp.exp(gl_i)[..., None, None] + jnp.einsum('bhcd,bhce->bhde', kt_i, v_new)
    return s_new, v_new


def gated_delta_chunked(q, k, v, log_g, beta, state0):
    b_, h_, t_, dk = k.shape
    dv = v.shape[-1]
    c_ = DN_CHUNK
    n = t_ // c_
    k = k.reshape(b_, h_, n, c_, dk)
    v = v.reshape(b_, h_, n, c_, dv)
    g_cum = jnp.cumsum(log_g.reshape(b_, h_, n, c_), axis=-1)
    beta = beta.reshape(b_, h_, n, c_, 1)
    incl = jnp.tril(jnp.ones((c_, c_), bool))
    strict = jnp.tril(jnp.ones((c_, c_), bool), -1)
    decay = jnp.exp(jnp.where(incl, g_cum[..., :, None] - g_cum[..., None, :], -jnp.inf))
    kb = k * beta
    a_mat = jnp.where(strict, jnp.einsum('bhncd,bhnsd->bhncs', kb, k) * decay, 0.0)
    lhs = a_mat + jnp.eye(c_, dtype=a_mat.dtype)
    rhs = jnp.concatenate([kb * jnp.exp(g_cum)[..., None], v * beta], axis=-1)
    wu = lax.linalg.triangular_solve(lhs, rhs, left_side=True, lower=True)
    w, u = wu[..., :dk], wu[..., dk:]
    g_last = g_cum[..., -1]
    k_tail = k * jnp.exp(g_last[..., None] - g_cum)[..., None]
    chunks = lambda t: jnp.moveaxis(t, 2, 0)
    if q is None:
        def step_state(s, inp):
            s_new, _ = _delta_update(s, *inp)
            return s_new, None
        s_last, _ = lax.scan(step_state, state0, (chunks(w), chunks(u), chunks(k_tail), chunks(g_last)))
        return None, s_last
    q = q.reshape(b_, h_, n, c_, dk)
    qk = jnp.einsum('bhncd,bhnsd->bhncs', q, k) * decay
    q_dec = q * jnp.exp(g_cum)[..., None]

    def step(s, inp):
        w_i, u_i, kt_i, gl_i, qd_i, qk_i = inp
        s_new, v_new = _delta_update(s, w_i, u_i, kt_i, gl_i)
        o_i = jnp.einsum('bhcd,bhde->bhce', qd_i, s) + jnp.einsum('bhcs,bhse->bhce', qk_i, v_new)
        return s_new, o_i

    s_last, o = lax.scan(step, state0, (chunks(w), chunks(u), chunks(k_tail), chunks(g_last),
                                        chunks(q_dec), chunks(qk)))
    return jnp.moveaxis(o, 0, 2).reshape(b_, h_, t_, dv), s_last


def deltanet_group(qkv, z, ab, qkv_c, z_c, ab_c, conv_w, a_log, dt_bias, norm_g, with_ctx_out):
    def prep(qkv_, ab_):
        b_, t_, _ = qkv_.shape
        y = jax.nn.silu(short_conv(qkv_, conv_w)).astype(F32)
        q, k, v = [t.reshape(b_, t_, DN_HEADS, DN_HEAD_DIM).transpose(0, 2, 1, 3) for t in jnp.split(y, 3, axis=-1)]
        q = l2norm(q) * DN_HEAD_DIM ** -0.5
        k = l2norm(k)
        ab_ = ab_.astype(F32).reshape(b_, t_, 2, 2, DN_HEADS)
        log_g = -jnp.exp(a_log.astype(F32)) * jax.nn.softplus(ab_[:, :, :, 0] + dt_bias.astype(F32))
        beta = jax.nn.sigmoid(ab_[:, :, :, 1])
        return q, k, v, log_g.transpose(2, 0, 3, 1), beta.transpose(2, 0, 3, 1)

    def out(o, z_):
        b_, t_, _ = z_.shape
        o = rms_norm(o.transpose(0, 2, 1, 3), norm_g) * jax.nn.silu(z_.astype(F32)).reshape(b_, t_, DN_HEADS, DN_HEAD_DIM)
        return o.reshape(b_, t_, DN_W).astype(z_.dtype)

    qc, kc, vc, lgc, bc = prep(qkv_c, ab_c)
    q, k, v, lg, bt = prep(qkv, ab)
    zero = jnp.zeros((qkv.shape[0], DN_HEADS, DN_HEAD_DIM, DN_HEAD_DIM), F32)
    oc_f, s_f = gated_delta_chunked(qc if with_ctx_out else None, kc, vc, lgc[0], bc[0], zero)
    oc_b, s_b = gated_delta_chunked(_flip_t(qc) if with_ctx_out else None, _flip_t(kc), _flip_t(vc),
                                    _flip_t(lgc[1]), _flip_t(bc[1]), zero)
    o_f, _ = gated_delta_chunked(q, k, v, lg[0], bt[0], s_f)
    o_b, _ = gated_delta_chunked(_flip_t(q), _flip_t(k), _flip_t(v), _flip_t(lg[1]), _flip_t(bt[1]), s_b)
    y = out(o_f + _flip_t(o_b), z)
    yc = out(oc_f + _flip_t(oc_b), z_c) if with_ctx_out else None
    return y, yc


def retention_scan(k, v, log_gamma, state0, emit_starts):
    b_, h_, t_, dk = k.shape
    c_ = RET_CHUNK
    n = t_ // c_
    pos = jnp.arange(c_, dtype=F32)
    zeta = jnp.exp((c_ - 1 - pos)[None, :] * log_gamma[:, None])
    kv = jnp.einsum('bhncd,bhnce->bhnde', k.reshape(b_, h_, n, c_, dk) * zeta[None, :, None, :, None],
                    v.reshape(b_, h_, n, c_, v.shape[-1]))
    g_chunk = jnp.exp(c_ * log_gamma)[None, :, None, None]

    def step(r, kv_i):
        return r * g_chunk + kv_i, (r if emit_starts else None)

    r_last, starts = lax.scan(step, state0, jnp.moveaxis(kv, 2, 0))
    return (jnp.moveaxis(starts, 0, 2) if emit_starts else None), r_last


def retention_readout(q, k, v, log_gamma, starts):
    b_, h_, t_, dk = q.shape
    dv = v.shape[-1]
    c_ = RET_CHUNK
    n = t_ // c_
    pos = jnp.arange(c_, dtype=F32)
    rel = pos[:, None] - pos[None, :]
    dmat = jnp.where(rel >= 0, jnp.exp(jnp.maximum(rel, 0.0)[None] * log_gamma[:, None, None]), 0.0)
    qr = q.reshape(b_, h_, n, c_, dk)
    kr = k.reshape(b_, h_, n, c_, dk)
    vr = v.reshape(b_, h_, n, c_, dv)
    inner = jnp.einsum('bhncs,bhnse->bhnce', jnp.einsum('bhncd,bhnsd->bhncs', qr, kr) * dmat[None, :, None], vr)
    xi = jnp.exp((pos + 1.0)[None, :] * log_gamma[:, None])
    cross = jnp.einsum('bhncd,bhnde->bhnce', qr * xi[None, :, None, :, None], starts)
    return (inner + cross).reshape(b_, h_, t_, dv)


def retention_group(q, k, v, g, qc, kc, vc, gc, log1m_gamma, norm_g, cos, sin, with_ctx_out):
    log_gamma = jnp.log1p(-jnp.exp(log1m_gamma.astype(F32)))
    heads = lambda t, dh: t.reshape(t.shape[0], t.shape[1], RET_HEADS, dh)
    bhtd = lambda t: t.astype(F32).transpose(0, 2, 1, 3)
    sc = RET_QK_DIM ** -0.5
    q = bhtd(apply_rope(heads(q, RET_QK_DIM), cos, sin)) * sc
    k = bhtd(apply_rope(heads(k, RET_QK_DIM), cos, sin))
    v = bhtd(heads(v, RET_V_DIM))
    kc = bhtd(heads(kc, RET_QK_DIM))
    vc = bhtd(heads(vc, RET_V_DIM))
    zero = jnp.zeros((q.shape[0], RET_HEADS, RET_QK_DIM, RET_V_DIM), F32)

    def out(o, g_):
        y = head_layer_norm(o.transpose(0, 2, 1, 3), norm_g) * jax.nn.silu(g_.astype(F32))
        return y.astype(g_.dtype)

    st_cf, r_f = retention_scan(kc, vc, log_gamma[0], zero, with_ctx_out)
    st_cb, r_b = retention_scan(_flip_t(kc), _flip_t(vc), log_gamma[1], zero, with_ctx_out)
    st_f, _ = retention_scan(k, v, log_gamma[0], r_f, True)
    st_b, _ = retention_scan(_flip_t(k), _flip_t(v), log_gamma[1], r_b, True)
    o = (retention_readout(q, k, v, log_gamma[0], st_f)
         + _flip_t(retention_readout(_flip_t(q), _flip_t(k), _flip_t(v), log_gamma[1], st_b)))
    y = out(o, g)
    yc = None
    if with_ctx_out:
        qcs = bhtd(heads(qc, RET_QK_DIM)) * sc
        oc = (retention_readout(qcs, kc, vc, log_gamma[0], st_cf)
              + _flip_t(retention_readout(_flip_t(qcs), _flip_t(kc), _flip_t(vc), log_gamma[1], st_cb)))
        yc = out(oc, gc)
    return y, yc


def mla_queries(cq, q_norm, w_uq, cos, sin):
    b_, t_, _ = cq.shape
    q = (rms_norm(cq, q_norm) @ w_uq).reshape(b_, t_, MLA_HEADS, MLA_NOPE_DIM + MLA_ROPE_DIM)
    if cos is None:
        return q
    return jnp.concatenate([q[..., :MLA_NOPE_DIM], apply_rope(q[..., MLA_NOPE_DIM:], cos, sin)], axis=-1)


def mla_keys_values(ckv, kr, kv_norm, w_ukv, cos, sin):
    b_, t_, _ = ckv.shape
    kv = (rms_norm(ckv, kv_norm) @ w_ukv).reshape(b_, t_, MLA_HEADS, MLA_NOPE_DIM + MLA_V_DIM)
    kr = kr[:, :, None, :]
    if cos is not None:
        kr = apply_rope(kr, cos, sin)
    k = jnp.concatenate([kv[..., :MLA_NOPE_DIM], jnp.broadcast_to(kr, (b_, t_, MLA_HEADS, MLA_ROPE_DIM))], axis=-1)
    return k, kv[..., MLA_NOPE_DIM:]


def mla_attend(q, k_all, v_all):
    b_, t_, h_, dq = q.shape
    nb = t_ // MLA_BLOCK
    scale = dq ** -0.5
    qb = q.reshape(b_, nb, MLA_BLOCK, h_, dq).transpose(1, 0, 2, 3, 4)

    def one_block(qi):
        s = jnp.einsum('bqhd,bkhd->bhqk', qi, k_all).astype(F32) * scale
        p = jax.nn.softmax(s, axis=-1).astype(v_all.dtype)
        return jnp.einsum('bhqk,bkhd->bqhd', p, v_all)

    o = lax.map(one_block, qb)
    return o.transpose(1, 0, 2, 3, 4).reshape(b_, t_, h_ * v_all.shape[-1])


def mla_group(cq, ckv, kr, cq_c, ckv_c, kr_c, q_norm, w_uq, kv_norm, w_ukv, cos, sin, with_ctx_out):
    q = mla_queries(cq, q_norm, w_uq, cos, sin)
    k, v = mla_keys_values(ckv, kr, kv_norm, w_ukv, cos, sin)
    kc, vc = mla_keys_values(ckv_c, kr_c, kv_norm, w_ukv, None, None)
    y = mla_attend(q, jnp.concatenate([k, kc], axis=1), jnp.concatenate([v, vc], axis=1))
    yc = mla_attend(mla_queries(cq_c, q_norm, w_uq, None, None), kc, vc) if with_ctx_out else None
    return y, yc


def token_mixers(h, hc, w_in, swa_sink, dn_conv_w, dn_a_log, dn_dt_bias, dn_norm_g, ret_log1m_gamma,
                 ret_norm_g, mla_q_norm, mla_w_uq, mla_kv_norm, mla_w_ukv, rope, with_ctx_out):
    (a_q, a_k, a_v, b_qkv, b_z, b_ab, c_q, c_k, c_v, c_g, d_cq, d_ckv, d_kr) = _split_columns(h @ w_in)
    (a_qc, a_kc, a_vc, b_qkvc, b_zc, b_abc, c_qc, c_kc, c_vc, c_gc, d_cqc, d_ckvc, d_krc) = _split_columns(hc @ w_in)
    swa_cos, swa_sin, ret_cos, ret_sin, mla_cos, mla_sin = rope
    ya, yac = swa_group(a_q, a_k, a_v, a_qc, a_kc, a_vc, swa_sink, swa_cos, swa_sin, with_ctx_out)
    yb, ybc = deltanet_group(b_qkv, b_z, b_ab, b_qkvc, b_zc, b_abc, dn_conv_w, dn_a_log, dn_dt_bias,
                             dn_norm_g, with_ctx_out)
    yr, yrc = retention_group(c_q, c_k, c_v, c_g, c_qc, c_kc, c_vc, c_gc, ret_log1m_gamma, ret_norm_g,
                              ret_cos, ret_sin, with_ctx_out)
    yd, ydc = mla_group(d_cq, d_ckv, d_kr, d_cqc, d_ckvc, d_krc, mla_q_norm, mla_w_uq, mla_kv_norm,
                        mla_w_ukv, mla_cos, mla_sin, with_ctx_out)
    y = jnp.concatenate([ya, yb, yr, yd], axis=-1)
    yc = jnp.concatenate([yac, ybc, yrc, ydc], axis=-1) if with_ctx_out else None
    return y, yc


def squared_relu_mlp(h, w1, w2):
    return jnp.square(jax.nn.relu(h @ w1)) @ w2


def setup_inputs(seed: int = 0) -> dict:
    key = jax.random.key(seed)
    ks = jax.random.split(key, 32)
    nrm = lambda k, shape, scale: jax.random.normal(k, shape, F32) * scale
    dt = jnp.exp(jax.random.uniform(ks[10], (DEPTH, 2, DN_HEADS), F32, math.log(1e-3), math.log(1e-1)))
    return {
        'x': nrm(ks[0], (BATCH, SEQ, D_MODEL), 1.0),
        'c': nrm(ks[1], (BATCH, D_MODEL), 1.0),
        'ctx': nrm(ks[2], (BATCH, CTX_LEN, D_MODEL), 1.0),
        'c_ctx': nrm(ks[3], (D_MODEL,), 1.0),
        'ada_w': nrm(ks[4], (DEPTH, D_MODEL, 6 * D_MODEL), D_MODEL ** -0.5),
        'ada_b': nrm(ks[5], (DEPTH, 6 * D_MODEL), 0.02),
        'w_in': nrm(ks[6], (DEPTH, D_MODEL, IN_WIDTH), D_MODEL ** -0.5),
        'swa_sink': nrm(ks[7], (DEPTH, SWA_HEADS), 0.5),
        'dn_conv_w': nrm(ks[8], (DEPTH, DN_CONV, 3 * DN_W), DN_CONV ** -0.5),
        'dn_a_log': jnp.log(jax.random.uniform(ks[9], (DEPTH, 2, DN_HEADS), F32, 1.0, 16.0)),
        'dn_dt_bias': dt + jnp.log(-jnp.expm1(-dt)),
        'dn_norm_g': 1.0 + nrm(ks[11], (DEPTH, DN_HEAD_DIM), 0.02),
        'ret_log1m_gamma': (-(5.0 + jnp.arange(RET_HEADS, dtype=F32)) * math.log(2.0)
                            + nrm(ks[12], (DEPTH, 2, RET_HEADS), 0.05)),
        'ret_norm_g': 1.0 + nrm(ks[13], (DEPTH, RET_V), 0.02),
        'mla_q_norm': 1.0 + nrm(ks[14], (DEPTH, MLA_Q_RANK), 0.02),
        'mla_w_uq': nrm(ks[15], (DEPTH, MLA_Q_RANK, MLA_HEADS * (MLA_NOPE_DIM + MLA_ROPE_DIM)), MLA_Q_RANK ** -0.5),
        'mla_kv_norm': 1.0 + nrm(ks[16], (DEPTH, MLA_KV_RANK), 0.02),
        'mla_w_ukv': nrm(ks[17], (DEPTH, MLA_KV_RANK, MLA_HEADS * (MLA_NOPE_DIM + MLA_V_DIM)), MLA_KV_RANK ** -0.5),
        'w_out': nrm(ks[18], (DEPTH, MIX_WIDTH, D_MODEL), MIX_WIDTH ** -0.5 * DEEPNORM_BETA),
        'ln1_g': 1.0 + nrm(ks[19], (DEPTH, D_MODEL), 0.02),
        'ln1_b': nrm(ks[20], (DEPTH, D_MODEL), 0.02),
        'w_ff1': nrm(ks[21], (DEPTH, D_MODEL, D_FF), D_MODEL ** -0.5),
        'w_ff2': nrm(ks[22], (DEPTH, D_FF, D_MODEL), D_FF ** -0.5 * DEEPNORM_BETA),
        'ln2_g': 1.0 + nrm(ks[23], (DEPTH, D_MODEL), 0.02),
        'ln2_b': nrm(ks[24], (DEPTH, D_MODEL), 0.02),
    }


def reference(x, c, ctx, c_ctx, ada_w, ada_b, w_in, swa_sink, dn_conv_w, dn_a_log, dn_dt_bias, dn_norm_g,
              ret_log1m_gamma, ret_norm_g, mla_q_norm, mla_w_uq, mla_kv_norm, mla_w_ukv, w_out, ln1_g, ln1_b,
              w_ff1, w_ff2, ln2_g, ln2_b):
    n_tok = x.shape[1]
    rows = n_tok // GRID_W
    rope = (*axial_rope(rows, SWA_HEAD_DIM), *sequence_rope(n_tok, RET_QK_DIM), *axial_rope(rows, MLA_ROPE_DIM))
    silu_c = jax.nn.silu(c)
    silu_cc = jax.nn.silu(c_ctx)
    xc = ctx
    for layer in range(DEPTH):
        with_ctx_out = layer < DEPTH - 1
        sh1, sc1, g1, sh2, sc2, g2 = jnp.split((silu_c @ ada_w[layer] + ada_b[layer])[:, None, :], 6, axis=-1)
        csh1, csc1, cg1, csh2, csc2, cg2 = jnp.split((silu_cc @ ada_w[layer] + ada_b[layer])[None, None, :], 6, axis=-1)
        y, yc = token_mixers(x * (1 + sc1) + sh1, xc * (1 + csc1) + csh1, w_in[layer], swa_sink[layer],
                             dn_conv_w[layer], dn_a_log[layer], dn_dt_bias[layer], dn_norm_g[layer],
                             ret_log1m_gamma[layer], ret_norm_g[layer], mla_q_norm[layer], mla_w_uq[layer],
                             mla_kv_norm[layer], mla_w_ukv[layer], rope, with_ctx_out)
        x = layer_norm(DEEPNORM_ALPHA * x + g1 * (y @ w_out[layer]), ln1_g[layer], ln1_b[layer])
        x = layer_norm(DEEPNORM_ALPHA * x + g2 * squared_relu_mlp(x * (1 + sc2) + sh2, w_ff1[layer], w_ff2[layer]),
                       ln2_g[layer], ln2_b[layer])
        if with_ctx_out:
            xc = layer_norm(DEEPNORM_ALPHA * xc + cg1 * (yc @ w_out[layer]), ln1_g[layer], ln1_b[layer])
            xc = layer_norm(DEEPNORM_ALPHA * xc + cg2 * squared_relu_mlp(xc * (1 + csc2) + csh2, w_ff1[layer], w_ff2[layer]),
                            ln2_g[layer], ln2_b[layer])
    return x
```

```cpp
#include <hip/hip_runtime.h>
#include <hip/hip_cooperative_groups.h>
#include <cstdio>
namespace cg = cooperative_groups;

#define DI __device__ __forceinline__
typedef unsigned short u16;
typedef unsigned int u32;
using bf16x8 = __attribute__((ext_vector_type(8))) short;
using s16x4 = __attribute__((ext_vector_type(4))) short;
using f32x16 = __attribute__((ext_vector_type(16))) float;
typedef __bf16 bfv2 __attribute__((ext_vector_type(2)));
typedef float flv2 __attribute__((ext_vector_type(2)));
#define MFMA(a, b, c) __builtin_amdgcn_mfma_f32_32x32x16_bf16((a), (b), (c), 0, 0, 0)
#define VHALF ((int)__builtin_amdgcn_readfirstlane((int)(threadIdx.x >> 8)))
#define VTID ((int)(threadIdx.x & 255))
#define VB ((int)(blockIdx.x * 2 + VHALF))
#define VG ((int)(gridDim.x * 2))

constexpr int NB = 16, TT = 4096, LC = 256, DM = 1024, NLAT = NB * TT, NCTX = NB * LC, ROWS = NLAT + NCTX;
constexpr int ZW = 2816, DFF = 4096, NPOS = TT + LC;
constexpr int AP = 1152;
constexpr int WP = 1152;
constexpr int WP2 = 4224;
constexpr int HP = 4224;
constexpr int KVP = 576;
constexpr float LOG2E = 1.4426950408889634f;
constexpr float DN_ALPHA = 1.4142135623730951f;
constexpr int C_AQ = 0, C_AK = 256, C_AV = 384, C_BQKV = 512, C_BZ = 1280, C_BAB = 1536, C_CQ = 1552, C_CK = 1680,
              C_CV = 1808, C_CG = 2064, C_DCQ = 2320, C_DCKV = 2576, C_DKR = 2704;

constexpr size_t al256(size_t x) { return (x + 255) & ~size_t(255); }
constexpr size_t SZ_WIN = (size_t)ZW * WP * 2, SZ_WOUT = (size_t)DM * WP * 2, SZ_WFF = (size_t)DFF * WP * 2,
                 SZ_WUQ = 384 * 256 * 2, SZ_WUKV = 512 * 128 * 2;
constexpr size_t O_WIN = 0;
constexpr size_t O_WOUT = O_WIN + 2 * SZ_WIN;
constexpr size_t O_WFF1 = O_WOUT + 2 * SZ_WOUT;
constexpr size_t O_WFF2 = O_WFF1 + 2 * SZ_WFF;
constexpr size_t O_WUQ = O_WFF2 + 2 * SZ_WFF;
constexpr size_t O_WUKV = O_WUQ + 2 * SZ_WUQ;
constexpr size_t O_MOD = O_WUKV + 2 * SZ_WUKV;
constexpr size_t O_TAB = al256(O_MOD + 2 * 17 * 6144 * 4);
constexpr size_t O_CNT = O_TAB + (size_t)TT * 64 * 8;
constexpr size_t O_GRAW = O_CNT + 256;
constexpr size_t O_G2 = O_GRAW + (size_t)ROWS * 16 * 4;
constexpr size_t O_XC = O_G2 + (size_t)ROWS * 16 * 4;
constexpr size_t O_ACT = O_XC + (size_t)NCTX * DM * 4;
constexpr size_t O_Z = O_ACT + (size_t)ROWS * AP * 2;
constexpr size_t O_QA = O_Z + (size_t)ROWS * ZW * 2;
constexpr size_t O_KA = O_QA + (size_t)NB * 4 * NPOS * 64 * 2;
constexpr size_t O_QD = O_KA + (size_t)NB * 2 * NPOS * 64 * 2;
constexpr size_t O_KVD = O_QD + (size_t)ROWS * 384 * 2;
constexpr size_t O_KR = O_KVD + (size_t)ROWS * KVP * 2;
constexpr size_t O_QKVB = O_KR + (size_t)ROWS * 32 * 2;
constexpr size_t O_OB = O_QKVB + (size_t)ROWS * 768 * 2;
constexpr size_t O_QC = O_OB + (size_t)ROWS * 256 * 2;
constexpr size_t O_KC = O_QC + (size_t)ROWS * 128 * 2;
constexpr size_t WS_END = O_KC + (size_t)ROWS * 128 * 2;
static_assert(O_Z + (size_t)ROWS * HP * 2 <= WS_END, "hid alias");
static_assert((size_t)DM * WP2 * 2 <= SZ_WFF, "ff2 weights");
static_assert(WS_END <= (size_t)1073741824, "workspace");

constexpr int LDS_BYTES = 73728;

struct Params {
  const float *x, *c, *ctx, *c_ctx, *ada_w, *ada_b, *w_in, *swa_sink, *dn_conv_w, *dn_a_log, *dn_dt_bias, *dn_norm_g,
      *ret_l1m, *ret_norm_g, *mla_q_norm, *mla_w_uq, *mla_kv_norm, *mla_w_ukv, *w_out, *ln1_g, *ln1_b, *w_ff1, *w_ff2,
      *ln2_g, *ln2_b;
  float* out;
  unsigned char* ws;
};

DI u16 f2bf(float x) { return __builtin_bit_cast(u16, (__bf16)x); }
DI float bf2f(u16 v) { return __uint_as_float(((u32)v) << 16); }
DI u32 pack2(float a, float b) {
  flv2 f = {a, b};
  bfv2 v = __builtin_convertvector(f, bfv2);
  return __builtin_bit_cast(u32, v);
}
DI float bflo(u32 u) { return __uint_as_float(u << 16); }
DI float bfhi(u32 u) { return __uint_as_float(u & 0xffff0000u); }
DI int crow(int reg, int h) { return (reg & 3) + 8 * (reg >> 2) + 4 * h; }
DI float wave_sum(float v) {
#pragma unroll
  for (int o = 32; o >= 1; o >>= 1) v += __shfl_xor(v, o);
  return v;
}
DI float siluf(float x) { return x / (1.f + __expf(-x)); }
DI f32x16 zero16() {
  f32x16 z;
#pragma unroll
  for (int i = 0; i < 16; ++i) z[i] = 0.f;
  return z;
}

DI void scat8s(u16* base, int stride, const uint4& v, float f) {
  base[0 * stride] = f2bf(bflo(v.x) * f); base[1 * stride] = f2bf(bfhi(v.x) * f);
  base[2 * stride] = f2bf(bflo(v.y) * f); base[3 * stride] = f2bf(bfhi(v.y) * f);
  base[4 * stride] = f2bf(bflo(v.z) * f); base[5 * stride] = f2bf(bfhi(v.z) * f);
  base[6 * stride] = f2bf(bflo(v.w) * f); base[7 * stride] = f2bf(bfhi(v.w) * f);
}
DI void scat8r(u16* base, int stride, const uint4& v) {
  base[0 * stride] = (u16)(v.x & 0xffffu); base[1 * stride] = (u16)(v.x >> 16);
  base[2 * stride] = (u16)(v.y & 0xffffu); base[3 * stride] = (u16)(v.y >> 16);
  base[4 * stride] = (u16)(v.z & 0xffffu); base[5 * stride] = (u16)(v.z >> 16);
  base[6 * stride] = (u16)(v.w & 0xffffu); base[7 * stride] = (u16)(v.w >> 16);
}
DI float sumsq8(const uint4& u) {
  float s = 0.f, a;
  a = bflo(u.x); s += a * a; a = bfhi(u.x); s += a * a;
  a = bflo(u.y); s += a * a; a = bfhi(u.y); s += a * a;
  a = bflo(u.z); s += a * a; a = bfhi(u.z); s += a * a;
  a = bflo(u.w); s += a * a; a = bfhi(u.w); s += a * a;
  return s;
}
typedef u32 u32x4 __attribute__((ext_vector_type(4)));
DI u32x4 ldg16(const u16* p) { return *(const u32x4*)p; }
DI void unpack8(const u32x4& u, float* f) {
  f[0] = bflo(u[0]); f[1] = bfhi(u[0]); f[2] = bflo(u[1]); f[3] = bfhi(u[1]);
  f[4] = bflo(u[2]); f[5] = bfhi(u[2]); f[6] = bflo(u[3]); f[7] = bfhi(u[3]);
}
DI u32x4 pack8(const float* f) {
  u32x4 o;
  o[0] = pack2(f[0], f[1]); o[1] = pack2(f[2], f[3]); o[2] = pack2(f[4], f[5]); o[3] = pack2(f[6], f[7]);
  return o;
}
DI float* xrow(const Params& p, int row) {
  return row < NLAT ? p.out + (size_t)row * DM : (float*)(p.ws + O_XC) + (size_t)(row - NLAT) * DM;
}
DI const float* xrow0(const Params& p, int row) {
  return row < NLAT ? p.x + (size_t)row * DM : p.ctx + (size_t)(row - NLAT) * DM;
}
DI int rowb(int row) { return row < NLAT ? (row >> 12) : 16; }

constexpr int CSL = 132;
constexpr int GS = 72;
template <typename Epi>
DI void gemm_tile(const u16* __restrict__ A, int lda, const u16* __restrict__ Bt, int ldb, int K, char* lds, Epi epi) {
  u16* As = (u16*)lds;
  u16* Bs = As + 256 * GS;
  float* Cs = (float*)lds;
  int tid_ = VTID;
  asm volatile("" : "+v"(tid_));
  const int tid = tid_, wave = tid >> 6, lane = tid & 63, r = lane & 31, h = lane >> 5;
  const int wm = wave >> 1, wn = wave & 1;
  f32x16 acc[4][2];
#pragma unroll
  for (int i = 0; i < 4; ++i)
#pragma unroll
    for (int j = 0; j < 2; ++j) acc[i][j] = zero16();
  const int lrow = tid >> 3, lcol = (tid & 7) * 8;
  const u16* Ap = A + (size_t)lrow * lda + lcol;
  const u16* Bp = Bt + (size_t)lrow * ldb + lcol;
  u16* Aw = As + lrow * GS + lcol;
  u16* Bw = Bs + lrow * GS + lcol;
  u32x4 ra[8], rb[4];
#define GT_LOAD(k0)                                                                 \
  {                                                                                 \
    _Pragma("unroll") for (int i_ = 0; i_ < 8; ++i_) ra[i_] = ldg16(Ap + (size_t)(i_ * 32) * lda + (k0)); \
    _Pragma("unroll") for (int i_ = 0; i_ < 4; ++i_) rb[i_] = ldg16(Bp + (size_t)(i_ * 32) * ldb + (k0)); \
  }
#define GT_STORE()                                                                  \
  {                                                                                 \
    _Pragma("unroll") for (int i_ = 0; i_ < 8; ++i_) *(u32x4*)(Aw + i_ * 32 * GS) = ra[i_]; \
    _Pragma("unroll") for (int i_ = 0; i_ < 4; ++i_) *(u32x4*)(Bw + i_ * 32 * GS) = rb[i_]; \
  }
#define GT_COMPUTE()                                                                              \
  _Pragma("unroll") for (int ks = 0; ks < 4; ++ks) {                                              \
    bf16x8 fa[4], fb[2];                                                                          \
    _Pragma("unroll") for (int i_ = 0; i_ < 4; ++i_)                                              \
      fa[i_] = *(const bf16x8*)(As + (wm * 128 + i_ * 32 + r) * GS + ks * 16 + 8 * h);            \
    _Pragma("unroll") for (int j_ = 0; j_ < 2; ++j_)                                              \
      fb[j_] = *(const bf16x8*)(Bs + (wn * 64 + j_ * 32 + r) * GS + ks * 16 + 8 * h);             \
    _Pragma("unroll") for (int i_ = 0; i_ < 4; ++i_)                                              \
      _Pragma("unroll") for (int j_ = 0; j_ < 2; ++j_) acc[i_][j_] = MFMA(fa[i_], fb[j_], acc[i_][j_]); \
  }
  const int nk = K >> 6;
  GT_LOAD(0);
  for (int kt = 0; kt + 1 < nk; ++kt) {
    __syncthreads();
    GT_STORE();
    __syncthreads();
    GT_LOAD((kt + 1) << 6);
    GT_COMPUTE();
  }
  __syncthreads();
  GT_STORE();
  __syncthreads();
  GT_COMPUTE();
#pragma unroll 1
  for (int half = 0; half < 2; ++half) {
    __syncthreads();
    if (wm == half) {
#pragma unroll
      for (int i = 0; i < 4; ++i)
#pragma unroll
        for (int j = 0; j < 2; ++j)
#pragma unroll
          for (int g = 0; g < 16; ++g) Cs[(i * 32 + crow(g, h)) * CSL + wn * 64 + j * 32 + r] = acc[i][j][g];
    }
    __syncthreads();
    epi(half);
  }
}

constexpr int CSW = 264;
template <typename Epi>
DI void gemm_tile512(const u16* __restrict__ A, int lda, const u16* __restrict__ Bt, int ldb, int K, char* lds_all, Epi epi) {
  constexpr int STG = 2 * 256 * GS;
  u16* S0 = (u16*)lds_all;
  float* Cs = (float*)lds_all;
  int tid_ = threadIdx.x;
  asm volatile("" : "+v"(tid_));
  const int tid = tid_, wave = tid >> 6, lane = tid & 63, r = lane & 31, h = lane >> 5;
  const int wm = wave >> 2, wn = wave & 3;
  f32x16 acc[4][2];
#pragma unroll
  for (int i = 0; i < 4; ++i)
#pragma unroll
    for (int j = 0; j < 2; ++j) acc[i][j] = zero16();
  const int lrow = tid >> 3, lcol = (tid & 7) * 8;
  const u16* Ap = A + (size_t)lrow * lda + lcol;
  const u16* Bp = Bt + (size_t)lrow * ldb + lcol;
  u16* Sw = S0 + lrow * GS + lcol;
  u32x4 ra[4], rb[4];
#define G5_LOAD(k0)                                                                 \
  {                                                                                 \
    _Pragma("unroll") for (int i_ = 0; i_ < 4; ++i_) ra[i_] = ldg16(Ap + (size_t)(i_ * 64) * lda + (k0)); \
    _Pragma("unroll") for (int i_ = 0; i_ < 4; ++i_) rb[i_] = ldg16(Bp + (size_t)(i_ * 64) * ldb + (k0)); \
  }
#define G5_STORE(s)                                                                 \
  {                                                                                 \
    _Pragma("unroll") for (int i_ = 0; i_ < 4; ++i_) *(u32x4*)(Sw + (s) * STG + i_ * 64 * GS) = ra[i_]; \
    _Pragma("unroll") for (int i_ = 0; i_ < 4; ++i_) *(u32x4*)(Sw + (s) * STG + 256 * GS + i_ * 64 * GS) = rb[i_]; \
  }
#define G5_COMPUTE(s)                                                                             \
  {                                                                                               \
    const u16* As_ = S0 + (s) * STG;                                                              \
    const u16* Bs_ = As_ + 256 * GS;                                                              \
    _Pragma("unroll") for (int ks = 0; ks < 4; ++ks) {                                            \
      bf16x8 fa[4], fb[2];                                                                        \
      _Pragma("unroll") for (int i_ = 0; i_ < 4; ++i_)                                            \
        fa[i_] = *(const bf16x8*)(As_ + (wm * 128 + i_ * 32 + r) * GS + ks * 16 + 8 * h);         \
      _Pragma("unroll") for (int j_ = 0; j_ < 2; ++j_)                                            \
        fb[j_] = *(const bf16x8*)(Bs_ + (wn * 64 + j_ * 32 + r) * GS + ks * 16 + 8 * h);          \
      _Pragma("unroll") for (int i_ = 0; i_ < 4; ++i_)                                            \
        _Pragma("unroll") for (int j_ = 0; j_ < 2; ++j_) acc[i_][j_] = MFMA(fa[i_], fb[j_], acc[i_][j_]); \
    }                                                                                             \
  }
  const int nk = K >> 6;
  __syncthreads();
  G5_LOAD(0);
  G5_STORE(0);
  G5_LOAD(64);
  __syncthreads();
  for (int kt = 0; kt + 2 < nk; ++kt) {
    const int cur = kt & 1;
    G5_STORE(cur ^ 1);
    G5_LOAD((kt + 2) << 6);
    G5_COMPUTE(cur);
    __syncthreads();
  }
  {
    const int cur = (nk - 2) & 1;
    G5_STORE(cur ^ 1);
    G5_COMPUTE(cur);
    __syncthreads();
    G5_COMPUTE(cur ^ 1);
  }
#pragma unroll 1
  for (int half = 0; half < 2; ++half) {
    __syncthreads();
    if (wm == half) {
#pragma unroll
      for (int i = 0; i < 4; ++i)
#pragma unroll
        for (int j = 0; j < 2; ++j)
#pragma unroll
          for (int g = 0; g < 16; ++g) Cs[(i * 32 + crow(g, h)) * CSW + wn * 64 + j * 32 + r] = acc[i][j][g];
    }
    __syncthreads();
    epi(half);
  }
}

DI void wtrans_tile(const float* __restrict__ src, int K, int N, u16* __restrict__ dst, int ldw, int tk, int tn,
                    const float* __restrict__ kscale, char* lds) {
  float* t = (float*)lds;
  int tid_ = VTID;
  asm volatile("" : "+v"(tid_));
  const int tid = tid_, j = tid & 63, i0 = tid >> 6;
  const int k0 = tk * 64, n0 = tn * 64;
  __syncthreads();
#pragma unroll
  for (int q = 0; q < 16; ++q) {
    int i = i0 + 4 * q;
    float v = (n0 + j < N) ? src[(size_t)(k0 + i) * N + n0 + j] : 0.f;
    if (kscale) v *= kscale[k0 + i];
    t[i * 65 + j] = v;
  }
  __syncthreads();
#pragma unroll 4
  for (int q = 0; q < 16; ++q) {
    int jj = i0 + 4 * q;
    dst[(size_t)(n0 + jj) * ldw + k0 + j] = f2bf(t[j * 65 + jj]);
  }
}

DI void ada_tile(const Params& p, int layer, int cg64, char* lds) {
  float* sc = (float*)lds;
  int tid_ = VTID;
  asm volatile("" : "+v"(tid_));
  const int tid = tid_;
  __syncthreads();
  for (int e = tid; e < 17 * 1024; e += 256) {
    int bi = e >> 10, k = e & 1023;
    float v = bi < 16 ? p.c[bi * 1024 + k] : p.c_ctx[k];
    sc[e] = siluf(v);
  }
  __syncthreads();
  const int col = tid & 63, kq = tid >> 6;
  const int n = cg64 * 64 + col;
  const float* w = p.ada_w + (size_t)layer * 1024 * 6144 + n;
  float acc[17];
#pragma unroll
  for (int i = 0; i < 17; ++i) acc[i] = 0.f;
#pragma unroll 8
  for (int kk = 0; kk < 256; ++kk) {
    int k = kq * 256 + kk;
    float wv = w[(size_t)k * 6144];
#pragma unroll
    for (int i = 0; i < 17; ++i) acc[i] += sc[i * 1024 + k] * wv;
  }
  __syncthreads();
  float* red = (float*)lds;
#pragma unroll
  for (int i = 0; i < 17; ++i) red[(kq * 17 + i) * 64 + col] = acc[i];
  __syncthreads();
  float* mod = (float*)(p.ws + O_MOD) + (size_t)layer * 17 * 6144;
  for (int e = tid; e < 17 * 64; e += 256) {
    int bi = e >> 6, cc = e & 63;
    float s = red[(0 * 17 + bi) * 64 + cc] + red[(1 * 17 + bi) * 64 + cc] + red[(2 * 17 + bi) * 64 + cc] +
              red[(3 * 17 + bi) * 64 + cc];
    int nn = cg64 * 64 + cc;
    mod[bi * 6144 + nn] = s + p.ada_b[layer * 6144 + nn];
  }
}

DI void phase0a(const Params& p, char* lds) {
  int tid_ = VTID;
  asm volatile("" : "+v"(tid_));
  const int tid = tid_;
  for (int t = VB; t < 6544; t += VG) {
    if (t < 6096) {
      int layer = t / 3048, q = t % 3048;
      if (q < 704) {
        wtrans_tile(p.w_in + (size_t)layer * 1024 * 2736, 1024, 2736, (u16*)(p.ws + O_WIN + layer * SZ_WIN), WP, q / 44, q % 44,
                    nullptr, lds);
      } else if (q < 960) {
        q -= 704;
        wtrans_tile(p.w_out + (size_t)layer * 1024 * 1024, 1024, 1024, (u16*)(p.ws + O_WOUT + layer * SZ_WOUT), WP, q / 16, q % 16,
                    nullptr, lds);
      } else if (q < 1984) {
        q -= 960;
        wtrans_tile(p.w_ff1 + (size_t)layer * 1024 * 4096, 1024, 4096, (u16*)(p.ws + O_WFF1 + layer * SZ_WFF), WP, q / 64, q % 64,
                    nullptr, lds);
      } else if (q < 3008) {
        q -= 1984;
        wtrans_tile(p.w_ff2 + (size_t)layer * 4096 * 1024, 4096, 1024, (u16*)(p.ws + O_WFF2 + layer * SZ_WFF), WP2, q / 16, q % 16,
                    nullptr, lds);
      } else if (q < 3032) {
        q -= 3008;
        wtrans_tile(p.mla_w_uq + (size_t)layer * 256 * 384, 256, 384, (u16*)(p.ws + O_WUQ + layer * SZ_WUQ), 256, q / 6, q % 6,
                    p.mla_q_norm + layer * 256, lds);
      } else {
        q -= 3032;
        wtrans_tile(p.mla_w_ukv + (size_t)layer * 128 * 512, 128, 512, (u16*)(p.ws + O_WUKV + layer * SZ_WUKV), 128, q / 8, q % 8,
                    p.mla_kv_norm + layer * 128, lds);
      }
    } else if (t < 6288) {
      int q = t - 6096;
      ada_tile(p, q / 96, q % 96, lds);
    } else {
      int q = t - 6288;
      float2* tab = (float2*)(p.ws + O_TAB);
      for (int e = q * 1024 + tid; e < (q + 1) * 1024; e += 256) {
        int tok = e >> 6, i = e & 63;
        float ang;
        if (i < 32) {
          int f = i & 15;
          float inv = powf(10000.f, -(float)(2 * f) / 32.f);
          ang = (float)(i < 16 ? (tok >> 6) : (tok & 63)) * inv;
        } else if (i < 48) {
          int f = i - 32;
          float inv = powf(10000.f, -(float)(2 * f) / 32.f);
          ang = (float)tok * inv;
        } else {
          int f = (i - 48) & 7;
          float inv = powf(10000.f, -(float)(2 * f) / 16.f);
          ang = (float)((i - 48) < 8 ? (tok >> 6) : (tok & 63)) * inv;
        }
        float sn, cs;
        sincosf(ang, &sn, &cs);
        tab[e] = make_float2(cs, sn);
      }
    }
  }
}

DI void modulate_rows(const Params& p, int layer_mod, int nrows) {
  int tid_ = VTID;
  asm volatile("" : "+v"(tid_));
  const int tid = tid_, wave = tid >> 6, lane = tid & 63;
  const float* mod = (const float*)(p.ws + O_MOD) + (size_t)layer_mod * 17 * 6144;
  u16* act = (u16*)(p.ws + O_ACT);
  const int stride = VG * 4;
  for (int row0 = VB * 4 + wave; row0 < nrows; row0 += 2 * stride) {
    const int row1 = row0 + stride;
    const bool has1 = row1 < nrows;
    float4 va[4], vb[4];
#pragma unroll
    for (int i = 0; i < 4; ++i) {
      va[i] = *(const float4*)(xrow0(p, row0) + (i * 64 + lane) * 4);
      vb[i] = has1 ? *(const float4*)(xrow0(p, row1) + (i * 64 + lane) * 4) : make_float4(0.f, 0.f, 0.f, 0.f);
    }
#pragma unroll
    for (int rr = 0; rr < 2; ++rr) {
      if (rr == 1 && !has1) break;
      const int row = rr ? row1 : row0;
      const float* m = mod + rowb(row) * 6144;
#pragma unroll
      for (int i = 0; i < 4; ++i) {
        int col = (i * 64 + lane) * 4;
        float4 v = rr ? vb[i] : va[i];
        float4 sh = *(const float4*)(m + col);
        float4 sc = *(const float4*)(m + 1024 + col);
        uint2 o;
        o.x = pack2(v.x * (1.f + sc.x) + sh.x, v.y * (1.f + sc.y) + sh.y);
        o.y = pack2(v.z * (1.f + sc.z) + sh.z, v.w * (1.f + sc.w) + sh.w);
        *(uint2*)(act + (size_t)row * AP + col) = o;
      }
    }
  }
}

DI void ln_rows(const Params& p, const float* g, const float* bb, int nrows, int mod_layer, int sh_chunk, bool write_act) {
  int tid_ = VTID;
  asm volatile("" : "+v"(tid_));
  const int tid = tid_, wave = tid >> 6, lane = tid & 63;
  u16* act = (u16*)(p.ws + O_ACT);
  const int stride = VG * 4;
  for (int row0 = VB * 4 + wave; row0 < nrows; row0 += 2 * stride) {
    const int row1 = row0 + stride;
    const bool has1 = row1 < nrows;
    float4 va[4], vb[4];
    float sa = 0.f, sb = 0.f;
#pragma unroll
    for (int i = 0; i < 4; ++i) {
      va[i] = *(const float4*)(xrow(p, row0) + (i * 64 + lane) * 4);
      vb[i] = has1 ? *(const float4*)(xrow(p, row1) + (i * 64 + lane) * 4) : make_float4(0.f, 0.f, 0.f, 0.f);
    }
#pragma unroll
    for (int i = 0; i < 4; ++i) {
      sa += va[i].x + va[i].y + va[i].z + va[i].w;
      sb += vb[i].x + vb[i].y + vb[i].z + vb[i].w;
    }
    const float ma = wave_sum(sa) * (1.f / 1024.f), mb = wave_sum(sb) * (1.f / 1024.f);
    float qa = 0.f, qb = 0.f;
#pragma unroll
    for (int i = 0; i < 4; ++i) {
      va[i].x -= ma; va[i].y -= ma; va[i].z -= ma; va[i].w -= ma;
      vb[i].x -= mb; vb[i].y -= mb; vb[i].z -= mb; vb[i].w -= mb;
      qa += va[i].x * va[i].x + va[i].y * va[i].y + va[i].z * va[i].z + va[i].w * va[i].w;
      qb += vb[i].x * vb[i].x + vb[i].y * vb[i].y + vb[i].z * vb[i].z + vb[i].w * vb[i].w;
    }
    const float ra = rsqrtf(wave_sum(qa) * (1.f / 1024.f) + 1e-5f), rb = rsqrtf(wave_sum(qb) * (1.f / 1024.f) + 1e-5f);
#pragma unroll
    for (int rr = 0; rr < 2; ++rr) {
      if (rr == 1 && !has1) break;
      const int row = rr ? row1 : row0;
      const float rstd = rr ? rb : ra;
      float* dst = xrow(p, row);
      const float* m = (const float*)(p.ws + O_MOD) + (size_t)mod_layer * 17 * 6144 + rowb(row) * 6144 + sh_chunk * 1024;
#pragma unroll
      for (int i = 0; i < 4; ++i) {
        int col = (i * 64 + lane) * 4;
        float4 v = rr ? vb[i] : va[i];
        float4 gg = *(const float4*)(g + col);
        float4 bv = *(const float4*)(bb + col);
        float4 y;
        y.x = v.x * rstd * gg.x + bv.x; y.y = v.y * rstd * gg.y + bv.y;
        y.z = v.z * rstd * gg.z + bv.z; y.w = v.w * rstd * gg.w + bv.w;
        *(float4*)(dst + col) = y;
        if (write_act) {
          float4 sh = *(const float4*)(m + col);
          float4 sc = *(const float4*)(m + 1024 + col);
          uint2 o;
          o.x = pack2(y.x * (1.f + sc.x) + sh.x, y.y * (1.f + sc.y) + sh.y);
          o.y = pack2(y.z * (1.f + sc.z) + sh.z, y.w * (1.f + sc.w) + sh.w);
          *(uint2*)(act + (size_t)row * AP + col) = o;
        }
      }
    }
  }
}

DI void gemm_phase(const Params& p, int layer, int mode, int nrows, char* lds_all) {
  int tid_ = threadIdx.x;
  asm volatile("" : "+v"(tid_));
  const int tid = tid_;
  const float* Cs = (const float*)lds_all;
  int ntn, K, lda, ldb;
  const u16 *A, *Bt;
  if (mode == 0) { ntn = 11; K = 1024; lda = AP; ldb = WP; A = (const u16*)(p.ws + O_ACT); Bt = (const u16*)(p.ws + O_WIN + layer * SZ_WIN); }
  else if (mode == 1) { ntn = 4; K = 1024; lda = AP; ldb = WP; A = (const u16*)(p.ws + O_ACT); Bt = (const u16*)(p.ws + O_WOUT + layer * SZ_WOUT); }
  else if (mode == 2) { ntn = 16; K = 1024; lda = AP; ldb = WP; A = (const u16*)(p.ws + O_ACT); Bt = (const u16*)(p.ws + O_WFF1 + layer * SZ_WFF); }
  else { ntn = 4; K = 4096; lda = HP; ldb = WP2; A = (const u16*)(p.ws + O_Z); Bt = (const u16*)(p.ws + O_WFF2 + layer * SZ_WFF); }
  const int ntm = nrows >> 8;
  const float* mod = (const float*)(p.ws + O_MOD) + (size_t)layer * 17 * 6144;
  const bool swz = (gridDim.x & 7) == 0;
  const int xcd = swz ? (blockIdx.x & 7) : 0, nx = swz ? 8 : 1;
  const int jb = swz ? (blockIdx.x >> 3) : blockIdx.x, nj = swz ? (gridDim.x >> 3) : gridDim.x;
  const int per = 2 * ntn, nsr = ntm >> 1;
  for (int i = jb;; i += nj) {
    const int srl = i / per, rem = i - srl * per;
    const int sr = xcd + nx * srl;
    if (sr >= nsr) break;
    const int tn = rem >> 1, tm = sr * 2 + (rem & 1);
    const int m0 = tm * 256, n0 = tn * 256;
    gemm_tile512(A + (size_t)m0 * lda, lda, Bt + (size_t)n0 * ldb, ldb, K, lds_all, [&](int half) {
      for (int idx = tid; idx < 128 * 64; idx += 512) {
        const int rr = idx >> 6, c4 = (idx & 63) * 4;
        const int row = m0 + half * 128 + rr, col = n0 + c4;
        float4 v = *(const float4*)(Cs + rr * CSW + c4);
        if (mode == 0) {
          uint2 o;
          o.x = pack2(v.x, v.y); o.y = pack2(v.z, v.w);
          *(uint2*)((u16*)(p.ws + O_Z) + (size_t)row * ZW + col) = o;
          if (n0 == C_BAB && c4 < 16) *(float4*)((float*)(p.ws + O_GRAW) + (size_t)row * 16 + c4) = v;
        } else if (mode == 2) {
          float a = fmaxf(v.x, 0.f), b = fmaxf(v.y, 0.f), c = fmaxf(v.z, 0.f), d = fmaxf(v.w, 0.f);
          uint2 o;
          o.x = pack2(a * a, b * b); o.y = pack2(c * c, d * d);
          *(uint2*)((u16*)(p.ws + O_Z) + (size_t)row * HP + col) = o;
        } else {
          const float* gate = mod + rowb(row) * 6144 + (mode == 1 ? 2 : 5) * 1024 + col;
          float4 gt = *(const float4*)gate;
          const float* res = (mode == 1 && layer == 0) ? xrow0(p, row) : xrow(p, row);
          float4 xr = *(const float4*)(res + col);
          float4 o;
          o.x = DN_ALPHA * xr.x + gt.x * v.x; o.y = DN_ALPHA * xr.y + gt.y * v.y;
          o.z = DN_ALPHA * xr.z + gt.z * v.z; o.w = DN_ALPHA * xr.w + gt.w * v.w;
          *(float4*)(xrow(p, row) + col) = o;
        }
      }
    });
  }
}

DI void prep_swa(const Params& p, int tile) {
  int tid_ = VTID;
  asm volatile("" : "+v"(tid_));
  const int tid = tid_;
  const u16* Z = (const u16*)(p.ws + O_Z);
  const float4* tab = (const float4*)(p.ws + O_TAB);
  u16* QA = (u16*)(p.ws + O_QA);
  u16* KA = (u16*)(p.ws + O_KA);
  const int m0 = tile * 64;
  for (int jb = 0; jb < 6; jb += 3) {
    u32x4 x1[3], x2[3];
    float4 tb[3][4];
#pragma unroll
    for (int u = 0; u < 3; ++u) {
      const int id = tid + 256 * (jb + u), ri = id / 24, rem = id % 24, slot = rem >> 2, i8 = rem & 3;
      const int row = m0 + ri;
      const int base = slot < 4 ? C_AQ + slot * 64 : C_AK + (slot - 4) * 64;
      x1[u] = ldg16(Z + (size_t)row * ZW + base + i8 * 8);
      x2[u] = ldg16(Z + (size_t)row * ZW + base + 32 + i8 * 8);
      const int pos = row < NLAT ? (row & 4095) : 0;
#pragma unroll
      for (int e = 0; e < 4; ++e) tb[u][e] = tab[(pos * 64 + i8 * 8) / 2 + e];
    }
#pragma unroll
    for (int u = 0; u < 3; ++u) {
      const int id = tid + 256 * (jb + u), ri = id / 24, rem = id % 24, slot = rem >> 2, i8 = rem & 3;
      const int row = m0 + ri;
      const bool lat = row < NLAT;
      int b, pos;
      if (lat) { b = row >> 12; pos = row & 4095; } else { b = (row - NLAT) >> 8; pos = TT + ((row - NLAT) & 255); }
      float a1[8], a2[8], o1[8], o2[8];
      unpack8(x1[u], a1); unpack8(x2[u], a2);
      const float qs = slot < 4 ? 0.125f * LOG2E : 1.f;
#pragma unroll
      for (int e = 0; e < 4; ++e) {
        float c0 = lat ? tb[u][e].x : 1.f, s0 = lat ? tb[u][e].y : 0.f, c1 = lat ? tb[u][e].z : 1.f, s1 = lat ? tb[u][e].w : 0.f;
        o1[2 * e] = (a1[2 * e] * c0 - a2[2 * e] * s0) * qs;
        o2[2 * e] = (a1[2 * e] * s0 + a2[2 * e] * c0) * qs;
        o1[2 * e + 1] = (a1[2 * e + 1] * c1 - a2[2 * e + 1] * s1) * qs;
        o2[2 * e + 1] = (a1[2 * e + 1] * s1 + a2[2 * e + 1] * c1) * qs;
      }
      u16* d = slot < 4 ? QA + ((size_t)(b * 4 + slot) * NPOS + pos) * 64 : KA + ((size_t)(b * 2 + slot - 4) * NPOS + pos) * 64;
      *(u32x4*)(d + i8 * 8) = pack8(o1);
      *(u32x4*)(d + 32 + i8 * 8) = pack8(o2);
    }
  }
}

DI void prep_ret(const Params& p, int tile) {
  int tid_ = VTID;
  asm volatile("" : "+v"(tid_));
  const int tid = tid_;
  const u16* Z = (const u16*)(p.ws + O_Z);
  const float4* tab = (const float4*)(p.ws + O_TAB);
  u16* QC = (u16*)(p.ws + O_QC);
  u16* KC = (u16*)(p.ws + O_KC);
  const int m0 = tile * 64;
  u32x4 x1[4], x2[4];
  float4 tb[4][4];
#pragma unroll
  for (int u = 0; u < 4; ++u) {
    const int id = tid + 256 * u, ri = id >> 4, rem = id & 15, slot = rem >> 1, i8 = rem & 1;
    const int row = m0 + ri;
    const int base = C_CQ + slot * 32;
    x1[u] = ldg16(Z + (size_t)row * ZW + base + i8 * 8);
    x2[u] = ldg16(Z + (size_t)row * ZW + base + 16 + i8 * 8);
    const int pos = row < NLAT ? (row & 4095) : 0;
#pragma unroll
    for (int e = 0; e < 4; ++e) tb[u][e] = tab[(pos * 64 + 32 + i8 * 8) / 2 + e];
  }
#pragma unroll
  for (int u = 0; u < 4; ++u) {
    const int id = tid + 256 * u, ri = id >> 4, rem = id & 15, slot = rem >> 1, i8 = rem & 1;
    const int row = m0 + ri;
    const bool lat = row < NLAT;
    float a1[8], a2[8], o1[8], o2[8];
    unpack8(x1[u], a1); unpack8(x2[u], a2);
    const float qs = slot < 4 ? 0.17677669529663687f : 1.f;
#pragma unroll
    for (int e = 0; e < 4; ++e) {
      float c0 = lat ? tb[u][e].x : 1.f, s0 = lat ? tb[u][e].y : 0.f, c1 = lat ? tb[u][e].z : 1.f, s1 = lat ? tb[u][e].w : 0.f;
      o1[2 * e] = (a1[2 * e] * c0 - a2[2 * e] * s0) * qs;
      o2[2 * e] = (a1[2 * e] * s0 + a2[2 * e] * c0) * qs;
      o1[2 * e + 1] = (a1[2 * e + 1] * c1 - a2[2 * e + 1] * s1) * qs;
      o2[2 * e + 1] = (a1[2 * e + 1] * s1 + a2[2 * e + 1] * c1) * qs;
    }
    u16* d = slot < 4 ? QC + (size_t)row * 128 + slot * 32 : KC + (size_t)row * 128 + (slot - 4) * 32;
    *(u32x4*)(d + i8 * 8) = pack8(o1);
    *(u32x4*)(d + 16 + i8 * 8) = pack8(o2);
  }
}

DI void prep_dn(const Params& p, int layer, int tile, char* lds) {
  int tid_ = VTID;
  asm volatile("" : "+v"(tid_));
  const int tid = tid_;
  const u16* Z = (const u16*)(p.ws + O_Z);
  u16* QKVB = (u16*)(p.ws + O_QKVB);
  float* cw = (float*)lds;
  const int m0 = tile * 64;
  __syncthreads();
  for (int e = tid; e < 3840; e += 256) cw[e] = p.dn_conv_w[(size_t)layer * 3840 + e];
  __syncthreads();
  for (int jb = 0; jb < 24; jb += 4) {
    u32x4 xr[4][5];
#pragma unroll
    for (int u = 0; u < 4; ++u) {
      const int id = tid + 256 * (jb + u), ri = id / 96, ch8 = id % 96;
      const int row = m0 + ri;
      int tpos, seqn;
      if (row < NLAT) { tpos = row & 4095; seqn = TT; } else { tpos = (row - NLAT) & 255; seqn = LC; }
      const u16* zc = Z + (size_t)row * ZW + C_BQKV + ch8 * 8;
#pragma unroll
      for (int j = 0; j < 5; ++j) {
        const int tp = tpos + j - 2;
        u32x4 zz = {0u, 0u, 0u, 0u};
        xr[u][j] = (tp >= 0 && tp < seqn) ? ldg16(zc + (j - 2) * ZW) : zz;
      }
    }
#pragma unroll
    for (int u = 0; u < 4; ++u) {
      const int id = tid + 256 * (jb + u), ri = id / 96, ch8 = id % 96;
      const int row = m0 + ri;
      float acc[8];
#pragma unroll
      for (int e = 0; e < 8; ++e) acc[e] = 0.f;
#pragma unroll
      for (int j = 0; j < 5; ++j) {
        float x[8];
        unpack8(xr[u][j], x);
        const float4 w0 = *(const float4*)(cw + j * 768 + ch8 * 8), w1 = *(const float4*)(cw + j * 768 + ch8 * 8 + 4);
        acc[0] += x[0] * w0.x; acc[1] += x[1] * w0.y; acc[2] += x[2] * w0.z; acc[3] += x[3] * w0.w;
        acc[4] += x[4] * w1.x; acc[5] += x[5] * w1.y; acc[6] += x[6] * w1.z; acc[7] += x[7] * w1.w;
      }
      float ss = 0.f;
#pragma unroll
      for (int e = 0; e < 8; ++e) { acc[e] = siluf(acc[e]); ss += acc[e] * acc[e]; }
      ss += __shfl_xor(ss, 1); ss += __shfl_xor(ss, 2); ss += __shfl_xor(ss, 4);
      const int grp = ch8 >> 3;
      const float sc = grp < 8 ? rsqrtf(ss + 1e-6f) * (grp < 4 ? 0.125f : 1.f) : 1.f;
#pragma unroll
      for (int e = 0; e < 8; ++e) acc[e] *= sc;
      *(u32x4*)(QKVB + (size_t)row * 768 + ch8 * 8) = pack8(acc);
    }
  }
  const float* graw = (const float*)(p.ws + O_GRAW);
  float* g2 = (float*)(p.ws + O_G2);
  for (int e = tid; e < 64 * 8; e += 256) {
    int ri = e >> 3, dh = e & 7, dir = dh >> 2, hh = dh & 3;
    int row = m0 + ri;
    float ra = graw[(size_t)row * 16 + dir * 8 + hh], rb = graw[(size_t)row * 16 + dir * 8 + 4 + hh];
    float xx = ra + p.dn_dt_bias[layer * 8 + dh];
    float sp = xx > 20.f ? xx : log1pf(expf(xx));
    float lg = -expf(p.dn_a_log[layer * 8 + dh]) * sp;
    float beta = 1.f / (1.f + expf(-rb));
    g2[(size_t)row * 16 + dh] = lg;
    g2[(size_t)row * 16 + 8 + dh] = beta;
  }
}

DI void prep_mla(const Params& p, int layer, int tm, int which, int nt, char* lds) {
  int tid_ = VTID;
  asm volatile("" : "+v"(tid_));
  const int tid = tid_;
  const u16* Z = (const u16*)(p.ws + O_Z);
  const int m0 = tm * 256;
  float* rs = (float*)(lds + 128 * CSL * 4);
  const int KK = which == 0 ? 256 : 128;
  const int cbase = which == 0 ? C_DCQ : C_DCKV;
  __syncthreads();
  {
    const u16* src = Z + (size_t)(m0 + tid) * ZW + cbase;
    float s = 0.f;
    for (int i = 0; i < KK / 8; i += 4) {
      u32x4 u0 = ldg16(src + i * 8), u1 = ldg16(src + i * 8 + 8), u2 = ldg16(src + i * 8 + 16), u3 = ldg16(src + i * 8 + 24);
      float f[8];
      unpack8(u0, f);
#pragma unroll
      for (int e = 0; e < 8; ++e) s += f[e] * f[e];
      unpack8(u1, f);
#pragma unroll
      for (int e = 0; e < 8; ++e) s += f[e] * f[e];
      unpack8(u2, f);
#pragma unroll
      for (int e = 0; e < 8; ++e) s += f[e] * f[e];
      unpack8(u3, f);
#pragma unroll
      for (int e = 0; e < 8; ++e) s += f[e] * f[e];
    }
    rs[tid] = rsqrtf(s / (float)KK + 1e-6f);
  }
  const u16* Bt = which == 0 ? (const u16*)(p.ws + O_WUQ + layer * SZ_WUQ) + (size_t)nt * 128 * 256
                             : (const u16*)(p.ws + O_WUKV + layer * SZ_WUKV) + (size_t)nt * 128 * 128;
  const float* Cs = (const float*)lds;
  const float2* tab = (const float2*)(p.ws + O_TAB);
  gemm_tile(Z + (size_t)m0 * ZW + cbase, ZW, Bt, KK, KK, lds, [&](int half) {
    if (which == 0) {
      u16* QD = (u16*)(p.ws + O_QD);
      const float qs = 0.10206207261596575f * LOG2E;
      for (int idx = tid; idx < 128 * 32; idx += 256) {
        const int rr = idx >> 5, c4 = (idx & 31) * 4;
        const int row = m0 + half * 128 + rr;
        const float sc = rs[half * 128 + rr] * qs;
        float o[4];
#pragma unroll
        for (int j = 0; j < 4; ++j) {
          int cl = c4 + j, c = nt * 128 + cl, d = c % 96;
          float v = Cs[rr * CSL + cl];
          if (d >= 64 && row < NLAT) {
            int i = d - 64;
            if (i < 16) {
              float2 t = tab[(row & 4095) * 64 + 48 + i];
              float x2 = Cs[rr * CSL + cl + 16];
              v = v * t.x - x2 * t.y;
            } else {
              float2 t = tab[(row & 4095) * 64 + 48 + i - 16];
              float x1 = Cs[rr * CSL + cl - 16];
              v = x1 * t.y + v * t.x;
            }
          }
          o[j] = v * sc;
        }
        uint2 w;
        w.x = pack2(o[0], o[1]); w.y = pack2(o[2], o[3]);
        *(uint2*)(QD + (size_t)row * 384 + nt * 128 + c4) = w;
      }
    } else {
      u16* KVD = (u16*)(p.ws + O_KVD);
      for (int idx = tid; idx < 128 * 32; idx += 256) {
        const int rr = idx >> 5, c4 = (idx & 31) * 4;
        const int row = m0 + half * 128 + rr;
        const float sc = rs[half * 128 + rr];
        float4 v = *(const float4*)(Cs + rr * CSL + c4);
        uint2 w;
        w.x = pack2(v.x * sc, v.y * sc); w.y = pack2(v.z * sc, v.w * sc);
        *(uint2*)(KVD + (size_t)row * KVP + nt * 128 + c4) = w;
      }
    }
  });
  if (which == 1 && nt == 0) {
    u16* KR = (u16*)(p.ws + O_KR);
    for (int e = tid; e < 256 * 16; e += 256) {
      int rr = e >> 4, i = e & 15, row = m0 + rr;
      float cs = 1.f, sn = 0.f;
      if (row < NLAT) { float2 t = tab[(row & 4095) * 64 + 48 + i]; cs = t.x; sn = t.y; }
      float x1 = bf2f(Z[(size_t)row * ZW + C_DKR + i]), x2 = bf2f(Z[(size_t)row * ZW + C_DKR + 16 + i]);
      KR[(size_t)row * 32 + i] = f2bf(x1 * cs - x2 * sn);
      KR[(size_t)row * 32 + 16 + i] = f2bf(x1 * sn + x2 * cs);
    }
  }
}

DI void prep_phase(const Params& p, int layer, char* lds) {
  const int total = 3264 + 816 + 1088;
  for (int t = VB; t < total; t += VG) {
    if (t < 1088) prep_swa(p, t);
    else if (t < 2176) prep_ret(p, t - 1088);
    else if (t < 3264) prep_dn(p, layer, t - 2176, lds);
    else if (t < 3264 + 816) { int q = t - 3264; prep_mla(p, layer, q / 3, 0, q % 3, lds); }
    else { int q = t - 3264 - 816; prep_mla(p, layer, q / 4, 1, q % 4, lds); }
  }
}

struct Seg {
  const u16* k; const u16* k2; const u16* v;
  int ldk, ldk2, ldv, n, pos0, masked;
};

template <int DQK>
DI void attn_tile(const u16* __restrict__ q, int ldq, int qpos0, const Seg& s0, const Seg& s1, int nseg, bool has_sink,
                  float sinkl2, u16* __restrict__ out, int ldo, char* lds) {
  constexpr int KST = DQK + 8;
  constexpr int CPK = DQK / 8;
  constexpr int NKS = DQK / 16;
  constexpr int VST = 96;
  u16* Ks = (u16*)lds;
  u16* Vs = Ks + 64 * KST;
  int ltid_ = threadIdx.x;
  asm volatile("" : "+v"(ltid_));
  const int ltid = ltid_;
  const int tid = ltid & 255, wave = tid >> 6, lane = tid & 63, r = lane & 31, h = lane >> 5;
  const int qi = wave * 32 + r;
  bf16x8 qf[NKS];
#pragma unroll
  for (int ks = 0; ks < NKS; ++ks) qf[ks] = *(const bf16x8*)(q + (size_t)qi * ldq + ks * 16 + 8 * h);
  const int nt0 = s0.n >> 6;
  const int NT = nt0 + (nseg > 1 ? (s1.n >> 6) : 0);
  uint4 kreg0, kreg1 = make_uint4(0, 0, 0, 0), vreg0;
  uint4 krgB0, krgB1 = make_uint4(0, 0, 0, 0), vrgB0;
  const int kkey0 = ltid / CPK, kpart0 = ltid % CPK;
  const int kkey1 = (ltid + 512) / CPK, kpart1 = (ltid + 512) % CPK;
  const bool k1 = (CPK == 12) && (ltid < 256);
  const int vkey = ltid >> 3, vpart = ltid & 7;
  typedef __attribute__((address_space(3))) const char* lds_cptr;
  typedef short v4i16_t __attribute__((ext_vector_type(4)));
  const lds_cptr vp0 = (lds_cptr)Vs + (4 * h + ((lane & 15) >> 2)) * (VST * 2) + ((lane >> 4) & 1) * 32 + (lane & 3) * 8;
#define ATT_VTR(p) __builtin_bit_cast(s16x4, __builtin_amdgcn_ds_read_tr16_b64_v4i16((__attribute__((address_space(3))) v4i16_t*)(p)))
#define ATT_KSRC(sg, off, key, part) \
  (((part) < 8) ? (sg).k + (size_t)((off) + (key)) * (sg).ldk + (part) * 8 : (sg).k2 + (size_t)((off) + (key)) * (sg).ldk2 + ((part) - 8) * 8)
#define ATT_LOADX(i, K0, K1, V0)                                                            \
  {                                                                                         \
    const Seg& sgl = ((i) < nt0) ? s0 : s1;                                                 \
    const int offl = (((i) < nt0) ? (i) : (i) - nt0) << 6;                                  \
    K0 = *(const uint4*)ATT_KSRC(sgl, offl, kkey0, kpart0);                                 \
    if (k1) K1 = *(const uint4*)ATT_KSRC(sgl, offl, kkey1, kpart1);                         \
    V0 = *(const uint4*)(sgl.v + (size_t)(offl + vkey) * sgl.ldv + vpart * 8);              \
  }
  f32x16 o0 = zero16(), o1 = zero16();
  float m = -1e30f, l = 0.f;
#define ATT_STOREX(K0, K1, V0)                                               \
  {                                                                           \
    *(uint4*)(Ks + kkey0 * KST + kpart0 * 8) = K0;                            \
    if (k1) *(uint4*)(Ks + kkey1 * KST + kpart1 * 8) = K1;                    \
    *(uint4*)(Vs + vkey * VST + vpart * 8) = V0;                              \
  }
  auto compute = [&](int i) {
    const Seg& sg = (i < nt0) ? s0 : s1;
    const int off = ((i < nt0) ? i : i - nt0) << 6;
    f32x16 sa = zero16(), sb = zero16();
#pragma unroll
    for (int ks = 0; ks < NKS; ++ks) {
      bf16x8 a0 = *(const bf16x8*)(Ks + r * KST + ks * 16 + 8 * h);
      bf16x8 a1 = *(const bf16x8*)(Ks + (32 + r) * KST + ks * 16 + 8 * h);
      sa = MFMA(a0, qf[ks], sa);
      sb = MFMA(a1, qf[ks], sb);
    }
    if (sg.masked) {
      const int qpos = qpos0 + qi;
      const int kb = sg.pos0 + off;
#pragma unroll
      for (int g = 0; g < 16; ++g) {
        int d0 = kb + crow(g, h) - qpos, d1 = d0 + 32;
        if (d0 > 128 || d0 < -128) sa[g] = -INFINITY;
        if (d1 > 128 || d1 < -128) sb[g] = -INFINITY;
      }
    }
    float mx = sa[0];
#pragma unroll
    for (int g = 1; g < 16; ++g) mx = fmaxf(mx, sa[g]);
#pragma unroll
    for (int g = 0; g < 16; ++g) mx = fmaxf(mx, sb[g]);
    mx = fmaxf(mx, __shfl_xor(mx, 32));
    const float mn = fmaxf(m, mx);
    const float alpha = __builtin_amdgcn_exp2f(m - mn);
    m = mn;
    float ps = 0.f;
#pragma unroll
    for (int g = 0; g < 16; ++g) { sa[g] = __builtin_amdgcn_exp2f(sa[g] - mn); ps += sa[g]; }
#pragma unroll
    for (int g = 0; g < 16; ++g) { sb[g] = __builtin_amdgcn_exp2f(sb[g] - mn); ps += sb[g]; }
    l = l * alpha + ps;
#pragma unroll
    for (int g = 0; g < 16; ++g) { o0[g] *= alpha; o1[g] *= alpha; }
#pragma unroll
    for (int kt = 0; kt < 2; ++kt) {
#pragma unroll
      for (int s = 0; s < 2; ++s) {
        const f32x16& sv = kt == 0 ? sa : sb;
        uint4 pu;
        pu.x = pack2(sv[8 * s + 0], sv[8 * s + 1]); pu.y = pack2(sv[8 * s + 2], sv[8 * s + 3]);
        pu.z = pack2(sv[8 * s + 4], sv[8 * s + 5]); pu.w = pack2(sv[8 * s + 6], sv[8 * s + 7]);
        bf16x8 pf = __builtin_bit_cast(bf16x8, pu);
        const lds_cptr vp = vp0 + (kt * 32 + 16 * s) * (VST * 2);
        {
          s16x4 lo = ATT_VTR(vp);
          s16x4 hi = ATT_VTR(vp + 8 * VST * 2);
          bf16x8 vf = __builtin_shufflevector(lo, hi, 0, 1, 2, 3, 4, 5, 6, 7);
          o0 = MFMA(vf, pf, o0);
        }
        {
          s16x4 lo = ATT_VTR(vp + 64);
          s16x4 hi = ATT_VTR(vp + 8 * VST * 2 + 64);
          bf16x8 vf = __builtin_shufflevector(lo, hi, 0, 1, 2, 3, 4, 5, 6, 7);
          o1 = MFMA(vf, pf, o1);
        }
      }
    }
  };
  ATT_LOADX(0, kreg0, kreg1, vreg0);
  ATT_LOADX(1, krgB0, krgB1, vrgB0);
  for (int i = 0; i < NT; i += 2) {
    __syncthreads();
    ATT_STOREX(kreg0, kreg1, vreg0);
    __syncthreads();
    if (i + 2 < NT) ATT_LOADX(i + 2, kreg0, kreg1, vreg0);
    compute(i);
    __syncthreads();
    ATT_STOREX(krgB0, krgB1, vrgB0);
    __syncthreads();
    if (i + 3 < NT) ATT_LOADX(i + 3, krgB0, krgB1, vrgB0);
    compute(i + 1);
  }
  float lt = l + __shfl_xor(l, 32);
  if (has_sink) lt += __builtin_amdgcn_exp2f(sinkl2 - m);
  const float inv = 1.f / lt;
#pragma unroll
  for (int g = 0; g < 4; ++g) {
    uint2 w;
    w.x = pack2(o0[4 * g] * inv, o0[4 * g + 1] * inv); w.y = pack2(o0[4 * g + 2] * inv, o0[4 * g + 3] * inv);
    *(uint2*)(out + (size_t)qi * ldo + 8 * g + 4 * h) = w;
    w.x = pack2(o1[4 * g] * inv, o1[4 * g + 1] * inv); w.y = pack2(o1[4 * g + 2] * inv, o1[4 * g + 3] * inv);
    *(uint2*)(out + (size_t)qi * ldo + 32 + 8 * g + 4 * h) = w;
  }
}

DI void mla_attn(const Params& p, int idx, char* lds) {
  const u16* QD = (const u16*)(p.ws + O_QD);
  const u16* KVD = (const u16*)(p.ws + O_KVD);
  const u16* KR = (const u16*)(p.ws + O_KR);
  u16* act = (u16*)(p.ws + O_ACT);
  Seg lat, cx;
  int b, hh, row0;
  bool is_ctx = idx >= 2048;
  if (!is_ctx) { b = idx >> 7; hh = (idx >> 5) & 3; row0 = b * TT + (idx & 31) * 128; }
  else { int q = idx - 2048; b = q >> 3; hh = (q >> 1) & 3; row0 = NLAT + b * LC + (q & 1) * 128; }
  const size_t lr = (size_t)b * TT, cr = (size_t)NLAT + b * LC;
  lat.k = KVD + lr * KVP + hh * 128; lat.ldk = KVP; lat.k2 = KR + lr * 32; lat.ldk2 = 32; lat.v = KVD + lr * KVP + hh * 128 + 64;
  lat.ldv = KVP; lat.n = TT; lat.pos0 = 0; lat.masked = 0;
  cx.k = KVD + cr * KVP + hh * 128; cx.ldk = KVP; cx.k2 = KR + cr * 32; cx.ldk2 = 32; cx.v = KVD + cr * KVP + hh * 128 + 64;
  cx.ldv = KVP; cx.n = LC; cx.pos0 = 0; cx.masked = 0;
  const u16* q = QD + (size_t)row0 * 384 + hh * 96;
  u16* o = act + (size_t)row0 * AP + 768 + hh * 64;
  if (!is_ctx) attn_tile<96>(q, 384, 0, lat, cx, 2, false, 0.f, o, AP, lds);
  else attn_tile<96>(q, 384, 0, cx, cx, 1, false, 0.f, o, AP, lds);
}

DI void swa_attn(const Params& p, int layer, int idx, char* lds) {
  const u16* QA = (const u16*)(p.ws + O_QA);
  const u16* KA = (const u16*)(p.ws + O_KA);
  const u16* Z = (const u16*)(p.ws + O_Z);
  u16* act = (u16*)(p.ws + O_ACT);
  Seg loc, cx;
  int b, hh, row0, pos0q;
  bool is_ctx = idx >= 2048;
  int nb = 0;
  if (!is_ctx) { b = idx >> 7; hh = ((idx >> 6) & 1) * 2 + (idx & 1); nb = (idx >> 1) & 31; pos0q = nb * 128; row0 = b * TT + pos0q; }
  else { int q = idx - 2048; b = q >> 3; hh = (q >> 1) & 3; pos0q = TT + (q & 1) * 128; row0 = NLAT + b * LC + (q & 1) * 128; }
  const int hk = hh >> 1;
  const u16* kbase = KA + (size_t)(b * 2 + hk) * NPOS * 64;
  cx.k = kbase + (size_t)TT * 64; cx.ldk = 64; cx.k2 = cx.k; cx.ldk2 = 64;
  cx.v = Z + ((size_t)NLAT + b * LC) * ZW + C_AV + hk * 64; cx.ldv = ZW; cx.n = LC; cx.pos0 = 0; cx.masked = 0;
  const float sinkl2 = p.swa_sink[layer * 4 + hh] * LOG2E;
  const u16* q = QA + ((size_t)(b * 4 + hh) * NPOS + pos0q) * 64;
  u16* o = act + (size_t)row0 * AP + hh * 64;
  if (!is_ctx) {
    int ks = nb * 128 - 128; if (ks < 0) ks = 0;
    int ke = nb * 128 + 256; if (ke > TT) ke = TT;
    loc.k = kbase + (size_t)ks * 64; loc.ldk = 64; loc.k2 = loc.k; loc.ldk2 = 64;
    loc.v = Z + ((size_t)b * TT + ks) * ZW + C_AV + hk * 64; loc.ldv = ZW; loc.n = ke - ks; loc.pos0 = ks; loc.masked = 1;
    attn_tile<64>(q, 64, pos0q, loc, cx, 2, true, sinkl2, o, AP, lds);
  } else {
    attn_tile<64>(q, 64, 0, cx, cx, 1, true, sinkl2, o, AP, lds);
  }
}

constexpr int LS = 72;
template <int KS>
DI f32x16 mm64(const u16* A, int lda, const u16* Bt, int ldb, int wm, int wn, int r, int h) {
  f32x16 acc = zero16();
#pragma unroll
  for (int s = 0; s < KS; ++s) {
    bf16x8 a = *(const bf16x8*)(A + (wm * 32 + r) * lda + s * 16 + 8 * h);
    bf16x8 b = *(const bf16x8*)(Bt + (wn * 32 + r) * ldb + s * 16 + 8 * h);
    acc = MFMA(a, b, acc);
  }
  return acc;
}
DI void st_straight(u16* D, int ld, const f32x16& v, int wm, int wn, int r, int h) {
#pragma unroll
  for (int g = 0; g < 16; ++g) D[(wm * 32 + crow(g, h)) * ld + wn * 32 + r] = f2bf(v[g]);
}
DI void st_transp(u16* D, int ld, const f32x16& v, int wm, int wn, int r, int h) {
#pragma unroll
  for (int g = 0; g < 4; ++g) {
    uint2 w;
    w.x = pack2(v[4 * g], v[4 * g + 1]); w.y = pack2(v[4 * g + 2], v[4 * g + 3]);
    *(uint2*)(D + (wn * 32 + r) * ld + wm * 32 + 8 * g + 4 * h) = w;
  }
}

template <int KS>
DI f32x16 mm64t(const u16* AT, int lda, const u16* Bt, int ldb, int wm, int wn, int r, int h, int lane) {
  typedef __attribute__((address_space(3))) const char* lds_cptr;
  typedef short v4i16_t __attribute__((ext_vector_type(4)));
  const lds_cptr base = (lds_cptr)AT + ((lane & 15) >> 2) * (lda * 2) + (wm * 32 + ((lane >> 4) & 1) * 16) * 2 + (lane & 3) * 8;
  f32x16 acc = zero16();
#pragma unroll
  for (int s = 0; s < KS; ++s) {
    s16x4 lo = __builtin_bit_cast(s16x4, __builtin_amdgcn_ds_read_tr16_b64_v4i16((__attribute__((address_space(3))) v4i16_t*)(base + (16 * s + 8 * h) * (lda * 2))));
    s16x4 hi = __builtin_bit_cast(s16x4, __builtin_amdgcn_ds_read_tr16_b64_v4i16((__attribute__((address_space(3))) v4i16_t*)(base + (16 * s + 8 * h + 4) * (lda * 2))));
    bf16x8 a = __builtin_shufflevector(lo, hi, 0, 1, 2, 3, 4, 5, 6, 7);
    bf16x8 b = *(const bf16x8*)(Bt + (wn * 32 + r) * ldb + s * 16 + 8 * h);
    acc = MFMA(a, b, acc);
  }
  return acc;
}

template <int KS, bool ATR, bool BTR>
DI f32x16 mm64x(const u16* A, int lda, const u16* B, int ldb, int wm, int wn, int r, int h, int lane) {
  typedef __attribute__((address_space(3))) const char* lds_cptr;
  typedef short v4i16_t __attribute__((ext_vector_type(4)));
  const int sub = ((lane & 15) >> 2), cb = ((lane >> 4) & 1) * 16, pb = (lane & 3) * 8;
  const lds_cptr abase = (lds_cptr)A + sub * (lda * 2) + (wm * 32 + cb) * 2 + pb;
  const lds_cptr bbase = (lds_cptr)B + sub * (ldb * 2) + (wn * 32 + cb) * 2 + pb;
  f32x16 acc = zero16();
#pragma unroll
  for (int s = 0; s < KS; ++s) {
    bf16x8 a, b;
    if (ATR) {
      s16x4 lo = __builtin_bit_cast(s16x4, __builtin_amdgcn_ds_read_tr16_b64_v4i16((__attribute__((address_space(3))) v4i16_t*)(abase + (16 * s + 8 * h) * (lda * 2))));
      s16x4 hi = __builtin_bit_cast(s16x4, __builtin_amdgcn_ds_read_tr16_b64_v4i16((__attribute__((address_space(3))) v4i16_t*)(abase + (16 * s + 8 * h + 4) * (lda * 2))));
      a = __builtin_shufflevector(lo, hi, 0, 1, 2, 3, 4, 5, 6, 7);
    } else {
      a = *(const bf16x8*)(A + (wm * 32 + r) * lda + s * 16 + 8 * h);
    }
    if (BTR) {
      s16x4 lo = __builtin_bit_cast(s16x4, __builtin_amdgcn_ds_read_tr16_b64_v4i16((__attribute__((address_space(3))) v4i16_t*)(bbase + (16 * s + 8 * h) * (ldb * 2))));
      s16x4 hi = __builtin_bit_cast(s16x4, __builtin_amdgcn_ds_read_tr16_b64_v4i16((__attribute__((address_space(3))) v4i16_t*)(bbase + (16 * s + 8 * h + 4) * (ldb * 2))));
      b = __builtin_shufflevector(lo, hi, 0, 1, 2, 3, 4, 5, 6, 7);
    } else {
      b = *(const bf16x8*)(B + (wn * 32 + r) * ldb + s * 16 + 8 * h);
    }
    acc = MFMA(a, b, acc);
  }
  return acc;
}
DI void st8s(u16* dst, const uint4& v, float f) {
  uint4 o;
  o.x = pack2(bflo(v.x) * f, bfhi(v.x) * f); o.y = pack2(bflo(v.y) * f, bfhi(v.y) * f);
  o.z = pack2(bflo(v.z) * f, bfhi(v.z) * f); o.w = pack2(bflo(v.w) * f, bfhi(v.w) * f);
  *(uint4*)dst = o;
}

DI void dn_chain(const Params& p, int chain, char* lds) {
  int tid_ = VTID;
  asm volatile("" : "+v"(tid_));
  const int tid = tid_, wave = tid >> 6, lane = tid & 63, r = lane & 31, h = lane >> 5;
  const int wm = wave >> 1, wn = wave & 1;
  const int b = chain >> 3, hh = (chain >> 1) & 3, dir = chain & 1;
  u16* kA = (u16*)lds;
  u16* St = kA + 64 * LS;
  u16* R1 = St + 64 * LS;
  u16* R2 = R1 + 64 * LS;
  u16* R3 = R2 + 64 * LS;
  u16* R4 = R3 + 64 * LS;
  u16* R5 = R4 + 64 * LS;
  float* gc = (float*)(R5 + 64 * LS);
  float* bt = gc + 64;
  const u16* QKVB = (const u16*)(p.ws + O_QKVB);
  const float* G2 = (const float*)(p.ws + O_G2);
  u16* OUT = dir ? (u16*)(p.ws + O_OB) : (u16*)(p.ws + O_ACT) + 256;
  const int opitch = dir ? 256 : AP;
  __syncthreads();
  for (int e = tid; e < 64 * LS / 2; e += 256) ((u32*)St)[e] = 0u;
  f32x16 S = zero16();
  const int lc = tid >> 3, lp = (tid & 7) * 8;
  auto rowof = [&](int n, int c) -> int {
    int cn, base, len;
    if (n < 4) { cn = n; base = NLAT + b * LC; len = LC; } else { cn = n - 4; base = b * TT; len = TT; }
    int pos = cn * 64 + c;
    return base + (dir ? len - 1 - pos : pos);
  };
  uint4 pk0, pk1, pq0, pq1, pv0, pv1;
  float pg = 0.f, pb = 0.f;
#define DN_LOAD(n)                                                                      \
  {                                                                                     \
    const u16* s0_ = QKVB + (size_t)rowof((n), lc) * 768 + hh * 64 + lp;                \
    const u16* s1_ = QKVB + (size_t)rowof((n), lc + 32) * 768 + hh * 64 + lp;           \
    pq0 = *(const uint4*)s0_; pk0 = *(const uint4*)(s0_ + 256); pv0 = *(const uint4*)(s0_ + 512); \
    pq1 = *(const uint4*)s1_; pk1 = *(const uint4*)(s1_ + 256); pv1 = *(const uint4*)(s1_ + 512); \
    if (tid < 64) {                                                                     \
      const float* g_ = G2 + (size_t)rowof((n), tid) * 16 + dir * 4 + hh;               \
      pg = g_[0]; pb = g_[8];                                                           \
    }                                                                                   \
  }
  DN_LOAD(0);
  for (int n = 0; n < 68; ++n) {
    const uint4 ck0 = pk0, ck1 = pk1, cq0 = pq0, cq1 = pq1, cv0 = pv0, cv1 = pv1;
    float cgv = pg, cbv = pb;
    __syncthreads();
    if (tid < 64) {
      float v = cgv;
#pragma unroll
      for (int o = 1; o < 64; o <<= 1) { float t = __shfl_up(v, o); if (lane >= o) v += t; }
      gc[tid] = v; bt[tid] = cbv;
    }
    *(uint4*)(kA + lc * LS + lp) = ck0;
    *(uint4*)(kA + (lc + 32) * LS + lp) = ck1;
    if (n + 1 < 68) DN_LOAD(n + 1);
    __syncthreads();
    const float gl = gc[63];
    f32x16 T;
    {
      f32x16 kk = mm64<4>(kA, LS, kA, LS, wm, wn, r, h);
      const int s = wn * 32 + r;
      const float gs = gc[s];
#pragma unroll
      for (int g = 0; g < 16; ++g) {
        int c = wm * 32 + crow(g, h);
        float v = (s < c) ? bt[c] * kk[g] * __expf(gc[c] - gs) : 0.f;
        kk[g] = v;
        T[g] = (c == s) ? 1.f : (((c >> 1) == (s >> 1)) ? -v : 0.f);
      }
      st_transp(R1, LS, kk, wm, wn, r, h);
      st_transp(R2, LS, T, wm, wn, r, h);
    }
    __syncthreads();
    for (int k = 1; k < 6; ++k) {
      f32x16 M = mm64t<4>(R1, LS, R2, LS, wm, wn, r, h, lane);
      st_transp(R4, LS, M, wm, wn, r, h);
      __syncthreads();
      f32x16 X = mm64t<4>(R2, LS, R4, LS, wm, wn, r, h, lane);
      {
        const int s = wn * 32 + r;
#pragma unroll
        for (int g = 0; g < 16; ++g) {
          int c = wm * 32 + crow(g, h);
          if ((c >> (k + 1)) == (s >> (k + 1)) && (c >> k) != (s >> k)) T[g] -= X[g];
        }
      }
      __syncthreads();
      st_transp(R2, LS, T, wm, wn, r, h);
      __syncthreads();
    }
    {
      const float fb0 = bt[lc], fk0 = fb0 * __expf(gc[lc]);
      const float fb1 = bt[lc + 32], fk1 = fb1 * __expf(gc[lc + 32]);
      st8s(R1 + lc * LS + lp, ck0, fk0);
      st8s(R1 + (lc + 32) * LS + lp, ck1, fk1);
      st8s(R3 + lc * LS + lp, cv0, fb0);
      st8s(R3 + (lc + 32) * LS + lp, cv1, fb1);
    }
    __syncthreads();
    f32x16 W = mm64x<4, true, true>(R2, LS, R1, LS, wm, wn, r, h, lane);
    f32x16 U = mm64x<4, true, true>(R2, LS, R3, LS, wm, wn, r, h, lane);
    st_transp(R4, LS, W, wm, wn, r, h);
    __syncthreads();
    {
      f32x16 ws = mm64t<4>(R4, LS, St, LS, wm, wn, r, h, lane);
#pragma unroll
      for (int g = 0; g < 16; ++g) U[g] -= ws[g];
      st_transp(R1, LS, U, wm, wn, r, h);
    }
    *(uint4*)(R2 + lc * LS + lp) = cq0;
    *(uint4*)(R2 + (lc + 32) * LS + lp) = cq1;
    st8s(R5 + lc * LS + lp, ck0, __expf(gl - gc[lc]));
    st8s(R5 + (lc + 32) * LS + lp, ck1, __expf(gl - gc[lc + 32]));
    __syncthreads();
    {
      f32x16 qk = mm64<4>(R2, LS, kA, LS, wm, wn, r, h);
      const int s = wn * 32 + r;
      const float gs = gc[s];
#pragma unroll
      for (int g = 0; g < 16; ++g) {
        int c = wm * 32 + crow(g, h);
        qk[g] = (s <= c) ? qk[g] * __expf(gc[c] - gs) : 0.f;
      }
      st_transp(R3, LS, qk, wm, wn, r, h);
    }
    __syncthreads();
    {
      f32x16 o1 = mm64<4>(R2, LS, St, LS, wm, wn, r, h);
      f32x16 o2 = mm64t<4>(R3, LS, R1, LS, wm, wn, r, h, lane);
      f32x16 sn = mm64x<4, true, false>(R5, LS, R1, LS, wm, wn, r, h, lane);
      const float egl = __expf(gl);
#pragma unroll
      for (int g = 0; g < 16; ++g) {
        int c = wm * 32 + crow(g, h);
        float ov = o1[g] * __expf(gc[c]) + o2[g];
        OUT[(size_t)rowof(n, c) * opitch + hh * 64 + wn * 32 + r] = f2bf(ov);
        S[g] = S[g] * egl + sn[g];
      }
    }
    __syncthreads();
    st_transp(St, LS, S, wm, wn, r, h);
  }
}

DI void ret_chain(const Params& p, int layer, int chain, char* lds) {
  int tid_ = VTID;
  asm volatile("" : "+v"(tid_));
  const int tid = tid_, wave = tid >> 6, lane = tid & 63, r = lane & 31, h = lane >> 5;
  const int wm = wave >> 1, wn = wave & 1;
  const int b = chain >> 2, hh = chain & 3;
  constexpr int L4 = 40;
  u16* qA = (u16*)lds;
  u16* kA = qA + 64 * L4;
  u16* kT = kA + 64 * L4;
  u16* vT = kT + 64 * LS;
  u16* QK = vT + 64 * LS;
  u16* Rt = QK + 64 * LS;
  float* Ot = (float*)(Rt + 64 * L4);
  const u16* QC = (const u16*)(p.ws + O_QC);
  const u16* KC = (const u16*)(p.ws + O_KC);
  const u16* Z = (const u16*)(p.ws + O_Z);
  u16* act = (u16*)(p.ws + O_ACT);
  const int lc = tid >> 2, lp4 = (tid & 3) * 8;
  const int vc = tid >> 3, vp = (tid & 7) * 8;
  for (int dir = 0; dir < 2; ++dir) {
    const float lg = log1pf(-expf(p.ret_l1m[layer * 8 + dir * 4 + hh]));
    __syncthreads();
    for (int e = tid; e < 64 * L4 / 2; e += 256) ((u32*)Rt)[e] = 0u;
    for (int e = tid; e < 64 * LS / 2; e += 256) ((u32*)kT)[e] = 0u;
    f32x16 R = zero16();
    auto rowof = [&](int n, int c) -> int {
      int cn, base, len;
      if (n < 4) { cn = n; base = NLAT + b * LC; len = LC; } else { cn = n - 4; base = b * TT; len = TT; }
      int pos = cn * 64 + c;
      return base + (dir ? len - 1 - pos : pos);
    };
    uint4 pq, pk, pv0, pv1;
#define RET_LOAD(n)                                                                                   \
  {                                                                                                   \
    const int row_ = rowof((n), lc);                                                                  \
    pq = *(const uint4*)(QC + (size_t)row_ * 128 + hh * 32 + lp4);                                    \
    pk = *(const uint4*)(KC + (size_t)row_ * 128 + hh * 32 + lp4);                                    \
    pv0 = *(const uint4*)(Z + (size_t)rowof((n), vc) * ZW + C_CV + hh * 64 + vp);                     \
    pv1 = *(const uint4*)(Z + (size_t)rowof((n), vc + 32) * ZW + C_CV + hh * 64 + vp);                \
  }
    RET_LOAD(0);
    for (int n = 0; n < 68; ++n) {
      __syncthreads();
      *(uint4*)(qA + lc * L4 + lp4) = pq;
      *(uint4*)(kA + lc * L4 + lp4) = pk;
      scat8s(kT + lp4 * LS + lc, LS, pk, __expf((float)(63 - lc) * lg));
      scat8r(vT + vp * LS + vc, LS, pv0);
      scat8r(vT + vp * LS + vc + 32, LS, pv1);
      if (n + 1 < 68) RET_LOAD(n + 1);
      u16 gt[16], orf[16];
#pragma unroll
      for (int ci = 0; ci < 16; ++ci) gt[ci] = Z[(size_t)rowof(n, wave * 16 + ci) * ZW + C_CG + hh * 64 + lane];
#pragma unroll
      for (int g = 0; g < 16; ++g) orf[g] = act[(size_t)rowof(n, wm * 32 + crow(g, h)) * AP + 512 + hh * 64 + wn * 32 + r];
      __syncthreads();
      {
        f32x16 qk = mm64<2>(qA, L4, kA, L4, wm, wn, r, h);
        const int s = wn * 32 + r;
#pragma unroll
        for (int g = 0; g < 16; ++g) {
          int c = wm * 32 + crow(g, h);
          qk[g] = (s <= c) ? qk[g] * __expf((float)(c - s) * lg) : 0.f;
        }
        st_straight(QK, LS, qk, wm, wn, r, h);
      }
      __syncthreads();
      {
        f32x16 o1 = mm64<4>(QK, LS, vT, LS, wm, wn, r, h);
        f32x16 o2 = mm64<2>(qA, L4, Rt, L4, wm, wn, r, h);
        f32x16 rn = mm64<4>(kT, LS, vT, LS, wm, wn, r, h);
        const float gch = __expf(64.f * lg);
#pragma unroll
        for (int g = 0; g < 16; ++g) {
          int c = wm * 32 + crow(g, h);
          float ov = o1[g] + __expf((float)(c + 1) * lg) * o2[g];
          size_t oi = (size_t)rowof(n, c) * AP + 512 + hh * 64 + wn * 32 + r;
          if (dir == 0) act[oi] = f2bf(ov);
          else Ot[c * 65 + wn * 32 + r] = ov + bf2f(orf[g]);
          R[g] = R[g] * gch + rn[g];
        }
      }
      __syncthreads();
      if (wm == 0) st_transp(Rt, L4, R, wm, wn, r, h);
      if (dir == 1) {
        const float gn = p.ret_norm_g[layer * 256 + hh * 64 + lane];
#pragma unroll
        for (int ci = 0; ci < 16; ++ci) {
          int c = wave * 16 + ci;
          float v = Ot[c * 65 + lane];
          float mean = wave_sum(v) * (1.f / 64.f);
          float d = v - mean;
          float var = wave_sum(d * d) * (1.f / 64.f);
          int row = rowof(n, c);
          float gate = bf2f(gt[ci]);
          act[(size_t)row * AP + 512 + hh * 64 + lane] = f2bf(d * rsqrtf(var + 1e-6f) * gn * siluf(gate));
        }
      }
    }
  }
}

DI void mixer_phase(const Params& p, int layer, char* lds, char* lds_all, int* s_tile) {
  int* cnt = (int*)(p.ws + O_CNT) + layer;
  const int nattn = layer == 0 ? 2176 : 2048;
  const int total = 128 + 64 + 2 * nattn;
  for (;;) {
    __syncthreads();
    if (threadIdx.x == 0) *s_tile = atomicAdd(cnt, 1);
    __syncthreads();
    const int t = 2 * (*s_tile) + VHALF;
    if (t >= total) break;
    if (t < 128) dn_chain(p, t, lds);
    else if (t < 192) ret_chain(p, layer, t - 128, lds);
    else if (t < 192 + nattn) mla_attn(p, t - 192, lds_all);
    else swa_attn(p, layer, t - 192 - nattn, lds_all);
  }
}

DI void dn_finalize(const Params& p, int layer, int nrows) {
  int tid_ = VTID;
  asm volatile("" : "+v"(tid_));
  const int tid = tid_;
  const u16* OB = (const u16*)(p.ws + O_OB);
  const u16* Z = (const u16*)(p.ws + O_Z);
  u16* act = (u16*)(p.ws + O_ACT);
  const int ntask = nrows * 32, stride = VG * 256;
  for (int id0 = VB * 256 + tid; id0 < ntask; id0 += 4 * stride) {
    u32x4 a[4], b[4], z[4];
#pragma unroll
    for (int u = 0; u < 4; ++u) {
      const int id = id0 + u * stride;
      const bool ok = id < ntask;
      const int row = ok ? (id >> 5) : 0, c8 = id & 31;
      a[u] = ldg16(act + (size_t)row * AP + 256 + c8 * 8);
      b[u] = ldg16(OB + (size_t)row * 256 + c8 * 8);
      z[u] = ldg16(Z + (size_t)row * ZW + C_BZ + c8 * 8);
    }
#pragma unroll
    for (int u = 0; u < 4; ++u) {
      const int id = id0 + u * stride;
      const int row = id >> 5, c8 = id & 31;
      float fa[8], fb[8], fz[8], o[8];
      unpack8(a[u], fa); unpack8(b[u], fb); unpack8(z[u], fz);
      float ss = 0.f;
#pragma unroll
      for (int e = 0; e < 8; ++e) { o[e] = fa[e] + fb[e]; ss += o[e] * o[e]; }
      ss += __shfl_xor(ss, 1); ss += __shfl_xor(ss, 2); ss += __shfl_xor(ss, 4);
      const float rn = rsqrtf(ss * (1.f / 64.f) + 1e-6f);
      const float4 g0 = *(const float4*)(p.dn_norm_g + layer * 64 + (c8 & 7) * 8), g1 = *(const float4*)(p.dn_norm_g + layer * 64 + (c8 & 7) * 8 + 4);
      const float gg[8] = {g0.x, g0.y, g0.z, g0.w, g1.x, g1.y, g1.z, g1.w};
#pragma unroll
      for (int e = 0; e < 8; ++e) o[e] = o[e] * rn * gg[e] * siluf(fz[e]);
      if (id < ntask) *(u32x4*)(act + (size_t)row * AP + 256 + c8 * 8) = pack8(o);
    }
  }
}

DI void gbar(const Params& p, unsigned& target) {
  unsigned* bar = (unsigned*)(p.ws + O_CNT + 128);
  target += gridDim.x;
  __syncthreads();
  if (threadIdx.x == 0) {
    __builtin_amdgcn_fence(__ATOMIC_RELEASE, "agent");
    __hip_atomic_fetch_add(bar, 1u, __ATOMIC_RELAXED, __HIP_MEMORY_SCOPE_AGENT);
    while (__hip_atomic_load(bar, __ATOMIC_RELAXED, __HIP_MEMORY_SCOPE_AGENT) < target) __builtin_amdgcn_s_sleep(2);
    __builtin_amdgcn_fence(__ATOMIC_ACQUIRE, "agent");
  }
  __syncthreads();
}

__global__ void __launch_bounds__(512, 2) fwd_megakernel(Params p) {
  __shared__ __attribute__((aligned(16))) char lds_all[2 * LDS_BYTES];
  __shared__ int s_tile;
  char* lds = lds_all + VHALF * LDS_BYTES;
  cg::grid_group grid = cg::this_grid();
  if (p.ws == nullptr) grid.sync();
  unsigned bt = 0;
  phase0a(p, lds);
  gbar(p, bt);
  modulate_rows(p, 0, ROWS);
  gbar(p, bt);
  for (int layer = 0; layer < 2; ++layer) {
    const int nrows = layer == 0 ? ROWS : NLAT;
    gemm_phase(p, layer, 0, ROWS, lds_all);
    gbar(p, bt);
    prep_phase(p, layer, lds);
    gbar(p, bt);
    mixer_phase(p, layer, lds, lds_all, &s_tile);
    gbar(p, bt);
    dn_finalize(p, layer, nrows);
    gbar(p, bt);
    gemm_phase(p, layer, 1, nrows, lds_all);
    gbar(p, bt);
    ln_rows(p, p.ln1_g + layer * DM, p.ln1_b + layer * DM, nrows, layer, 3, true);
    gbar(p, bt);
    gemm_phase(p, layer, 2, nrows, lds_all);
    gbar(p, bt);
    gemm_phase(p, layer, 3, nrows, lds_all);
    gbar(p, bt);
    ln_rows(p, p.ln2_g + layer * DM, p.ln2_b + layer * DM, nrows, layer == 0 ? 1 : 0, 0, layer == 0);
    if (layer == 0) gbar(p, bt);
  }
}

extern "C" void kernel_launch(void* const* d_in, const int* in_sizes, int n_in, void* d_out, int out_size, void* d_ws,
                              size_t ws_size, hipStream_t stream) {
  static int grid_blocks = 0;
  if (!grid_blocks) {
    int dev = 0, cus = 0, per_cu = 0;
    hipGetDevice(&dev);
    hipDeviceGetAttribute(&cus, hipDeviceAttributeMultiprocessorCount, dev);
    hipOccupancyMaxActiveBlocksPerMultiprocessor(&per_cu, fwd_megakernel, 512, 0);
    if (per_cu < 1) per_cu = 1;
    if (per_cu > 1) per_cu = 1;
    grid_blocks = cus * per_cu;
    if (ws_size < WS_END) fprintf(stderr, "kernel_launch: workspace too small: %zu < %zu\n", ws_size, (size_t)WS_END);
  }
  Params p{};
  const float** f = (const float**)&p;
  for (int i = 0; i < 25; ++i) f[i] = (const float*)d_in[i];
  p.out = (float*)d_out;
  p.ws = (unsigned char*)d_ws;
  hipMemsetAsync((char*)d_ws + O_CNT, 0, 256, stream);
  void* args[] = {&p};
  hipError_t e = hipLaunchCooperativeKernel((void*)fwd_megakernel, dim3(grid_blocks), dim3(512), args, 0, stream);
  if (e != hipSuccess) fprintf(stderr, "cooperative launch failed: %s (grid %d)\n", hipGetErrorString(e), grid_blocks);
}
```

```cpp
#include <hip/hip_runtime.h>
#include <hip/hip_cooperative_groups.h>
#include <cstdio>
namespace cg = cooperative_groups;

#define DI __device__ __forceinline__
typedef unsigned short u16;
typedef unsigned int u32;
using bf16x8 = __attribute__((ext_vector_type(8))) short;
using s16x4 = __attribute__((ext_vector_type(4))) short;
using f32x16 = __attribute__((ext_vector_type(16))) float;
typedef __bf16 bfv2 __attribute__((ext_vector_type(2)));
typedef float flv2 __attribute__((ext_vector_type(2)));
#define MFMA(a, b, c) __builtin_amdgcn_mfma_f32_32x32x16_bf16((a), (b), (c), 0, 0, 0)
#define VHALF ((int)__builtin_amdgcn_readfirstlane((int)(threadIdx.x >> 8)))
#define VTID ((int)(threadIdx.x & 255))
#define VB ((int)(blockIdx.x * 2 + VHALF))
#define VG ((int)(gridDim.x * 2))

constexpr int NB = 16, TT = 4096, LC = 256, DM = 1024, NLAT = NB * TT, NCTX = NB * LC, ROWS = NLAT + NCTX;
constexpr int ZW = 2816, DFF = 4096, NPOS = TT + LC;
constexpr int AP = 1152;
constexpr int WP = 1152;
constexpr int WP2 = 4224;
constexpr int HP = 4224;
constexpr int KVP = 576;
constexpr float LOG2E = 1.4426950408889634f;
constexpr float DN_ALPHA = 1.4142135623730951f;
constexpr int C_AQ = 0, C_AK = 256, C_AV = 384, C_BQKV = 512, C_BZ = 1280, C_BAB = 1536, C_CQ = 1552, C_CK = 1680,
              C_CV = 1808, C_CG = 2064, C_DCQ = 2320, C_DCKV = 2576, C_DKR = 2704;

constexpr size_t al256(size_t x) { return (x + 255) & ~size_t(255); }
constexpr size_t SZ_WIN = (size_t)ZW * WP * 2, SZ_WOUT = (size_t)DM * WP * 2, SZ_WFF = (size_t)DFF * WP * 2,
                 SZ_WUQ = 384 * 256 * 2, SZ_WUKV = 512 * 128 * 2;
constexpr size_t O_WIN = 0;
constexpr size_t O_WOUT = O_WIN + 2 * SZ_WIN;
constexpr size_t O_WFF1 = O_WOUT + 2 * SZ_WOUT;
constexpr size_t O_WFF2 = O_WFF1 + 2 * SZ_WFF;
constexpr size_t O_WUQ = O_WFF2 + 2 * SZ_WFF;
constexpr size_t O_WUKV = O_WUQ + 2 * SZ_WUQ;
constexpr size_t O_MOD = O_WUKV + 2 * SZ_WUKV;
constexpr size_t O_TAB = al256(O_MOD + 2 * 17 * 6144 * 4);
constexpr size_t O_CNT = O_TAB + (size_t)TT * 64 * 8;
constexpr size_t O_GRAW = O_CNT + 256;
constexpr size_t O_G2 = O_GRAW + (size_t)ROWS * 16 * 4;
constexpr size_t O_XC = O_G2 + (size_t)ROWS * 16 * 4;
constexpr size_t O_ACT = O_XC + (size_t)NCTX * DM * 4;
constexpr size_t O_Z = O_ACT + (size_t)ROWS * AP * 2;
constexpr size_t O_QA = O_Z + (size_t)ROWS * ZW * 2;
constexpr size_t O_KA = O_QA + (size_t)NB * 4 * NPOS * 64 * 2;
constexpr size_t O_QD = O_KA + (size_t)NB * 2 * NPOS * 64 * 2;
constexpr size_t O_KVD = O_QD + (size_t)ROWS * 384 * 2;
constexpr size_t O_KR = O_KVD + (size_t)ROWS * KVP * 2;
constexpr size_t O_QKVB = O_KR + (size_t)ROWS * 32 * 2;
constexpr size_t O_OB = O_QKVB + (size_t)ROWS * 768 * 2;
constexpr size_t O_QC = O_OB + (size_t)ROWS * 256 * 2;
constexpr size_t O_KC = O_QC + (size_t)ROWS * 128 * 2;
constexpr size_t O_ORB = O_KC + (size_t)ROWS * 128 * 2;
constexpr size_t WS_END = O_ORB + (size_t)ROWS * 256 * 2;
static_assert(O_Z + (size_t)ROWS * HP * 2 <= WS_END, "hid alias");
static_assert((size_t)DM * WP2 * 2 <= SZ_WFF, "ff2 weights");
static_assert(WS_END <= (size_t)1073741824, "workspace");

constexpr int LDS_BYTES = 73728;

struct Params {
  const float *x, *c, *ctx, *c_ctx, *ada_w, *ada_b, *w_in, *swa_sink, *dn_conv_w, *dn_a_log, *dn_dt_bias, *dn_norm_g,
      *ret_l1m, *ret_norm_g, *mla_q_norm, *mla_w_uq, *mla_kv_norm, *mla_w_ukv, *w_out, *ln1_g, *ln1_b, *w_ff1, *w_ff2,
      *ln2_g, *ln2_b;
  float* out;
  unsigned char* ws;
};

DI u16 f2bf(float x) { return __builtin_bit_cast(u16, (__bf16)x); }
DI float bf2f(u16 v) { return __uint_as_float(((u32)v) << 16); }
DI u32 pack2(float a, float b) {
  flv2 f = {a, b};
  bfv2 v = __builtin_convertvector(f, bfv2);
  return __builtin_bit_cast(u32, v);
}
DI float bflo(u32 u) { return __uint_as_float(u << 16); }
DI float bfhi(u32 u) { return __uint_as_float(u & 0xffff0000u); }
DI int crow(int reg, int h) { return (reg & 3) + 8 * (reg >> 2) + 4 * h; }
DI float wave_sum(float v) {
#pragma unroll
  for (int o = 32; o >= 1; o >>= 1) v += __shfl_xor(v, o);
  return v;
}
DI float siluf(float x) { return x / (1.f + __expf(-x)); }
DI f32x16 zero16() {
  f32x16 z;
#pragma unroll
  for (int i = 0; i < 16; ++i) z[i] = 0.f;
  return z;
}

DI void scat8s(u16* base, int stride, const uint4& v, float f) {
  base[0 * stride] = f2bf(bflo(v.x) * f); base[1 * stride] = f2bf(bfhi(v.x) * f);
  base[2 * stride] = f2bf(bflo(v.y) * f); base[3 * stride] = f2bf(bfhi(v.y) * f);
  base[4 * stride] = f2bf(bflo(v.z) * f); base[5 * stride] = f2bf(bfhi(v.z) * f);
  base[6 * stride] = f2bf(bflo(v.w) * f); base[7 * stride] = f2bf(bfhi(v.w) * f);
}
DI void scat8r(u16* base, int stride, const uint4& v) {
  base[0 * stride] = (u16)(v.x & 0xffffu); base[1 * stride] = (u16)(v.x >> 16);
  base[2 * stride] = (u16)(v.y & 0xffffu); base[3 * stride] = (u16)(v.y >> 16);
  base[4 * stride] = (u16)(v.z & 0xffffu); base[5 * stride] = (u16)(v.z >> 16);
  base[6 * stride] = (u16)(v.w & 0xffffu); base[7 * stride] = (u16)(v.w >> 16);
}
DI float sumsq8(const uint4& u) {
  float s = 0.f, a;
  a = bflo(u.x); s += a * a; a = bfhi(u.x); s += a * a;
  a = bflo(u.y); s += a * a; a = bfhi(u.y); s += a * a;
  a = bflo(u.z); s += a * a; a = bfhi(u.z); s += a * a;
  a = bflo(u.w); s += a * a; a = bfhi(u.w); s += a * a;
  return s;
}
typedef u32 u32x4 __attribute__((ext_vector_type(4)));
DI u32x4 ldg16(const u16* p) { return *(const u32x4*)p; }
DI void unpack8(const u32x4& u, float* f) {
  f[0] = bflo(u[0]); f[1] = bfhi(u[0]); f[2] = bflo(u[1]); f[3] = bfhi(u[1]);
  f[4] = bflo(u[2]); f[5] = bfhi(u[2]); f[6] = bflo(u[3]); f[7] = bfhi(u[3]);
}
DI u32x4 pack8(const float* f) {
  u32x4 o;
  o[0] = pack2(f[0], f[1]); o[1] = pack2(f[2], f[3]); o[2] = pack2(f[4], f[5]); o[3] = pack2(f[6], f[7]);
  return o;
}
DI float* xrow(const Params& p, int row) {
  return row < NLAT ? p.out + (size_t)row * DM : (float*)(p.ws + O_XC) + (size_t)(row - NLAT) * DM;
}
DI const float* xrow0(const Params& p, int row) {
  return row < NLAT ? p.x + (size_t)row * DM : p.ctx + (size_t)(row - NLAT) * DM;
}
DI int rowb(int row) { return row < NLAT ? (row >> 12) : 16; }

constexpr int CSL = 132;
constexpr int GS = 72;
template <typename Epi>
DI void gemm_tile(const u16* __restrict__ A, int lda, const u16* __restrict__ Bt, int ldb, int K, char* lds, Epi epi) {
  u16* As = (u16*)lds;
  u16* Bs = As + 256 * GS;
  float* Cs = (float*)lds;
  int tid_ = VTID;
  asm volatile("" : "+v"(tid_));
  const int tid = tid_, wave = tid >> 6, lane = tid & 63, r = lane & 31, h = lane >> 5;
  const int wm = wave >> 1, wn = wave & 1;
  f32x16 acc[4][2];
#pragma unroll
  for (int i = 0; i < 4; ++i)
#pragma unroll
    for (int j = 0; j < 2; ++j) acc[i][j] = zero16();
  const int lrow = tid >> 3, lcol = (tid & 7) * 8;
  const u16* Ap = A + (size_t)lrow * lda + lcol;
  const u16* Bp = Bt + (size_t)lrow * ldb + lcol;
  u16* Aw = As + lrow * GS + lcol;
  u16* Bw = Bs + lrow * GS + lcol;
  u32x4 ra[8], rb[4];
#define GT_LOAD(k0)                                                                 \
  {                                                                                 \
    _Pragma("unroll") for (int i_ = 0; i_ < 8; ++i_) ra[i_] = ldg16(Ap + (size_t)(i_ * 32) * lda + (k0)); \
    _Pragma("unroll") for (int i_ = 0; i_ < 4; ++i_) rb[i_] = ldg16(Bp + (size_t)(i_ * 32) * ldb + (k0)); \
  }
#define GT_STORE()                                                                  \
  {                                                                                 \
    _Pragma("unroll") for (int i_ = 0; i_ < 8; ++i_) *(u32x4*)(Aw + i_ * 32 * GS) = ra[i_]; \
    _Pragma("unroll") for (int i_ = 0; i_ < 4; ++i_) *(u32x4*)(Bw + i_ * 32 * GS) = rb[i_]; \
  }
#define GT_COMPUTE()                                                                              \
  _Pragma("unroll") for (int ks = 0; ks < 4; ++ks) {                                              \
    bf16x8 fa[4], fb[2];                                                                          \
    _Pragma("unroll") for (int i_ = 0; i_ < 4; ++i_)                                              \
      fa[i_] = *(const bf16x8*)(As + (wm * 128 + i_ * 32 + r) * GS + ks * 16 + 8 * h);            \
    _Pragma("unroll") for (int j_ = 0; j_ < 2; ++j_)                                              \
      fb[j_] = *(const bf16x8*)(Bs + (wn * 64 + j_ * 32 + r) * GS + ks * 16 + 8 * h);             \
    _Pragma("unroll") for (int i_ = 0; i_ < 4; ++i_)                                              \
      _Pragma("unroll") for (int j_ = 0; j_ < 2; ++j_) acc[i_][j_] = MFMA(fa[i_], fb[j_], acc[i_][j_]); \
  }
  const int nk = K >> 6;
  GT_LOAD(0);
  for (int kt = 0; kt + 1 < nk; ++kt) {
    __syncthreads();
    GT_STORE();
    __syncthreads();
    GT_LOAD((kt + 1) << 6);
    GT_COMPUTE();
  }
  __syncthreads();
  GT_STORE();
  __syncthreads();
  GT_COMPUTE();
#pragma unroll 1
  for (int half = 0; half < 2; ++half) {
    __syncthreads();
    if (wm == half) {
#pragma unroll
      for (int i = 0; i < 4; ++i)
#pragma unroll
        for (int j = 0; j < 2; ++j)
#pragma unroll
          for (int g = 0; g < 16; ++g) Cs[(i * 32 + crow(g, h)) * CSL + wn * 64 + j * 32 + r] = acc[i][j][g];
    }
    __syncthreads();
    epi(half);
  }
}

constexpr int CSW = 264;
template <typename Epi>
DI void gemm_tile512(const u16* __restrict__ A, int lda, const u16* __restrict__ Bt, int ldb, int K, char* lds_all, Epi epi) {
  constexpr int STG = 2 * 256 * GS;
  u16* S0 = (u16*)lds_all;
  float* Cs = (float*)lds_all;
  int tid_ = threadIdx.x;
  asm volatile("" : "+v"(tid_));
  const int tid = tid_, wave = tid >> 6, lane = tid & 63, r = lane & 31, h = lane >> 5;
  const int wm = wave >> 2, wn = wave & 3;
  f32x16 acc[4][2];
#pragma unroll
  for (int i = 0; i < 4; ++i)
#pragma unroll
    for (int j = 0; j < 2; ++j) acc[i][j] = zero16();
  const int lrow = tid >> 3, lcol = (tid & 7) * 8;
  const u16* Ap = A + (size_t)lrow * lda + lcol;
  const u16* Bp = Bt + (size_t)lrow * ldb + lcol;
  u16* Sw = S0 + lrow * GS + lcol;
  u32x4 ra[4], rb[4];
#define G5_LOAD(k0)                                                                 \
  {                                                                                 \
    _Pragma("unroll") for (int i_ = 0; i_ < 4; ++i_) ra[i_] = ldg16(Ap + (size_t)(i_ * 64) * lda + (k0)); \
    _Pragma("unroll") for (int i_ = 0; i_ < 4; ++i_) rb[i_] = ldg16(Bp + (size_t)(i_ * 64) * ldb + (k0)); \
  }
#define G5_STORE(s)                                                                 \
  {                                                                                 \
    _Pragma("unroll") for (int i_ = 0; i_ < 4; ++i_) *(u32x4*)(Sw + (s) * STG + i_ * 64 * GS) = ra[i_]; \
    _Pragma("unroll") for (int i_ = 0; i_ < 4; ++i_) *(u32x4*)(Sw + (s) * STG + 256 * GS + i_ * 64 * GS) = rb[i_]; \
  }
#define G5_COMPUTE(s)                                                                             \
  {                                                                                               \
    const u16* As_ = S0 + (s) * STG;                                                              \
    const u16* Bs_ = As_ + 256 * GS;                                                              \
    _Pragma("unroll") for (int ks = 0; ks < 4; ++ks) {                                            \
      bf16x8 fa[4], fb[2];                                                                        \
      _Pragma("unroll") for (int i_ = 0; i_ < 4; ++i_)                                            \
        fa[i_] = *(const bf16x8*)(As_ + (wm * 128 + i_ * 32 + r) * GS + ks * 16 + 8 * h);         \
      _Pragma("unroll") for (int j_ = 0; j_ < 2; ++j_)                                            \
        fb[j_] = *(const bf16x8*)(Bs_ + (wn * 64 + j_ * 32 + r) * GS + ks * 16 + 8 * h);          \
      _Pragma("unroll") for (int i_ = 0; i_ < 4; ++i_)                                            \
        _Pragma("unroll") for (int j_ = 0; j_ < 2; ++j_) acc[i_][j_] = MFMA(fa[i_], fb[j_], acc[i_][j_]); \
    }                                                                                             \
  }
  const int nk = K >> 6;
  __syncthreads();
  G5_LOAD(0);
  G5_STORE(0);
  G5_LOAD(64);
  __syncthreads();
  for (int kt = 0; kt + 2 < nk; ++kt) {
    const int cur = kt & 1;
    G5_STORE(cur ^ 1);
    G5_LOAD((kt + 2) << 6);
    G5_COMPUTE(cur);
    __syncthreads();
  }
  {
    const int cur = (nk - 2) & 1;
    G5_STORE(cur ^ 1);
    G5_COMPUTE(cur);
    __syncthreads();
    G5_COMPUTE(cur ^ 1);
  }
#pragma unroll 1
  for (int half = 0; half < 2; ++half) {
    __syncthreads();
    if (wm == half) {
#pragma unroll
      for (int i = 0; i < 4; ++i)
#pragma unroll
        for (int j = 0; j < 2; ++j)
#pragma unroll
          for (int g = 0; g < 16; ++g) Cs[(i * 32 + crow(g, h)) * CSW + wn * 64 + j * 32 + r] = acc[i][j][g];
    }
    __syncthreads();
    epi(half);
  }
}

DI void wtrans_tile(const float* __restrict__ src, int K, int N, u16* __restrict__ dst, int ldw, int tk, int tn,
                    const float* __restrict__ kscale, char* lds) {
  float* t = (float*)lds;
  int tid_ = VTID;
  asm volatile("" : "+v"(tid_));
  const int tid = tid_, j = tid & 63, i0 = tid >> 6;
  const int k0 = tk * 64, n0 = tn * 64;
  __syncthreads();
#pragma unroll
  for (int q = 0; q < 16; ++q) {
    int i = i0 + 4 * q;
    float v = (n0 + j < N) ? src[(size_t)(k0 + i) * N + n0 + j] : 0.f;
    if (kscale) v *= kscale[k0 + i];
    t[i * 65 + j] = v;
  }
  __syncthreads();
#pragma unroll 4
  for (int q = 0; q < 16; ++q) {
    int jj = i0 + 4 * q;
    dst[(size_t)(n0 + jj) * ldw + k0 + j] = f2bf(t[j * 65 + jj]);
  }
}

DI void ada_tile(const Params& p, int layer, int cg64, char* lds) {
  float* sc = (float*)lds;
  int tid_ = VTID;
  asm volatile("" : "+v"(tid_));
  const int tid = tid_;
  __syncthreads();
  for (int e = tid; e < 17 * 1024; e += 256) {
    int bi = e >> 10, k = e & 1023;
    float v = bi < 16 ? p.c[bi * 1024 + k] : p.c_ctx[k];
    sc[e] = siluf(v);
  }
  __syncthreads();
  const int col = tid & 63, kq = tid >> 6;
  const int n = cg64 * 64 + col;
  const float* w = p.ada_w + (size_t)layer * 1024 * 6144 + n;
  float acc[17];
#pragma unroll
  for (int i = 0; i < 17; ++i) acc[i] = 0.f;
#pragma unroll 8
  for (int kk = 0; kk < 256; ++kk) {
    int k = kq * 256 + kk;
    float wv = w[(size_t)k * 6144];
#pragma unroll
    for (int i = 0; i < 17; ++i) acc[i] += sc[i * 1024 + k] * wv;
  }
  __syncthreads();
  float* red = (float*)lds;
#pragma unroll
  for (int i = 0; i < 17; ++i) red[(kq * 17 + i) * 64 + col] = acc[i];
  __syncthreads();
  float* mod = (float*)(p.ws + O_MOD) + (size_t)layer * 17 * 6144;
  for (int e = tid; e < 17 * 64; e += 256) {
    int bi = e >> 6, cc = e & 63;
    float s = red[(0 * 17 + bi) * 64 + cc] + red[(1 * 17 + bi) * 64 + cc] + red[(2 * 17 + bi) * 64 + cc] +
              red[(3 * 17 + bi) * 64 + cc];
    int nn = cg64 * 64 + cc;
    mod[bi * 6144 + nn] = s + p.ada_b[layer * 6144 + nn];
  }
}

DI void phase0a(const Params& p, char* lds) {
  int tid_ = VTID;
  asm volatile("" : "+v"(tid_));
  const int tid = tid_;
  for (int t = VB; t < 6544; t += VG) {
    if (t < 6096) {
      int layer = t / 3048, q = t % 3048;
      if (q < 704) {
        wtrans_tile(p.w_in + (size_t)layer * 1024 * 2736, 1024, 2736, (u16*)(p.ws + O_WIN + layer * SZ_WIN), WP, q / 44, q % 44,
                    nullptr, lds);
      } else if (q < 960) {
        q -= 704;
        wtrans_tile(p.w_out + (size_t)layer * 1024 * 1024, 1024, 1024, (u16*)(p.ws + O_WOUT + layer * SZ_WOUT), WP, q / 16, q % 16,
                    nullptr, lds);
      } else if (q < 1984) {
        q -= 960;
        wtrans_tile(p.w_ff1 + (size_t)layer * 1024 * 4096, 1024, 4096, (u16*)(p.ws + O_WFF1 + layer * SZ_WFF), WP, q / 64, q % 64,
                    nullptr, lds);
      } else if (q < 3008) {
        q -= 1984;
        wtrans_tile(p.w_ff2 + (size_t)layer * 4096 * 1024, 4096, 1024, (u16*)(p.ws + O_WFF2 + layer * SZ_WFF), WP2, q / 16, q % 16,
                    nullptr, lds);
      } else if (q < 3032) {
        q -= 3008;
        wtrans_tile(p.mla_w_uq + (size_t)layer * 256 * 384, 256, 384, (u16*)(p.ws + O_WUQ + layer * SZ_WUQ), 256, q / 6, q % 6,
                    p.mla_q_norm + layer * 256, lds);
      } else {
        q -= 3032;
        wtrans_tile(p.mla_w_ukv + (size_t)layer * 128 * 512, 128, 512, (u16*)(p.ws + O_WUKV + layer * SZ_WUKV), 128, q / 8, q % 8,
                    p.mla_kv_norm + layer * 128, lds);
      }
    } else if (t < 6288) {
      int q = t - 6096;
      ada_tile(p, q / 96, q % 96, lds);
    } else {
      int q = t - 6288;
      float2* tab = (float2*)(p.ws + O_TAB);
      for (int e = q * 1024 + tid; e < (q + 1) * 1024; e += 256) {
        int tok = e >> 6, i = e & 63;
        float ang;
        if (i < 32) {
          int f = i & 15;
          float inv = powf(10000.f, -(float)(2 * f) / 32.f);
          ang = (float)(i < 16 ? (tok >> 6) : (tok & 63)) * inv;
        } else if (i < 48) {
          int f = i - 32;
          float inv = powf(10000.f, -(float)(2 * f) / 32.f);
          ang = (float)tok * inv;
        } else {
          int f = (i - 48) & 7;
          float inv = powf(10000.f, -(float)(2 * f) / 16.f);
          ang = (float)((i - 48) < 8 ? (tok >> 6) : (tok & 63)) * inv;
        }
        float sn, cs;
        sincosf(ang, &sn, &cs);
        tab[e] = make_float2(cs, sn);
      }
    }
  }
}

DI void modulate_rows(const Params& p, int layer_mod, int nrows) {
  int tid_ = VTID;
  asm volatile("" : "+v"(tid_));
  const int tid = tid_, wave = tid >> 6, lane = tid & 63;
  const float* mod = (const float*)(p.ws + O_MOD) + (size_t)layer_mod * 17 * 6144;
  u16* act = (u16*)(p.ws + O_ACT);
  const int stride = VG * 4;
  for (int row0 = VB * 4 + wave; row0 < nrows; row0 += 2 * stride) {
    const int row1 = row0 + stride;
    const bool has1 = row1 < nrows;
    float4 va[4], vb[4];
#pragma unroll
    for (int i = 0; i < 4; ++i) {
      va[i] = *(const float4*)(xrow0(p, row0) + (i * 64 + lane) * 4);
      vb[i] = has1 ? *(const float4*)(xrow0(p, row1) + (i * 64 + lane) * 4) : make_float4(0.f, 0.f, 0.f, 0.f);
    }
#pragma unroll
    for (int rr = 0; rr < 2; ++rr) {
      if (rr == 1 && !has1) break;
      const int row = rr ? row1 : row0;
      const float* m = mod + rowb(row) * 6144;
#pragma unroll
      for (int i = 0; i < 4; ++i) {
        int col = (i * 64 + lane) * 4;
        float4 v = rr ? vb[i] : va[i];
        float4 sh = *(const float4*)(m + col);
        float4 sc = *(const float4*)(m + 1024 + col);
        uint2 o;
        o.x = pack2(v.x * (1.f + sc.x) + sh.x, v.y * (1.f + sc.y) + sh.y);
        o.y = pack2(v.z * (1.f + sc.z) + sh.z, v.w * (1.f + sc.w) + sh.w);
        *(uint2*)(act + (size_t)row * AP + col) = o;
      }
    }
  }
}

DI void ln_rows(const Params& p, const float* g, const float* bb, int nrows, int mod_layer, int sh_chunk, bool write_act) {
  int tid_ = VTID;
  asm volatile("" : "+v"(tid_));
  const int tid = tid_, wave = tid >> 6, lane = tid & 63;
  u16* act = (u16*)(p.ws + O_ACT);
  const int stride = VG * 4;
  for (int row0 = VB * 4 + wave; row0 < nrows; row0 += 2 * stride) {
    const int row1 = row0 + stride;
    const bool has1 = row1 < nrows;
    float4 va[4], vb[4];
    float sa = 0.f, sb = 0.f;
#pragma unroll
    for (int i = 0; i < 4; ++i) {
      va[i] = *(const float4*)(xrow(p, row0) + (i * 64 + lane) * 4);
      vb[i] = has1 ? *(const float4*)(xrow(p, row1) + (i * 64 + lane) * 4) : make_float4(0.f, 0.f, 0.f, 0.f);
    }
#pragma unroll
    for (int i = 0; i < 4; ++i) {
      sa += va[i].x + va[i].y + va[i].z + va[i].w;
      sb += vb[i].x + vb[i].y + vb[i].z + vb[i].w;
    }
    const float ma = wave_sum(sa) * (1.f / 1024.f), mb = wave_sum(sb) * (1.f / 1024.f);
    float qa = 0.f, qb = 0.f;
#pragma unroll
    for (int i = 0; i < 4; ++i) {
      va[i].x -= ma; va[i].y -= ma; va[i].z -= ma; va[i].w -= ma;
      vb[i].x -= mb; vb[i].y -= mb; vb[i].z -= mb; vb[i].w -= mb;
      qa += va[i].x * va[i].x + va[i].y * va[i].y + va[i].z * va[i].z + va[i].w * va[i].w;
      qb += vb[i].x * vb[i].x + vb[i].y * vb[i].y + vb[i].z * vb[i].z + vb[i].w * vb[i].w;
    }
    const float ra = rsqrtf(wave_sum(qa) * (1.f / 1024.f) + 1e-5f), rb = rsqrtf(wave_sum(qb) * (1.f / 1024.f) + 1e-5f);
#pragma unroll
    for (int rr = 0; rr < 2; ++rr) {
      if (rr == 1 && !has1) break;
      const int row = rr ? row1 : row0;
      const float rstd = rr ? rb : ra;
      float* dst = xrow(p, row);
      const float* m = (const float*)(p.ws + O_MOD) + (size_t)mod_layer * 17 * 6144 + rowb(row) * 6144 + sh_chunk * 1024;
#pragma unroll
      for (int i = 0; i < 4; ++i) {
        int col = (i * 64 + lane) * 4;
        float4 v = rr ? vb[i] : va[i];
        float4 gg = *(const float4*)(g + col);
        float4 bv = *(const float4*)(bb + col);
        float4 y;
        y.x = v.x * rstd * gg.x + bv.x; y.y = v.y * rstd * gg.y + bv.y;
        y.z = v.z * rstd * gg.z + bv.z; y.w = v.w * rstd * gg.w + bv.w;
        *(float4*)(dst + col) = y;
        if (write_act) {
          float4 sh = *(const float4*)(m + col);
          float4 sc = *(const float4*)(m + 1024 + col);
          uint2 o;
          o.x = pack2(y.x * (1.f + sc.x) + sh.x, y.y * (1.f + sc.y) + sh.y);
          o.y = pack2(y.z * (1.f + sc.z) + sh.z, y.w * (1.f + sc.w) + sh.w);
          *(uint2*)(act + (size_t)row * AP + col) = o;
        }
      }
    }
  }
}

DI void gemm_phase(const Params& p, int layer, int mode, int nrows, char* lds_all) {
  int tid_ = threadIdx.x;
  asm volatile("" : "+v"(tid_));
  const int tid = tid_;
  const float* Cs = (const float*)lds_all;
  int ntn, K, lda, ldb;
  const u16 *A, *Bt;
  if (mode == 0) { ntn = 11; K = 1024; lda = AP; ldb = WP; A = (const u16*)(p.ws + O_ACT); Bt = (const u16*)(p.ws + O_WIN + layer * SZ_WIN); }
  else if (mode == 1) { ntn = 4; K = 1024; lda = AP; ldb = WP; A = (const u16*)(p.ws + O_ACT); Bt = (const u16*)(p.ws + O_WOUT + layer * SZ_WOUT); }
  else if (mode == 2) { ntn = 16; K = 1024; lda = AP; ldb = WP; A = (const u16*)(p.ws + O_ACT); Bt = (const u16*)(p.ws + O_WFF1 + layer * SZ_WFF); }
  else { ntn = 4; K = 4096; lda = HP; ldb = WP2; A = (const u16*)(p.ws + O_Z); Bt = (const u16*)(p.ws + O_WFF2 + layer * SZ_WFF); }
  const int ntm = nrows >> 8;
  const float* mod = (const float*)(p.ws + O_MOD) + (size_t)layer * 17 * 6144;
  const bool swz = (gridDim.x & 7) == 0;
  const int xcd = swz ? (blockIdx.x & 7) : 0, nx = swz ? 8 : 1;
  const int jb = swz ? (blockIdx.x >> 3) : blockIdx.x, nj = swz ? (gridDim.x >> 3) : gridDim.x;
  const int per = 2 * ntn, nsr = ntm >> 1;
  for (int i = jb;; i += nj) {
    const int srl = i / per, rem = i - srl * per;
    const int sr = xcd + nx * srl;
    if (sr >= nsr) break;
    const int tn = rem >> 1, tm = sr * 2 + (rem & 1);
    const int m0 = tm * 256, n0 = tn * 256;
    gemm_tile512(A + (size_t)m0 * lda, lda, Bt + (size_t)n0 * ldb, ldb, K, lds_all, [&](int half) {
      for (int idx = tid; idx < 128 * 64; idx += 512) {
        const int rr = idx >> 6, c4 = (idx & 63) * 4;
        const int row = m0 + half * 128 + rr, col = n0 + c4;
        float4 v = *(const float4*)(Cs + rr * CSW + c4);
        if (mode == 0) {
          uint2 o;
          o.x = pack2(v.x, v.y); o.y = pack2(v.z, v.w);
          *(uint2*)((u16*)(p.ws + O_Z) + (size_t)row * ZW + col) = o;
          if (n0 == C_BAB && c4 < 16) *(float4*)((float*)(p.ws + O_GRAW) + (size_t)row * 16 + c4) = v;
        } else if (mode == 2) {
          float a = fmaxf(v.x, 0.f), b = fmaxf(v.y, 0.f), c = fmaxf(v.z, 0.f), d = fmaxf(v.w, 0.f);
          uint2 o;
          o.x = pack2(a * a, b * b); o.y = pack2(c * c, d * d);
          *(uint2*)((u16*)(p.ws + O_Z) + (size_t)row * HP + col) = o;
        } else {
          const float* gate = mod + rowb(row) * 6144 + (mode == 1 ? 2 : 5) * 1024 + col;
          float4 gt = *(const float4*)gate;
          const float* res = (mode == 1 && layer == 0) ? xrow0(p, row) : xrow(p, row);
          float4 xr = *(const float4*)(res + col);
          float4 o;
          o.x = DN_ALPHA * xr.x + gt.x * v.x; o.y = DN_ALPHA * xr.y + gt.y * v.y;
          o.z = DN_ALPHA * xr.z + gt.z * v.z; o.w = DN_ALPHA * xr.w + gt.w * v.w;
          *(float4*)(xrow(p, row) + col) = o;
        }
      }
    });
  }
}

DI void prep_swa(const Params& p, int tile) {
  int tid_ = VTID;
  asm volatile("" : "+v"(tid_));
  const int tid = tid_;
  const u16* Z = (const u16*)(p.ws + O_Z);
  const float4* tab = (const float4*)(p.ws + O_TAB);
  u16* QA = (u16*)(p.ws + O_QA);
  u16* KA = (u16*)(p.ws + O_KA);
  const int m0 = tile * 64;
  for (int jb = 0; jb < 6; jb += 3) {
    u32x4 x1[3], x2[3];
    float4 tb[3][4];
#pragma unroll
    for (int u = 0; u < 3; ++u) {
      const int id = tid + 256 * (jb + u), ri = id / 24, rem = id % 24, slot = rem >> 2, i8 = rem & 3;
      const int row = m0 + ri;
      const int base = slot < 4 ? C_AQ + slot * 64 : C_AK + (slot - 4) * 64;
      x1[u] = ldg16(Z + (size_t)row * ZW + base + i8 * 8);
      x2[u] = ldg16(Z + (size_t)row * ZW + base + 32 + i8 * 8);
      const int pos = row < NLAT ? (row & 4095) : 0;
#pragma unroll
      for (int e = 0; e < 4; ++e) tb[u][e] = tab[(pos * 64 + i8 * 8) / 2 + e];
    }
#pragma unroll
    for (int u = 0; u < 3; ++u) {
      const int id = tid + 256 * (jb + u), ri = id / 24, rem = id % 24, slot = rem >> 2, i8 = rem & 3;
      const int row = m0 + ri;
      const bool lat = row < NLAT;
      int b, pos;
      if (lat) { b = row >> 12; pos = row & 4095; } else { b = (row - NLAT) >> 8; pos = TT + ((row - NLAT) & 255); }
      float a1[8], a2[8], o1[8], o2[8];
      unpack8(x1[u], a1); unpack8(x2[u], a2);
      const float qs = slot < 4 ? 0.125f * LOG2E : 1.f;
#pragma unroll
      for (int e = 0; e < 4; ++e) {
        float c0 = lat ? tb[u][e].x : 1.f, s0 = lat ? tb[u][e].y : 0.f, c1 = lat ? tb[u][e].z : 1.f, s1 = lat ? tb[u][e].w : 0.f;
        o1[2 * e] = (a1[2 * e] * c0 - a2[2 * e] * s0) * qs;
        o2[2 * e] = (a1[2 * e] * s0 + a2[2 * e] * c0) * qs;
        o1[2 * e + 1] = (a1[2 * e + 1] * c1 - a2[2 * e + 1] * s1) * qs;
        o2[2 * e + 1] = (a1[2 * e + 1] * s1 + a2[2 * e + 1] * c1) * qs;
      }
      u16* d = slot < 4 ? QA + ((size_t)(b * 4 + slot) * NPOS + pos) * 64 : KA + ((size_t)(b * 2 + slot - 4) * NPOS + pos) * 64;
      *(u32x4*)(d + i8 * 8) = pack8(o1);
      *(u32x4*)(d + 32 + i8 * 8) = pack8(o2);
    }
  }
}

DI void prep_ret(const Params& p, int tile) {
  int tid_ = VTID;
  asm volatile("" : "+v"(tid_));
  const int tid = tid_;
  const u16* Z = (const u16*)(p.ws + O_Z);
  const float4* tab = (const float4*)(p.ws + O_TAB);
  u16* QC = (u16*)(p.ws + O_QC);
  u16* KC = (u16*)(p.ws + O_KC);
  const int m0 = tile * 64;
  u32x4 x1[4], x2[4];
  float4 tb[4][4];
#pragma unroll
  for (int u = 0; u < 4; ++u) {
    const int id = tid + 256 * u, ri = id >> 4, rem = id & 15, slot = rem >> 1, i8 = rem & 1;
    const int row = m0 + ri;
    const int base = C_CQ + slot * 32;
    x1[u] = ldg16(Z + (size_t)row * ZW + base + i8 * 8);
    x2[u] = ldg16(Z + (size_t)row * ZW + base + 16 + i8 * 8);
    const int pos = row < NLAT ? (row & 4095) : 0;
#pragma unroll
    for (int e = 0; e < 4; ++e) tb[u][e] = tab[(pos * 64 + 32 + i8 * 8) / 2 + e];
  }
#pragma unroll
  for (int u = 0; u < 4; ++u) {
    const int id = tid + 256 * u, ri = id >> 4, rem = id & 15, slot = rem >> 1, i8 = rem & 1;
    const int row = m0 + ri;
    const bool lat = row < NLAT;
    float a1[8], a2[8], o1[8], o2[8];
    unpack8(x1[u], a1); unpack8(x2[u], a2);
    const float qs = slot < 4 ? 0.17677669529663687f : 1.f;
#pragma unroll
    for (int e = 0; e < 4; ++e) {
      float c0 = lat ? tb[u][e].x : 1.f, s0 = lat ? tb[u][e].y : 0.f, c1 = lat ? tb[u][e].z : 1.f, s1 = lat ? tb[u][e].w : 0.f;
      o1[2 * e] = (a1[2 * e] * c0 - a2[2 * e] * s0) * qs;
      o2[2 * e] = (a1[2 * e] * s0 + a2[2 * e] * c0) * qs;
      o1[2 * e + 1] = (a1[2 * e + 1] * c1 - a2[2 * e + 1] * s1) * qs;
      o2[2 * e + 1] = (a1[2 * e + 1] * s1 + a2[2 * e + 1] * c1) * qs;
    }
    u16* d = slot < 4 ? QC + (size_t)row * 128 + slot * 32 : KC + (size_t)row * 128 + (slot - 4) * 32;
    *(u32x4*)(d + i8 * 8) = pack8(o1);
    *(u32x4*)(d + 16 + i8 * 8) = pack8(o2);
  }
}

DI void prep_dn(const Params& p, int layer, int tile, char* lds) {
  int tid_ = VTID;
  asm volatile("" : "+v"(tid_));
  const int tid = tid_;
  const u16* Z = (const u16*)(p.ws + O_Z);
  u16* QKVB = (u16*)(p.ws + O_QKVB);
  float* cw = (float*)lds;
  const int m0 = tile * 64;
  __syncthreads();
  for (int e = tid; e < 3840; e += 256) cw[e] = p.dn_conv_w[(size_t)layer * 3840 + e];
  __syncthreads();
  for (int jb = 0; jb < 24; jb += 4) {
    u32x4 xr[4][5];
#pragma unroll
    for (int u = 0; u < 4; ++u) {
      const int id = tid + 256 * (jb + u), ri = id / 96, ch8 = id % 96;
      const int row = m0 + ri;
      int tpos, seqn;
      if (row < NLAT) { tpos = row & 4095; seqn = TT; } else { tpos = (row - NLAT) & 255; seqn = LC; }
      const u16* zc = Z + (size_t)row * ZW + C_BQKV + ch8 * 8;
#pragma unroll
      for (int j = 0; j < 5; ++j) {
        const int tp = tpos + j - 2;
        u32x4 zz = {0u, 0u, 0u, 0u};
        xr[u][j] = (tp >= 0 && tp < seqn) ? ldg16(zc + (j - 2) * ZW) : zz;
      }
    }
#pragma unroll
    for (int u = 0; u < 4; ++u) {
      const int id = tid + 256 * (jb + u), ri = id / 96, ch8 = id % 96;
      const int row = m0 + ri;
      float acc[8];
#pragma unroll
      for (int e = 0; e < 8; ++e) acc[e] = 0.f;
#pragma unroll
      for (int j = 0; j < 5; ++j) {
        float x[8];
        unpack8(xr[u][j], x);
        const float4 w0 = *(const float4*)(cw + j * 768 + ch8 * 8), w1 = *(const float4*)(cw + j * 768 + ch8 * 8 + 4);
        acc[0] += x[0] * w0.x; acc[1] += x[1] * w0.y; acc[2] += x[2] * w0.z; acc[3] += x[3] * w0.w;
        acc[4] += x[4] * w1.x; acc[5] += x[5] * w1.y; acc[6] += x[6] * w1.z; acc[7] += x[7] * w1.w;
      }
      float ss = 0.f;
#pragma unroll
      for (int e = 0; e < 8; ++e) { acc[e] = siluf(acc[e]); ss += acc[e] * acc[e]; }
      ss += __shfl_xor(ss, 1); ss += __shfl_xor(ss, 2); ss += __shfl_xor(ss, 4);
      const int grp = ch8 >> 3;
      const float sc = grp < 8 ? rsqrtf(ss + 1e-6f) * (grp < 4 ? 0.125f : 1.f) : 1.f;
#pragma unroll
      for (int e = 0; e < 8; ++e) acc[e] *= sc;
      *(u32x4*)(QKVB + (size_t)row * 768 + ch8 * 8) = pack8(acc);
    }
  }
  const float* graw = (const float*)(p.ws + O_GRAW);
  float* g2 = (float*)(p.ws + O_G2);
  for (int e = tid; e < 64 * 8; e += 256) {
    int ri = e >> 3, dh = e & 7, dir = dh >> 2, hh = dh & 3;
    int row = m0 + ri;
    float ra = graw[(size_t)row * 16 + dir * 8 + hh], rb = graw[(size_t)row * 16 + dir * 8 + 4 + hh];
    float xx = ra + p.dn_dt_bias[layer * 8 + dh];
    float sp = xx > 20.f ? xx : log1pf(expf(xx));
    float lg = -expf(p.dn_a_log[layer * 8 + dh]) * sp;
    float beta = 1.f / (1.f + expf(-rb));
    g2[(size_t)row * 16 + dh] = lg;
    g2[(size_t)row * 16 + 8 + dh] = beta;
  }
}

DI void prep_mla(const Params& p, int layer, int tm, int which, int nt, char* lds) {
  int tid_ = VTID;
  asm volatile("" : "+v"(tid_));
  const int tid = tid_;
  const u16* Z = (const u16*)(p.ws + O_Z);
  const int m0 = tm * 256;
  float* rs = (float*)(lds + 128 * CSL * 4);
  const int KK = which == 0 ? 256 : 128;
  const int cbase = which == 0 ? C_DCQ : C_DCKV;
  __syncthreads();
  {
    const u16* src = Z + (size_t)(m0 + tid) * ZW + cbase;
    float s = 0.f;
    for (int i = 0; i < KK / 8; i += 4) {
      u32x4 u0 = ldg16(src + i * 8), u1 = ldg16(src + i * 8 + 8), u2 = ldg16(src + i * 8 + 16), u3 = ldg16(src + i * 8 + 24);
      float f[8];
      unpack8(u0, f);
#pragma unroll
      for (int e = 0; e < 8; ++e) s += f[e] * f[e];
      unpack8(u1, f);
#pragma unroll
      for (int e = 0; e < 8; ++e) s += f[e] * f[e];
      unpack8(u2, f);
#pragma unroll
      for (int e = 0; e < 8; ++e) s += f[e] * f[e];
      unpack8(u3, f);
#pragma unroll
      for (int e = 0; e < 8; ++e) s += f[e] * f[e];
    }
    rs[tid] = rsqrtf(s / (float)KK + 1e-6f);
  }
  const u16* Bt = which == 0 ? (const u16*)(p.ws + O_WUQ + layer * SZ_WUQ) + (size_t)nt * 128 * 256
                             : (const u16*)(p.ws + O_WUKV + layer * SZ_WUKV) + (size_t)nt * 128 * 128;
  const float* Cs = (const float*)lds;
  const float2* tab = (const float2*)(p.ws + O_TAB);
  gemm_tile(Z + (size_t)m0 * ZW + cbase, ZW, Bt, KK, KK, lds, [&](int half) {
    if (which == 0) {
      u16* QD = (u16*)(p.ws + O_QD);
      const float qs = 0.10206207261596575f * LOG2E;
      for (int idx = tid; idx < 128 * 32; idx += 256) {
        const int rr = idx >> 5, c4 = (idx & 31) * 4;
        const int row = m0 + half * 128 + rr;
        const float sc = rs[half * 128 + rr] * qs;
        float o[4];
#pragma unroll
        for (int j = 0; j < 4; ++j) {
          int cl = c4 + j, c = nt * 128 + cl, d = c % 96;
          float v = Cs[rr * CSL + cl];
          if (d >= 64 && row < NLAT) {
            int i = d - 64;
            if (i < 16) {
              float2 t = tab[(row & 4095) * 64 + 48 + i];
              float x2 = Cs[rr * CSL + cl + 16];
              v = v * t.x - x2 * t.y;
            } else {
              float2 t = tab[(row & 4095) * 64 + 48 + i - 16];
              float x1 = Cs[rr * CSL + cl - 16];
              v = x1 * t.y + v * t.x;
            }
          }
          o[j] = v * sc;
        }
        uint2 w;
        w.x = pack2(o[0], o[1]); w.y = pack2(o[2], o[3]);
        *(uint2*)(QD + (size_t)row * 384 + nt * 128 + c4) = w;
      }
    } else {
      u16* KVD = (u16*)(p.ws + O_KVD);
      for (int idx = tid; idx < 128 * 32; idx += 256) {
        const int rr = idx >> 5, c4 = (idx & 31) * 4;
        const int row = m0 + half * 128 + rr;
        const float sc = rs[half * 128 + rr];
        float4 v = *(const float4*)(Cs + rr * CSL + c4);
        uint2 w;
        w.x = pack2(v.x * sc, v.y * sc); w.y = pack2(v.z * sc, v.w * sc);
        *(uint2*)(KVD + (size_t)row * KVP + nt * 128 + c4) = w;
      }
    }
  });
  if (which == 1 && nt == 0) {
    u16* KR = (u16*)(p.ws + O_KR);
    for (int e = tid; e < 256 * 16; e += 256) {
      int rr = e >> 4, i = e & 15, row = m0 + rr;
      float cs = 1.f, sn = 0.f;
      if (row < NLAT) { float2 t = tab[(row & 4095) * 64 + 48 + i]; cs = t.x; sn = t.y; }
      float x1 = bf2f(Z[(size_t)row * ZW + C_DKR + i]), x2 = bf2f(Z[(size_t)row * ZW + C_DKR + 16 + i]);
      KR[(size_t)row * 32 + i] = f2bf(x1 * cs - x2 * sn);
      KR[(size_t)row * 32 + 16 + i] = f2bf(x1 * sn + x2 * cs);
    }
  }
}

DI void prep_phase(const Params& p, int layer, char* lds) {
  const int total = 3264 + 816 + 1088;
  for (int t = VB; t < total; t += VG) {
    if (t < 1088) prep_swa(p, t);
    else if (t < 2176) prep_ret(p, t - 1088);
    else if (t < 3264) prep_dn(p, layer, t - 2176, lds);
    else if (t < 3264 + 816) { int q = t - 3264; prep_mla(p, layer, q / 3, 0, q % 3, lds); }
    else { int q = t - 3264 - 816; prep_mla(p, layer, q / 4, 1, q % 4, lds); }
  }
}

struct Seg {
  const u16* k; const u16* k2; const u16* v;
  int ldk, ldk2, ldv, n, pos0, masked;
};

template <int DQK>
DI void attn_tile(const u16* __restrict__ q, int ldq, int qpos0, const Seg& s0, const Seg& s1, int nseg, bool has_sink,
                  float sinkl2, u16* __restrict__ out, int ldo, char* lds) {
  constexpr int KST = DQK + 8;
  constexpr int CPK = DQK / 8;
  constexpr int NKS = DQK / 16;
  constexpr int VST = 96;
  u16* Ks = (u16*)lds;
  u16* Vs = Ks + 64 * KST;
  int ltid_ = threadIdx.x;
  asm volatile("" : "+v"(ltid_));
  const int ltid = ltid_;
  const int tid = ltid & 255, wave = tid >> 6, lane = tid & 63, r = lane & 31, h = lane >> 5;
  const int qi = wave * 32 + r;
  bf16x8 qf[NKS];
#pragma unroll
  for (int ks = 0; ks < NKS; ++ks) qf[ks] = *(const bf16x8*)(q + (size_t)qi * ldq + ks * 16 + 8 * h);
  const int nt0 = s0.n >> 6;
  const int NT = nt0 + (nseg > 1 ? (s1.n >> 6) : 0);
  uint4 kreg0, kreg1 = make_uint4(0, 0, 0, 0), vreg0;
  uint4 krgB0, krgB1 = make_uint4(0, 0, 0, 0), vrgB0;
  const int kkey0 = ltid / CPK, kpart0 = ltid % CPK;
  const int kkey1 = (ltid + 512) / CPK, kpart1 = (ltid + 512) % CPK;
  const bool k1 = (CPK == 12) && (ltid < 256);
  const int vkey = ltid >> 3, vpart = ltid & 7;
  typedef __attribute__((address_space(3))) const char* lds_cptr;
  typedef short v4i16_t __attribute__((ext_vector_type(4)));
  const lds_cptr vp0 = (lds_cptr)Vs + (4 * h + ((lane & 15) >> 2)) * (VST * 2) + ((lane >> 4) & 1) * 32 + (lane & 3) * 8;
#define ATT_VTR(p) __builtin_bit_cast(s16x4, __builtin_amdgcn_ds_read_tr16_b64_v4i16((__attribute__((address_space(3))) v4i16_t*)(p)))
#define ATT_KSRC(sg, off, key, part) \
  (((part) < 8) ? (sg).k + (size_t)((off) + (key)) * (sg).ldk + (part) * 8 : (sg).k2 + (size_t)((off) + (key)) * (sg).ldk2 + ((part) - 8) * 8)
#define ATT_LOADX(i, K0, K1, V0)                                                            \
  {                                                                                         \
    const Seg& sgl = ((i) < nt0) ? s0 : s1;                                                 \
    const int offl = (((i) < nt0) ? (i) : (i) - nt0) << 6;                                  \
    K0 = *(const uint4*)ATT_KSRC(sgl, offl, kkey0, kpart0);                                 \
    if (k1) K1 = *(const uint4*)ATT_KSRC(sgl, offl, kkey1, kpart1);                         \
    V0 = *(const uint4*)(sgl.v + (size_t)(offl + vkey) * sgl.ldv + vpart * 8);              \
  }
  f32x16 o0 = zero16(), o1 = zero16();
  float m = -1e30f, l = 0.f;
#define ATT_STOREX(K0, K1, V0)                                               \
  {                                                                           \
    *(uint4*)(Ks + kkey0 * KST + kpart0 * 8) = K0;                            \
    if (k1) *(uint4*)(Ks + kkey1 * KST + kpart1 * 8) = K1;                    \
    *(uint4*)(Vs + vkey * VST + vpart * 8) = V0;                              \
  }
  auto compute = [&](int i) {
    const Seg& sg = (i < nt0) ? s0 : s1;
    const int off = ((i < nt0) ? i : i - nt0) << 6;
    f32x16 sa = zero16(), sb = zero16();
#pragma unroll
    for (int ks = 0; ks < NKS; ++ks) {
      bf16x8 a0 = *(const bf16x8*)(Ks + r * KST + ks * 16 + 8 * h);
      bf16x8 a1 = *(const bf16x8*)(Ks + (32 + r) * KST + ks * 16 + 8 * h);
      sa = MFMA(a0, qf[ks], sa);
      sb = MFMA(a1, qf[ks], sb);
    }
    if (sg.masked) {
      const int qpos = qpos0 + qi;
      const int kb = sg.pos0 + off;
#pragma unroll
      for (int g = 0; g < 16; ++g) {
        int d0 = kb + crow(g, h) - qpos, d1 = d0 + 32;
        if (d0 > 128 || d0 < -128) sa[g] = -INFINITY;
        if (d1 > 128 || d1 < -128) sb[g] = -INFINITY;
      }
    }
    float mx = sa[0];
#pragma unroll
    for (int g = 1; g < 16; ++g) mx = fmaxf(mx, sa[g]);
#pragma unroll
    for (int g = 0; g < 16; ++g) mx = fmaxf(mx, sb[g]);
    mx = fmaxf(mx, __shfl_xor(mx, 32));
    const float mn = fmaxf(m, mx);
    const float alpha = __builtin_amdgcn_exp2f(m - mn);
    m = mn;
    float ps = 0.f;
#pragma unroll
    for (int g = 0; g < 16; ++g) { sa[g] = __builtin_amdgcn_exp2f(sa[g] - mn); ps += sa[g]; }
#pragma unroll
    for (int g = 0; g < 16; ++g) { sb[g] = __builtin_amdgcn_exp2f(sb[g] - mn); ps += sb[g]; }
    l = l * alpha + ps;
#pragma unroll
    for (int g = 0; g < 16; ++g) { o0[g] *= alpha; o1[g] *= alpha; }
#pragma unroll
    for (int kt = 0; kt < 2; ++kt) {
#pragma unroll
      for (int s = 0; s < 2; ++s) {
        const f32x16& sv = kt == 0 ? sa : sb;
        uint4 pu;
        pu.x = pack2(sv[8 * s + 0], sv[8 * s + 1]); pu.y = pack2(sv[8 * s + 2], sv[8 * s + 3]);
        pu.z = pack2(sv[8 * s + 4], sv[8 * s + 5]); pu.w = pack2(sv[8 * s + 6], sv[8 * s + 7]);
        bf16x8 pf = __builtin_bit_cast(bf16x8, pu);
        const lds_cptr vp = vp0 + (kt * 32 + 16 * s) * (VST * 2);
        {
          s16x4 lo = ATT_VTR(vp);
          s16x4 hi = ATT_VTR(vp + 8 * VST * 2);
          bf16x8 vf = __builtin_shufflevector(lo, hi, 0, 1, 2, 3, 4, 5, 6, 7);
          o0 = MFMA(vf, pf, o0);
        }
        {
          s16x4 lo = ATT_VTR(vp + 64);
          s16x4 hi = ATT_VTR(vp + 8 * VST * 2 + 64);
          bf16x8 vf = __builtin_shufflevector(lo, hi, 0, 1, 2, 3, 4, 5, 6, 7);
          o1 = MFMA(vf, pf, o1);
        }
      }
    }
  };
  ATT_LOADX(0, kreg0, kreg1, vreg0);
  ATT_LOADX(1, krgB0, krgB1, vrgB0);
  for (int i = 0; i < NT; i += 2) {
    __syncthreads();
    ATT_STOREX(kreg0, kreg1, vreg0);
    __syncthreads();
    if (i + 2 < NT) ATT_LOADX(i + 2, kreg0, kreg1, vreg0);
    compute(i);
    __syncthreads();
    ATT_STOREX(krgB0, krgB1, vrgB0);
    __syncthreads();
    if (i + 3 < NT) ATT_LOADX(i + 3, krgB0, krgB1, vrgB0);
    compute(i + 1);
  }
  float lt = l + __shfl_xor(l, 32);
  if (has_sink) lt += __builtin_amdgcn_exp2f(sinkl2 - m);
  const float inv = 1.f / lt;
#pragma unroll
  for (int g = 0; g < 4; ++g) {
    uint2 w;
    w.x = pack2(o0[4 * g] * inv, o0[4 * g + 1] * inv); w.y = pack2(o0[4 * g + 2] * inv, o0[4 * g + 3] * inv);
    *(uint2*)(out + (size_t)qi * ldo + 8 * g + 4 * h) = w;
    w.x = pack2(o1[4 * g] * inv, o1[4 * g + 1] * inv); w.y = pack2(o1[4 * g + 2] * inv, o1[4 * g + 3] * inv);
    *(uint2*)(out + (size_t)qi * ldo + 32 + 8 * g + 4 * h) = w;
  }
}

DI void mla_attn(const Params& p, int idx, char* lds) {
  const u16* QD = (const u16*)(p.ws + O_QD);
  const u16* KVD = (const u16*)(p.ws + O_KVD);
  const u16* KR = (const u16*)(p.ws + O_KR);
  u16* act = (u16*)(p.ws + O_ACT);
  Seg lat, cx;
  int b, hh, row0;
  bool is_ctx = idx >= 2048;
  if (!is_ctx) { b = idx >> 7; hh = (idx >> 5) & 3; row0 = b * TT + (idx & 31) * 128; }
  else { int q = idx - 2048; b = q >> 3; hh = (q >> 1) & 3; row0 = NLAT + b * LC + (q & 1) * 128; }
  const size_t lr = (size_t)b * TT, cr = (size_t)NLAT + b * LC;
  lat.k = KVD + lr * KVP + hh * 128; lat.ldk = KVP; lat.k2 = KR + lr * 32; lat.ldk2 = 32; lat.v = KVD + lr * KVP + hh * 128 + 64;
  lat.ldv = KVP; lat.n = TT; lat.pos0 = 0; lat.masked = 0;
  cx.k = KVD + cr * KVP + hh * 128; cx.ldk = KVP; cx.k2 = KR + cr * 32; cx.ldk2 = 32; cx.v = KVD + cr * KVP + hh * 128 + 64;
  cx.ldv = KVP; cx.n = LC; cx.pos0 = 0; cx.masked = 0;
  const u16* q = QD + (size_t)row0 * 384 + hh * 96;
  u16* o = act + (size_t)row0 * AP + 768 + hh * 64;
  if (!is_ctx) attn_tile<96>(q, 384, 0, lat, cx, 2, false, 0.f, o, AP, lds);
  else attn_tile<96>(q, 384, 0, cx, cx, 1, false, 0.f, o, AP, lds);
}

DI void swa_attn(const Params& p, int layer, int idx, char* lds) {
  const u16* QA = (const u16*)(p.ws + O_QA);
  const u16* KA = (const u16*)(p.ws + O_KA);
  const u16* Z = (const u16*)(p.ws + O_Z);
  u16* act = (u16*)(p.ws + O_ACT);
  Seg loc, cx;
  int b, hh, row0, pos0q;
  bool is_ctx = idx >= 2048;
  int nb = 0;
  if (!is_ctx) { b = idx >> 7; hh = ((idx >> 6) & 1) * 2 + (idx & 1); nb = (idx >> 1) & 31; pos0q = nb * 128; row0 = b * TT + pos0q; }
  else { int q = idx - 2048; b = q >> 3; hh = (q >> 1) & 3; pos0q = TT + (q & 1) * 128; row0 = NLAT + b * LC + (q & 1) * 128; }
  const int hk = hh >> 1;
  const u16* kbase = KA + (size_t)(b * 2 + hk) * NPOS * 64;
  cx.k = kbase + (size_t)TT * 64; cx.ldk = 64; cx.k2 = cx.k; cx.ldk2 = 64;
  cx.v = Z + ((size_t)NLAT + b * LC) * ZW + C_AV + hk * 64; cx.ldv = ZW; cx.n = LC; cx.pos0 = 0; cx.masked = 0;
  const float sinkl2 = p.swa_sink[layer * 4 + hh] * LOG2E;
  const u16* q = QA + ((size_t)(b * 4 + hh) * NPOS + pos0q) * 64;
  u16* o = act + (size_t)row0 * AP + hh * 64;
  if (!is_ctx) {
    int ks = nb * 128 - 128; if (ks < 0) ks = 0;
    int ke = nb * 128 + 256; if (ke > TT) ke = TT;
    loc.k = kbase + (size_t)ks * 64; loc.ldk = 64; loc.k2 = loc.k; loc.ldk2 = 64;
    loc.v = Z + ((size_t)b * TT + ks) * ZW + C_AV + hk * 64; loc.ldv = ZW; loc.n = ke - ks; loc.pos0 = ks; loc.masked = 1;
    attn_tile<64>(q, 64, pos0q, loc, cx, 2, true, sinkl2, o, AP, lds);
  } else {
    attn_tile<64>(q, 64, 0, cx, cx, 1, true, sinkl2, o, AP, lds);
  }
}

constexpr int LS = 72;
template <int KS>
DI f32x16 mm64(const u16* A, int lda, const u16* Bt, int ldb, int wm, int wn, int r, int h) {
  f32x16 acc = zero16();
#pragma unroll
  for (int s = 0; s < KS; ++s) {
    bf16x8 a = *(const bf16x8*)(A + (wm * 32 + r) * lda + s * 16 + 8 * h);
    bf16x8 b = *(const bf16x8*)(Bt + (wn * 32 + r) * ldb + s * 16 + 8 * h);
    acc = MFMA(a, b, acc);
  }
  return acc;
}
DI void st_straight(u16* D, int ld, const f32x16& v, int wm, int wn, int r, int h) {
#pragma unroll
  for (int g = 0; g < 16; ++g) D[(wm * 32 + crow(g, h)) * ld + wn * 32 + r] = f2bf(v[g]);
}
DI void st_transp(u16* D, int ld, const f32x16& v, int wm, int wn, int r, int h) {
#pragma unroll
  for (int g = 0; g < 4; ++g) {
    uint2 w;
    w.x = pack2(v[4 * g], v[4 * g + 1]); w.y = pack2(v[4 * g + 2], v[4 * g + 3]);
    *(uint2*)(D + (wn * 32 + r) * ld + wm * 32 + 8 * g + 4 * h) = w;
  }
}

template <int KS>
DI f32x16 mm64t(const u16* AT, int lda, const u16* Bt, int ldb, int wm, int wn, int r, int h, int lane) {
  typedef __attribute__((address_space(3))) const char* lds_cptr;
  typedef short v4i16_t __attribute__((ext_vector_type(4)));
  const lds_cptr base = (lds_cptr)AT + ((lane & 15) >> 2) * (lda * 2) + (wm * 32 + ((lane >> 4) & 1) * 16) * 2 + (lane & 3) * 8;
  f32x16 acc = zero16();
#pragma unroll
  for (int s = 0; s < KS; ++s) {
    s16x4 lo = __builtin_bit_cast(s16x4, __builtin_amdgcn_ds_read_tr16_b64_v4i16((__attribute__((address_space(3))) v4i16_t*)(base + (16 * s + 8 * h) * (lda * 2))));
    s16x4 hi = __builtin_bit_cast(s16x4, __builtin_amdgcn_ds_read_tr16_b64_v4i16((__attribute__((address_space(3))) v4i16_t*)(base + (16 * s + 8 * h + 4) * (lda * 2))));
    bf16x8 a = __builtin_shufflevector(lo, hi, 0, 1, 2, 3, 4, 5, 6, 7);
    bf16x8 b = *(const bf16x8*)(Bt + (wn * 32 + r) * ldb + s * 16 + 8 * h);
    acc = MFMA(a, b, acc);
  }
  return acc;
}

template <int KS, bool ATR, bool BTR>
DI f32x16 mm64x(const u16* A, int lda, const u16* B, int ldb, int wm, int wn, int r, int h, int lane) {
  typedef __attribute__((address_space(3))) const char* lds_cptr;
  typedef short v4i16_t __attribute__((ext_vector_type(4)));
  const int sub = ((lane & 15) >> 2), cb = ((lane >> 4) & 1) * 16, pb = (lane & 3) * 8;
  const lds_cptr abase = (lds_cptr)A + sub * (lda * 2) + (wm * 32 + cb) * 2 + pb;
  const lds_cptr bbase = (lds_cptr)B + sub * (ldb * 2) + (wn * 32 + cb) * 2 + pb;
  f32x16 acc = zero16();
#pragma unroll
  for (int s = 0; s < KS; ++s) {
    bf16x8 a, b;
    if (ATR) {
      s16x4 lo = __builtin_bit_cast(s16x4, __builtin_amdgcn_ds_read_tr16_b64_v4i16((__attribute__((address_space(3))) v4i16_t*)(abase + (16 * s + 8 * h) * (lda * 2))));
      s16x4 hi = __builtin_bit_cast(s16x4, __builtin_amdgcn_ds_read_tr16_b64_v4i16((__attribute__((address_space(3))) v4i16_t*)(abase + (16 * s + 8 * h + 4) * (lda * 2))));
      a = __builtin_shufflevector(lo, hi, 0, 1, 2, 3, 4, 5, 6, 7);
    } else {
      a = *(const bf16x8*)(A + (wm * 32 + r) * lda + s * 16 + 8 * h);
    }
    if (BTR) {
      s16x4 lo = __builtin_bit_cast(s16x4, __builtin_amdgcn_ds_read_tr16_b64_v4i16((__attribute__((address_space(3))) v4i16_t*)(bbase + (16 * s + 8 * h) * (ldb * 2))));
      s16x4 hi = __builtin_bit_cast(s16x4, __builtin_amdgcn_ds_read_tr16_b64_v4i16((__attribute__((address_space(3))) v4i16_t*)(bbase + (16 * s + 8 * h + 4) * (ldb * 2))));
      b = __builtin_shufflevector(lo, hi, 0, 1, 2, 3, 4, 5, 6, 7);
    } else {
      b = *(const bf16x8*)(B + (wn * 32 + r) * ldb + s * 16 + 8 * h);
    }
    acc = MFMA(a, b, acc);
  }
  return acc;
}
DI void st8s(u16* dst, const uint4& v, float f) {
  uint4 o;
  o.x = pack2(bflo(v.x) * f, bfhi(v.x) * f); o.y = pack2(bflo(v.y) * f, bfhi(v.y) * f);
  o.z = pack2(bflo(v.z) * f, bfhi(v.z) * f); o.w = pack2(bflo(v.w) * f, bfhi(v.w) * f);
  *(uint4*)dst = o;
}

DI void dn_chain(const Params& p, int chain, char* lds) {
  int tid_ = VTID;
  asm volatile("" : "+v"(tid_));
  const int tid = tid_, wave = tid >> 6, lane = tid & 63, r = lane & 31, h = lane >> 5;
  const int wm = wave >> 1, wn = wave & 1;
  const int b = chain >> 3, hh = (chain >> 1) & 3, dir = chain & 1;
  u16* kA = (u16*)lds;
  u16* St = kA + 64 * LS;
  u16* R1 = St + 64 * LS;
  u16* R2 = R1 + 64 * LS;
  u16* R3 = R2 + 64 * LS;
  u16* R4 = R3 + 64 * LS;
  u16* R5 = R4 + 64 * LS;
  float* gc = (float*)(R5 + 64 * LS);
  float* bt = gc + 64;
  const u16* QKVB = (const u16*)(p.ws + O_QKVB);
  const float* G2 = (const float*)(p.ws + O_G2);
  u16* OUT = dir ? (u16*)(p.ws + O_OB) : (u16*)(p.ws + O_ACT) + 256;
  const int opitch = dir ? 256 : AP;
  __syncthreads();
  for (int e = tid; e < 64 * LS / 2; e += 256) ((u32*)St)[e] = 0u;
  f32x16 S = zero16();
  const int lc = tid >> 3, lp = (tid & 7) * 8;
  auto rowof = [&](int n, int c) -> int {
    int cn, base, len;
    if (n < 4) { cn = n; base = NLAT + b * LC; len = LC; } else { cn = n - 4; base = b * TT; len = TT; }
    int pos = cn * 64 + c;
    return base + (dir ? len - 1 - pos : pos);
  };
  uint4 pk0, pk1, pq0, pq1, pv0, pv1;
  float pg = 0.f, pb = 0.f;
#define DN_LOAD(n)                                                                      \
  {                                                                                     \
    const u16* s0_ = QKVB + (size_t)rowof((n), lc) * 768 + hh * 64 + lp;                \
    const u16* s1_ = QKVB + (size_t)rowof((n), lc + 32) * 768 + hh * 64 + lp;           \
    pq0 = *(const uint4*)s0_; pk0 = *(const uint4*)(s0_ + 256); pv0 = *(const uint4*)(s0_ + 512); \
    pq1 = *(const uint4*)s1_; pk1 = *(const uint4*)(s1_ + 256); pv1 = *(const uint4*)(s1_ + 512); \
    if (tid < 64) {                                                                     \
      const float* g_ = G2 + (size_t)rowof((n), tid) * 16 + dir * 4 + hh;               \
      pg = g_[0]; pb = g_[8];                                                           \
    }                                                                                   \
  }
  DN_LOAD(0);
  for (int n = 0; n < 68; ++n) {
    const uint4 ck0 = pk0, ck1 = pk1, cq0 = pq0, cq1 = pq1, cv0 = pv0, cv1 = pv1;
    float cgv = pg, cbv = pb;
    __syncthreads();
    if (tid < 64) {
      float v = cgv;
#pragma unroll
      for (int o = 1; o < 64; o <<= 1) { float t = __shfl_up(v, o); if (lane >= o) v += t; }
      gc[tid] = v; bt[tid] = cbv;
    }
    *(uint4*)(kA + lc * LS + lp) = ck0;
    *(uint4*)(kA + (lc + 32) * LS + lp) = ck1;
    if (n + 1 < 68) DN_LOAD(n + 1);
    __syncthreads();
    const float gl = gc[63];
    f32x16 T;
    {
      f32x16 kk = mm64<4>(kA, LS, kA, LS, wm, wn, r, h);
      const int s = wn * 32 + r;
      const float gs = gc[s];
#pragma unroll
      for (int g = 0; g < 16; ++g) {
        int c = wm * 32 + crow(g, h);
        float v = (s < c) ? bt[c] * kk[g] * __expf(gc[c] - gs) : 0.f;
        kk[g] = v;
        T[g] = (c == s) ? 1.f : (((c >> 1) == (s >> 1)) ? -v : 0.f);
      }
      st_transp(R1, LS, kk, wm, wn, r, h);
      st_transp(R2, LS, T, wm, wn, r, h);
    }
    __syncthreads();
    for (int k = 1; k < 6; ++k) {
      f32x16 M = mm64t<4>(R1, LS, R2, LS, wm, wn, r, h, lane);
      st_transp(R4, LS, M, wm, wn, r, h);
      __syncthreads();
      f32x16 X = mm64t<4>(R2, LS, R4, LS, wm, wn, r, h, lane);
      {
        const int s = wn * 32 + r;
#pragma unroll
        for (int g = 0; g < 16; ++g) {
          int c = wm * 32 + crow(g, h);
          if ((c >> (k + 1)) == (s >> (k + 1)) && (c >> k) != (s >> k)) T[g] -= X[g];
        }
      }
      __syncthreads();
      st_transp(R2, LS, T, wm, wn, r, h);
      __syncthreads();
    }
    {
      const float fb0 = bt[lc], fk0 = fb0 * __expf(gc[lc]);
      const float fb1 = bt[lc + 32], fk1 = fb1 * __expf(gc[lc + 32]);
      st8s(R1 + lc * LS + lp, ck0, fk0);
      st8s(R1 + (lc + 32) * LS + lp, ck1, fk1);
      st8s(R3 + lc * LS + lp, cv0, fb0);
      st8s(R3 + (lc + 32) * LS + lp, cv1, fb1);
    }
    __syncthreads();
    f32x16 W = mm64x<4, true, true>(R2, LS, R1, LS, wm, wn, r, h, lane);
    f32x16 U = mm64x<4, true, true>(R2, LS, R3, LS, wm, wn, r, h, lane);
    st_transp(R4, LS, W, wm, wn, r, h);
    __syncthreads();
    {
      f32x16 ws = mm64t<4>(R4, LS, St, LS, wm, wn, r, h, lane);
#pragma unroll
      for (int g = 0; g < 16; ++g) U[g] -= ws[g];
      st_transp(R1, LS, U, wm, wn, r, h);
    }
    *(uint4*)(R2 + lc * LS + lp) = cq0;
    *(uint4*)(R2 + (lc + 32) * LS + lp) = cq1;
    st8s(R5 + lc * LS + lp, ck0, __expf(gl - gc[lc]));
    st8s(R5 + (lc + 32) * LS + lp, ck1, __expf(gl - gc[lc + 32]));
    __syncthreads();
    {
      f32x16 qk = mm64<4>(R2, LS, kA, LS, wm, wn, r, h);
      const int s = wn * 32 + r;
      const float gs = gc[s];
#pragma unroll
      for (int g = 0; g < 16; ++g) {
        int c = wm * 32 + crow(g, h);
        qk[g] = (s <= c) ? qk[g] * __expf(gc[c] - gs) : 0.f;
      }
      st_transp(R3, LS, qk, wm, wn, r, h);
    }
    __syncthreads();
    {
      f32x16 o1 = mm64<4>(R2, LS, St, LS, wm, wn, r, h);
      f32x16 o2 = mm64t<4>(R3, LS, R1, LS, wm, wn, r, h, lane);
      f32x16 sn = mm64x<4, true, false>(R5, LS, R1, LS, wm, wn, r, h, lane);
      const float egl = __expf(gl);
#pragma unroll
      for (int g = 0; g < 16; ++g) {
        int c = wm * 32 + crow(g, h);
        float ov = o1[g] * __expf(gc[c]) + o2[g];
        OUT[(size_t)rowof(n, c) * opitch + hh * 64 + wn * 32 + r] = f2bf(ov);
        S[g] = S[g] * egl + sn[g];
      }
    }
    __syncthreads();
    st_transp(St, LS, S, wm, wn, r, h);
  }
}

DI void ret_chain(const Params& p, int layer, int chain, char* lds) {
  int tid_ = VTID;
  asm volatile("" : "+v"(tid_));
  const int tid = tid_, wave = tid >> 6, lane = tid & 63, r = lane & 31, h = lane >> 5;
  const int wm = wave >> 1, wn = wave & 1;
  const int b = chain >> 3, hh = (chain >> 1) & 3, dir = chain & 1;
  constexpr int L4 = 40;
  u16* qA = (u16*)lds;
  u16* kA = qA + 64 * L4;
  u16* ks = kA + 64 * L4;
  u16* vs = ks + 64 * LS;
  u16* QK = vs + 64 * LS;
  u16* Rt = QK + 64 * LS;
  const u16* QC = (const u16*)(p.ws + O_QC);
  const u16* KC = (const u16*)(p.ws + O_KC);
  const u16* Z = (const u16*)(p.ws + O_Z);
  u16* OUT = dir ? (u16*)(p.ws + O_ORB) : (u16*)(p.ws + O_ACT) + 512;
  const int opitch = dir ? 256 : AP;
  const int lc = tid >> 2, lp4 = (tid & 3) * 8;
  const int vc = tid >> 3, vp = (tid & 7) * 8;
  const float lg = log1pf(-expf(p.ret_l1m[layer * 8 + dir * 4 + hh]));
  f32x16 R = zero16();
  auto rowof = [&](int n, int c) -> int {
    int cn, base, len;
    if (n < 4) { cn = n; base = NLAT + b * LC; len = LC; } else { cn = n - 4; base = b * TT; len = TT; }
    int pos = cn * 64 + c;
    return base + (dir ? len - 1 - pos : pos);
  };
  uint4 pq, pk, pv0, pv1;
#define RET_LOAD(n)                                                                                   \
  {                                                                                                   \
    const int row_ = rowof((n), lc);                                                                  \
    pq = *(const uint4*)(QC + (size_t)row_ * 128 + hh * 32 + lp4);                                    \
    pk = *(const uint4*)(KC + (size_t)row_ * 128 + hh * 32 + lp4);                                    \
    pv0 = *(const uint4*)(Z + (size_t)rowof((n), vc) * ZW + C_CV + hh * 64 + vp);                     \
    pv1 = *(const uint4*)(Z + (size_t)rowof((n), vc + 32) * ZW + C_CV + hh * 64 + vp);                \
  }
  RET_LOAD(0);
  for (int n = 0; n < 68; ++n) {
    __syncthreads();
    *(uint4*)(qA + lc * L4 + lp4) = pq;
    *(uint4*)(kA + lc * L4 + lp4) = pk;
    st8s(ks + lc * L4 + lp4, pk, __expf((float)(63 - lc) * lg));
    *(uint4*)(vs + vc * LS + vp) = pv0;
    *(uint4*)(vs + (vc + 32) * LS + vp) = pv1;
    if (wm == 0) st_transp(Rt, L4, R, wm, wn, r, h);
    if (n + 1 < 68) RET_LOAD(n + 1);
    __syncthreads();
    {
      f32x16 qk = mm64<2>(qA, L4, kA, L4, wm, wn, r, h);
      const int s = wn * 32 + r;
#pragma unroll
      for (int g = 0; g < 16; ++g) {
        int c = wm * 32 + crow(g, h);
        qk[g] = (s <= c) ? qk[g] * __expf((float)(c - s) * lg) : 0.f;
      }
      st_transp(QK, LS, qk, wm, wn, r, h);
    }
    __syncthreads();
    {
      f32x16 o1 = mm64x<4, true, true>(QK, LS, vs, LS, wm, wn, r, h, lane);
      f32x16 o2 = mm64<2>(qA, L4, Rt, L4, wm, wn, r, h);
      const float gch = __expf(64.f * lg);
#pragma unroll
      for (int g = 0; g < 16; ++g) {
        int c = wm * 32 + crow(g, h);
        float ov = o1[g] + __expf((float)(c + 1) * lg) * o2[g];
        OUT[(size_t)rowof(n, c) * opitch + hh * 64 + wn * 32 + r] = f2bf(ov);
      }
      if (wm == 0) {
        f32x16 rn = mm64x<4, true, true>(ks, L4, vs, LS, wm, wn, r, h, lane);
#pragma unroll
        for (int g = 0; g < 16; ++g) R[g] = R[g] * gch + rn[g];
      }
    }
  }
}

DI void mixer_phase(const Params& p, int layer, char* lds, char* lds_all, int* s_tile) {
  int* cnt = (int*)(p.ws + O_CNT) + layer;
  const int nattn = layer == 0 ? 2176 : 2048;
  const int total = 128 + 128 + 2 * nattn;
  for (;;) {
    __syncthreads();
    if (threadIdx.x == 0) *s_tile = atomicAdd(cnt, 1);
    __syncthreads();
    const int t = 2 * (*s_tile) + VHALF;
    if (t >= total) break;
    if (t < 128) dn_chain(p, t, lds);
    else if (t < 256) ret_chain(p, layer, t - 128, lds);
    else if (t < 256 + nattn) mla_attn(p, t - 256, lds_all);
    else swa_attn(p, layer, t - 256 - nattn, lds_all);
  }
}

DI void dn_finalize(const Params& p, int layer, int nrows) {
  int tid_ = VTID;
  asm volatile("" : "+v"(tid_));
  const int tid = tid_;
  const u16* OB = (const u16*)(p.ws + O_OB);
  const u16* Z = (const u16*)(p.ws + O_Z);
  u16* act = (u16*)(p.ws + O_ACT);
  const int ntask = nrows * 32, stride = VG * 256;
  for (int id0 = VB * 256 + tid; id0 < ntask; id0 += 4 * stride) {
    u32x4 a[4], b[4], z[4];
#pragma unroll
    for (int u = 0; u < 4; ++u) {
      const int id = id0 + u * stride;
      const bool ok = id < ntask;
      const int row = ok ? (id >> 5) : 0, c8 = id & 31;
      a[u] = ldg16(act + (size_t)row * AP + 256 + c8 * 8);
      b[u] = ldg16(OB + (size_t)row * 256 + c8 * 8);
      z[u] = ldg16(Z + (size_t)row * ZW + C_BZ + c8 * 8);
    }
#pragma unroll
    for (int u = 0; u < 4; ++u) {
      const int id = id0 + u * stride;
      const int row = id >> 5, c8 = id & 31;
      float fa[8], fb[8], fz[8], o[8];
      unpack8(a[u], fa); unpack8(b[u], fb); unpack8(z[u], fz);
      float ss = 0.f;
#pragma unroll
      for (int e = 0; e < 8; ++e) { o[e] = fa[e] + fb[e]; ss += o[e] * o[e]; }
      ss += __shfl_xor(ss, 1); ss += __shfl_xor(ss, 2); ss += __shfl_xor(ss, 4);
      const float rn = rsqrtf(ss * (1.f / 64.f) + 1e-6f);
      const float4 g0 = *(const float4*)(p.dn_norm_g + layer * 64 + (c8 & 7) * 8), g1 = *(const float4*)(p.dn_norm_g + layer * 64 + (c8 & 7) * 8 + 4);
      const float gg[8] = {g0.x, g0.y, g0.z, g0.w, g1.x, g1.y, g1.z, g1.w};
#pragma unroll
      for (int e = 0; e < 8; ++e) o[e] = o[e] * rn * gg[e] * siluf(fz[e]);
      if (id < ntask) *(u32x4*)(act + (size_t)row * AP + 256 + c8 * 8) = pack8(o);
    }
  }
  const u16* ORB = (const u16*)(p.ws + O_ORB);
  for (int id0 = VB * 256 + tid; id0 < ntask; id0 += 4 * stride) {
    u32x4 a[4], b[4], z[4];
#pragma unroll
    for (int u = 0; u < 4; ++u) {
      const int id = id0 + u * stride;
      const bool ok = id < ntask;
      const int row = ok ? (id >> 5) : 0, c8 = id & 31;
      a[u] = ldg16(act + (size_t)row * AP + 512 + c8 * 8);
      b[u] = ldg16(ORB + (size_t)row * 256 + c8 * 8);
      z[u] = ldg16(Z + (size_t)row * ZW + C_CG + c8 * 8);
    }
#pragma unroll
    for (int u = 0; u < 4; ++u) {
      const int id = id0 + u * stride;
      const int row = id >> 5, c8 = id & 31;
      float fa[8], fb[8], fz[8], o[8];
      unpack8(a[u], fa); unpack8(b[u], fb); unpack8(z[u], fz);
      float sm = 0.f;
#pragma unroll
      for (int e = 0; e < 8; ++e) { o[e] = fa[e] + fb[e]; sm += o[e]; }
      sm += __shfl_xor(sm, 1); sm += __shfl_xor(sm, 2); sm += __shfl_xor(sm, 4);
      const float mean = sm * (1.f / 64.f);
      float ss = 0.f;
#pragma unroll
      for (int e = 0; e < 8; ++e) { o[e] -= mean; ss += o[e] * o[e]; }
      ss += __shfl_xor(ss, 1); ss += __shfl_xor(ss, 2); ss += __shfl_xor(ss, 4);
      const float rn = rsqrtf(ss * (1.f / 64.f) + 1e-6f);
      const float4 g0 = *(const float4*)(p.ret_norm_g + layer * 256 + c8 * 8), g1 = *(const float4*)(p.ret_norm_g + layer * 256 + c8 * 8 + 4);
      const float gg[8] = {g0.x, g0.y, g0.z, g0.w, g1.x, g1.y, g1.z, g1.w};
#pragma unroll
      for (int e = 0; e < 8; ++e) o[e] = o[e] * rn * gg[e] * siluf(fz[e]);
      if (id < ntask) *(u32x4*)(act + (size_t)row * AP + 512 + c8 * 8) = pack8(o);
    }
  }
}

DI void gbar(const Params& p, unsigned& target) {
  unsigned* bar = (unsigned*)(p.ws + O_CNT + 128);
  target += gridDim.x;
  __syncthreads();
  if (threadIdx.x == 0) {
    __builtin_amdgcn_fence(__ATOMIC_RELEASE, "agent");
    __hip_atomic_fetch_add(bar, 1u, __ATOMIC_RELAXED, __HIP_MEMORY_SCOPE_AGENT);
    while (__hip_atomic_load(bar, __ATOMIC_RELAXED, __HIP_MEMORY_SCOPE_AGENT) < target) __builtin_amdgcn_s_sleep(2);
    __builtin_amdgcn_fence(__ATOMIC_ACQUIRE, "agent");
  }
  __syncthreads();
}

__global__ void __launch_bounds__(512, 2) fwd_megakernel(Params p) {
  __shared__ __attribute__((aligned(16))) char lds_all[2 * LDS_BYTES];
  __shared__ int s_tile;
  char* lds = lds_all + VHALF * LDS_BYTES;
  cg::grid_group grid = cg::this_grid();
  if (p.ws == nullptr) grid.sync();
  unsigned bt = 0;
  phase0a(p, lds);
  gbar(p, bt);
  modulate_rows(p, 0, ROWS);
  gbar(p, bt);
  for (int layer = 0; layer < 2; ++layer) {
    const int nrows = layer == 0 ? ROWS : NLAT;
    gemm_phase(p, layer, 0, ROWS, lds_all);
    gbar(p, bt);
    prep_phase(p, layer, lds);
    gbar(p, bt);
    mixer_phase(p, layer, lds, lds_all, &s_tile);
    gbar(p, bt);
    dn_finalize(p, layer, nrows);
    gbar(p, bt);
    gemm_phase(p, layer, 1, nrows, lds_all);
    gbar(p, bt);
    ln_rows(p, p.ln1_g + layer * DM, p.ln1_b + layer * DM, nrows, layer, 3, true);
    gbar(p, bt);
    gemm_phase(p, layer, 2, nrows, lds_all);
    gbar(p, bt);
    gemm_phase(p, layer, 3, nrows, lds_all);
    gbar(p, bt);
    ln_rows(p, p.ln2_g + layer * DM, p.ln2_b + layer * DM, nrows, layer == 0 ? 1 : 0, 0, layer == 0);
    if (layer == 0) gbar(p, bt);
  }
}

extern "C" void kernel_launch(void* const* d_in, const int* in_sizes, int n_in, void* d_out, int out_size, void* d_ws,
                              size_t ws_size, hipStream_t stream) {
  static int grid_blocks = 0;
  if (!grid_blocks) {
    int dev = 0, cus = 0, per_cu = 0;
    hipGetDevice(&dev);
    hipDeviceGetAttribute(&cus, hipDeviceAttributeMultiprocessorCount, dev);
    hipOccupancyMaxActiveBlocksPerMultiprocessor(&per_cu, fwd_megakernel, 512, 0);
    if (per_cu < 1) per_cu = 1;
    if (per_cu > 1) per_cu = 1;
    grid_blocks = cus * per_cu;
    if (ws_size < WS_END) fprintf(stderr, "kernel_launch: workspace too small: %zu < %zu\n", ws_size, (size_t)WS_END);
  }
  Params p{};
  const float** f = (const float**)&p;
  for (int i = 0; i < 25; ++i) f[i] = (const float*)d_in[i];
  p.out = (float*)d_out;
  p.ws = (unsigned char*)d_ws;
  hipMemsetAsync((char*)d_ws + O_CNT, 0, 256, stream);
  void* args[] = {&p};
  hipError_t e = hipLaunchCooperativeKernel((void*)fwd_megakernel, dim3(grid_blocks), dim3(512), args, 0, stream);
  if (e != hipSuccess) fprintf(stderr, "cooperative launch failed: %s (grid %d)\n", hipGetErrorString(e), grid_blocks);
}
```

```cpp
#include <hip/hip_runtime.h>
#include <hip/hip_cooperative_groups.h>
#include <cstdio>
namespace cg = cooperative_groups;

#define DI __device__ __forceinline__
typedef unsigned short u16;
typedef unsigned int u32;
using bf16x8 = __attribute__((ext_vector_type(8))) short;
using s16x4 = __attribute__((ext_vector_type(4))) short;
using f32x16 = __attribute__((ext_vector_type(16))) float;
typedef __bf16 bfv2 __attribute__((ext_vector_type(2)));
typedef float flv2 __attribute__((ext_vector_type(2)));
#define MFMA(a, b, c) __builtin_amdgcn_mfma_f32_32x32x16_bf16((a), (b), (c), 0, 0, 0)
#define VHALF ((int)__builtin_amdgcn_readfirstlane((int)(threadIdx.x >> 8)))
#define VTID ((int)(threadIdx.x & 255))
#define VB ((int)(blockIdx.x * 2 + VHALF))
#define VG ((int)(gridDim.x * 2))

constexpr int NB = 16, TT = 4096, LC = 256, DM = 1024, NLAT = NB * TT, NCTX = NB * LC, ROWS = NLAT + NCTX;
constexpr int ZW = 2816, DFF = 4096, NPOS = TT + LC;
constexpr int AP = 1152;
constexpr int WP = 1152;
constexpr int WP2 = 4224;
constexpr int HP = 4224;
constexpr int KVP = 576;
constexpr float LOG2E = 1.4426950408889634f;
constexpr float DN_ALPHA = 1.4142135623730951f;
constexpr int C_AQ = 0, C_AK = 256, C_AV = 384, C_BQKV = 512, C_BZ = 1280, C_BAB = 1536, C_CQ = 1552, C_CK = 1680,
              C_CV = 1808, C_CG = 2064, C_DCQ = 2320, C_DCKV = 2576, C_DKR = 2704;

constexpr size_t al256(size_t x) { return (x + 255) & ~size_t(255); }
constexpr size_t SZ_WIN = (size_t)ZW * WP * 2, SZ_WOUT = (size_t)DM * WP * 2, SZ_WFF = (size_t)DFF * WP * 2,
                 SZ_WUQ = 384 * 256 * 2, SZ_WUKV = 512 * 128 * 2;
constexpr size_t O_WIN = 0;
constexpr size_t O_WOUT = O_WIN + 2 * SZ_WIN;
constexpr size_t O_WFF1 = O_WOUT + 2 * SZ_WOUT;
constexpr size_t O_WFF2 = O_WFF1 + 2 * SZ_WFF;
constexpr size_t O_WUQ = O_WFF2 + 2 * SZ_WFF;
constexpr size_t O_WUKV = O_WUQ + 2 * SZ_WUQ;
constexpr size_t O_MOD = O_WUKV + 2 * SZ_WUKV;
constexpr size_t O_TAB = al256(O_MOD + 2 * 17 * 6144 * 4);
constexpr size_t O_CNT = O_TAB + (size_t)TT * 64 * 8;
constexpr size_t O_GRAW = O_CNT + 256;
constexpr size_t O_G2 = O_GRAW + (size_t)ROWS * 16 * 4;
constexpr size_t O_XC = O_G2 + (size_t)ROWS * 16 * 4;
constexpr size_t O_ACT = O_XC + (size_t)NCTX * DM * 4;
constexpr size_t O_Z = O_ACT + (size_t)ROWS * AP * 2;
constexpr size_t O_QA = O_Z + (size_t)ROWS * ZW * 2;
constexpr size_t O_KA = O_QA + (size_t)NB * 4 * NPOS * 64 * 2;
constexpr size_t O_QD = O_KA + (size_t)NB * 2 * NPOS * 64 * 2;
constexpr size_t O_KVD = O_QD + (size_t)ROWS * 384 * 2;
constexpr size_t O_KR = O_KVD + (size_t)ROWS * KVP * 2;
constexpr size_t O_QKVB = O_KR + (size_t)ROWS * 32 * 2;
constexpr size_t O_OB = O_QKVB + (size_t)ROWS * 768 * 2;
constexpr size_t O_QC = O_OB + (size_t)ROWS * 256 * 2;
constexpr size_t O_KC = O_QC + (size_t)ROWS * 128 * 2;
constexpr size_t O_ORB = O_KC + (size_t)ROWS * 128 * 2;
constexpr size_t O_ST = O_ORB + (size_t)ROWS * 256 * 2;
constexpr size_t WS_END = O_ST + (size_t)ROWS * 8;
static_assert(O_Z + (size_t)ROWS * HP * 2 <= WS_END, "hid alias");
static_assert((size_t)DM * WP2 * 2 <= SZ_WFF, "ff2 weights");
static_assert(WS_END <= (size_t)1073741824, "workspace");

constexpr int LDS_BYTES = 73728;

struct Params {
  const float *x, *c, *ctx, *c_ctx, *ada_w, *ada_b, *w_in, *swa_sink, *dn_conv_w, *dn_a_log, *dn_dt_bias, *dn_norm_g,
      *ret_l1m, *ret_norm_g, *mla_q_norm, *mla_w_uq, *mla_kv_norm, *mla_w_ukv, *w_out, *ln1_g, *ln1_b, *w_ff1, *w_ff2,
      *ln2_g, *ln2_b;
  float* out;
  unsigned char* ws;
};

DI u16 f2bf(float x) { return __builtin_bit_cast(u16, (__bf16)x); }
DI float bf2f(u16 v) { return __uint_as_float(((u32)v) << 16); }
DI u32 pack2(float a, float b) {
  flv2 f = {a, b};
  bfv2 v = __builtin_convertvector(f, bfv2);
  return __builtin_bit_cast(u32, v);
}
DI float bflo(u32 u) { return __uint_as_float(u << 16); }
DI float bfhi(u32 u) { return __uint_as_float(u & 0xffff0000u); }
DI int crow(int reg, int h) { return (reg & 3) + 8 * (reg >> 2) + 4 * h; }
DI float wave_sum(float v) {
#pragma unroll
  for (int o = 32; o >= 1; o >>= 1) v += __shfl_xor(v, o);
  return v;
}
DI float siluf(float x) { return x / (1.f + __expf(-x)); }
DI f32x16 zero16() {
  f32x16 z;
#pragma unroll
  for (int i = 0; i < 16; ++i) z[i] = 0.f;
  return z;
}

DI void scat8s(u16* base, int stride, const uint4& v, float f) {
  base[0 * stride] = f2bf(bflo(v.x) * f); base[1 * stride] = f2bf(bfhi(v.x) * f);
  base[2 * stride] = f2bf(bflo(v.y) * f); base[3 * stride] = f2bf(bfhi(v.y) * f);
  base[4 * stride] = f2bf(bflo(v.z) * f); base[5 * stride] = f2bf(bfhi(v.z) * f);
  base[6 * stride] = f2bf(bflo(v.w) * f); base[7 * stride] = f2bf(bfhi(v.w) * f);
}
DI void scat8r(u16* base, int stride, const uint4& v) {
  base[0 * stride] = (u16)(v.x & 0xffffu); base[1 * stride] = (u16)(v.x >> 16);
  base[2 * stride] = (u16)(v.y & 0xffffu); base[3 * stride] = (u16)(v.y >> 16);
  base[4 * stride] = (u16)(v.z & 0xffffu); base[5 * stride] = (u16)(v.z >> 16);
  base[6 * stride] = (u16)(v.w & 0xffffu); base[7 * stride] = (u16)(v.w >> 16);
}
DI float sumsq8(const uint4& u) {
  float s = 0.f, a;
  a = bflo(u.x); s += a * a; a = bfhi(u.x); s += a * a;
  a = bflo(u.y); s += a * a; a = bfhi(u.y); s += a * a;
  a = bflo(u.z); s += a * a; a = bfhi(u.z); s += a * a;
  a = bflo(u.w); s += a * a; a = bfhi(u.w); s += a * a;
  return s;
}
typedef u32 u32x4 __attribute__((ext_vector_type(4)));
DI u32x4 ldg16(const u16* p) { return *(const u32x4*)p; }
DI void unpack8(const u32x4& u, float* f) {
  f[0] = bflo(u[0]); f[1] = bfhi(u[0]); f[2] = bflo(u[1]); f[3] = bfhi(u[1]);
  f[4] = bflo(u[2]); f[5] = bfhi(u[2]); f[6] = bflo(u[3]); f[7] = bfhi(u[3]);
}
DI u32x4 pack8(const float* f) {
  u32x4 o;
  o[0] = pack2(f[0], f[1]); o[1] = pack2(f[2], f[3]); o[2] = pack2(f[4], f[5]); o[3] = pack2(f[6], f[7]);
  return o;
}
DI float* xrow(const Params& p, int row) {
  return row < NLAT ? p.out + (size_t)row * DM : (float*)(p.ws + O_XC) + (size_t)(row - NLAT) * DM;
}
DI const float* xrow0(const Params& p, int row) {
  return row < NLAT ? p.x + (size_t)row * DM : p.ctx + (size_t)(row - NLAT) * DM;
}
DI int rowb(int row) { return row < NLAT ? (row >> 12) : 16; }

constexpr int CSL = 132;
constexpr int GS = 72;
template <typename Epi>
DI void gemm_tile(const u16* __restrict__ A, int lda, const u16* __restrict__ Bt, int ldb, int K, char* lds, Epi epi) {
  u16* As = (u16*)lds;
  u16* Bs = As + 256 * GS;
  float* Cs = (float*)lds;
  int tid_ = VTID;
  asm volatile("" : "+v"(tid_));
  const int tid = tid_, wave = tid >> 6, lane = tid & 63, r = lane & 31, h = lane >> 5;
  const int wm = wave >> 1, wn = wave & 1;
  f32x16 acc[4][2];
#pragma unroll
  for (int i = 0; i < 4; ++i)
#pragma unroll
    for (int j = 0; j < 2; ++j) acc[i][j] = zero16();
  const int lrow = tid >> 3, lcol = (tid & 7) * 8;
  const u16* Ap = A + (size_t)lrow * lda + lcol;
  const u16* Bp = Bt + (size_t)lrow * ldb + lcol;
  u16* Aw = As + lrow * GS + lcol;
  u16* Bw = Bs + lrow * GS + lcol;
  u32x4 ra[8], rb[4];
#define GT_LOAD(k0)                                                                 \
  {                                                                                 \
    _Pragma("unroll") for (int i_ = 0; i_ < 8; ++i_) ra[i_] = ldg16(Ap + (size_t)(i_ * 32) * lda + (k0)); \
    _Pragma("unroll") for (int i_ = 0; i_ < 4; ++i_) rb[i_] = ldg16(Bp + (size_t)(i_ * 32) * ldb + (k0)); \
  }
#define GT_STORE()                                                                  \
  {                                                                                 \
    _Pragma("unroll") for (int i_ = 0; i_ < 8; ++i_) *(u32x4*)(Aw + i_ * 32 * GS) = ra[i_]; \
    _Pragma("unroll") for (int i_ = 0; i_ < 4; ++i_) *(u32x4*)(Bw + i_ * 32 * GS) = rb[i_]; \
  }
#define GT_COMPUTE()                                                                              \
  _Pragma("unroll") for (int ks = 0; ks < 4; ++ks) {                                              \
    bf16x8 fa[4], fb[2];                                                                          \
    _Pragma("unroll") for (int i_ = 0; i_ < 4; ++i_)                                              \
      fa[i_] = *(const bf16x8*)(As + (wm * 128 + i_ * 32 + r) * GS + ks * 16 + 8 * h);            \
    _Pragma("unroll") for (int j_ = 0; j_ < 2; ++j_)                                              \
      fb[j_] = *(const bf16x8*)(Bs + (wn * 64 + j_ * 32 + r) * GS + ks * 16 + 8 * h);             \
    _Pragma("unroll") for (int i_ = 0; i_ < 4; ++i_)                                              \
      _Pragma("unroll") for (int j_ = 0; j_ < 2; ++j_) acc[i_][j_] = MFMA(fa[i_], fb[j_], acc[i_][j_]); \
  }
  const int nk = K >> 6;
  GT_LOAD(0);
  for (int kt = 0; kt + 1 < nk; ++kt) {
    __syncthreads();
    GT_STORE();
    __syncthreads();
    GT_LOAD((kt + 1) << 6);
    GT_COMPUTE();
  }
  __syncthreads();
  GT_STORE();
  __syncthreads();
  GT_COMPUTE();
#pragma unroll 1
  for (int half = 0; half < 2; ++half) {
    __syncthreads();
    if (wm == half) {
#pragma unroll
      for (int i = 0; i < 4; ++i)
#pragma unroll
        for (int j = 0; j < 2; ++j)
#pragma unroll
          for (int g = 0; g < 16; ++g) Cs[(i * 32 + crow(g, h)) * CSL + wn * 64 + j * 32 + r] = acc[i][j][g];
    }
    __syncthreads();
    epi(half);
  }
}

constexpr int CSW = 264;
template <typename Epi>
DI void gemm_tile512(const u16* __restrict__ A, int lda, const u16* __restrict__ Bt, int ldb, int K, char* lds_all, Epi epi) {
  constexpr int STG = 2 * 256 * GS;
  u16* S0 = (u16*)lds_all;
  float* Cs = (float*)lds_all;
  int tid_ = threadIdx.x;
  asm volatile("" : "+v"(tid_));
  const int tid = tid_, wave = tid >> 6, lane = tid & 63, r = lane & 31, h = lane >> 5;
  const int wm = wave >> 2, wn = wave & 3;
  f32x16 acc[4][2];
#pragma unroll
  for (int i = 0; i < 4; ++i)
#pragma unroll
    for (int j = 0; j < 2; ++j) acc[i][j] = zero16();
  const int lrow = tid >> 3, lcol = (tid & 7) * 8;
  const u16* Ap = A + (size_t)lrow * lda + lcol;
  const u16* Bp = Bt + (size_t)lrow * ldb + lcol;
  u16* Sw = S0 + lrow * GS + lcol;
  u32x4 ra[4], rb[4];
#define G5_LOAD(k0)                                                                 \
  {                                                                                 \
    _Pragma("unroll") for (int i_ = 0; i_ < 4; ++i_) ra[i_] = ldg16(Ap + (size_t)(i_ * 64) * lda + (k0)); \
    _Pragma("unroll") for (int i_ = 0; i_ < 4; ++i_) rb[i_] = ldg16(Bp + (size_t)(i_ * 64) * ldb + (k0)); \
  }
#define G5_STORE(s)                                                                 \
  {                                                                                 \
    _Pragma("unroll") for (int i_ = 0; i_ < 4; ++i_) *(u32x4*)(Sw + (s) * STG + i_ * 64 * GS) = ra[i_]; \
    _Pragma("unroll") for (int i_ = 0; i_ < 4; ++i_) *(u32x4*)(Sw + (s) * STG + 256 * GS + i_ * 64 * GS) = rb[i_]; \
  }
#define G5_COMPUTE(s)                                                                             \
  {                                                                                               \
    const u16* As_ = S0 + (s) * STG;                                                              \
    const u16* Bs_ = As_ + 256 * GS;                                                              \
    _Pragma("unroll") for (int ks = 0; ks < 4; ++ks) {                                            \
      bf16x8 fa[4], fb[2];                                                                        \
      _Pragma("unroll") for (int i_ = 0; i_ < 4; ++i_)                                            \
        fa[i_] = *(const bf16x8*)(As_ + (wm * 128 + i_ * 32 + r) * GS + ks * 16 + 8 * h);         \
      _Pragma("unroll") for (int j_ = 0; j_ < 2; ++j_)                                            \
        fb[j_] = *(const bf16x8*)(Bs_ + (wn * 64 + j_ * 32 + r) * GS + ks * 16 + 8 * h);          \
      _Pragma("unroll") for (int i_ = 0; i_ < 4; ++i_)                                            \
        _Pragma("unroll") for (int j_ = 0; j_ < 2; ++j_) acc[i_][j_] = MFMA(fa[i_], fb[j_], acc[i_][j_]); \
    }                                                                                             \
  }
  const int nk = K >> 6;
  __syncthreads();
  G5_LOAD(0);
  G5_STORE(0);
  G5_LOAD(64);
  __syncthreads();
  for (int kt = 0; kt + 2 < nk; ++kt) {
    const int cur = kt & 1;
    G5_STORE(cur ^ 1);
    G5_LOAD((kt + 2) << 6);
    G5_COMPUTE(cur);
    __syncthreads();
  }
  {
    const int cur = (nk - 2) & 1;
    G5_STORE(cur ^ 1);
    G5_COMPUTE(cur);
    __syncthreads();
    G5_COMPUTE(cur ^ 1);
  }
#pragma unroll 1
  for (int half = 0; half < 2; ++half) {
    __syncthreads();
    if (wm == half) {
#pragma unroll
      for (int i = 0; i < 4; ++i)
#pragma unroll
        for (int j = 0; j < 2; ++j)
#pragma unroll
          for (int g = 0; g < 16; ++g) Cs[(i * 32 + crow(g, h)) * CSW + wn * 64 + j * 32 + r] = acc[i][j][g];
    }
    __syncthreads();
    epi(half);
  }
}

DI void wtrans_tile(const float* __restrict__ src, int K, int N, u16* __restrict__ dst, int ldw, int tk, int tn,
                    const float* __restrict__ kscale, char* lds) {
  float* t = (float*)lds;
  int tid_ = VTID;
  asm volatile("" : "+v"(tid_));
  const int tid = tid_, j = tid & 63, i0 = tid >> 6;
  const int k0 = tk * 64, n0 = tn * 64;
  __syncthreads();
#pragma unroll
  for (int q = 0; q < 16; ++q) {
    int i = i0 + 4 * q;
    float v = (n0 + j < N) ? src[(size_t)(k0 + i) * N + n0 + j] : 0.f;
    if (kscale) v *= kscale[k0 + i];
    t[i * 65 + j] = v;
  }
  __syncthreads();
#pragma unroll 4
  for (int q = 0; q < 16; ++q) {
    int jj = i0 + 4 * q;
    dst[(size_t)(n0 + jj) * ldw + k0 + j] = f2bf(t[j * 65 + jj]);
  }
}

DI void ada_tile(const Params& p, int layer, int cg64, char* lds) {
  float* sc = (float*)lds;
  int tid_ = VTID;
  asm volatile("" : "+v"(tid_));
  const int tid = tid_;
  __syncthreads();
  for (int e = tid; e < 17 * 1024; e += 256) {
    int bi = e >> 10, k = e & 1023;
    float v = bi < 16 ? p.c[bi * 1024 + k] : p.c_ctx[k];
    sc[e] = siluf(v);
  }
  __syncthreads();
  const int col = tid & 63, kq = tid >> 6;
  const int n = cg64 * 64 + col;
  const float* w = p.ada_w + (size_t)layer * 1024 * 6144 + n;
  float acc[17];
#pragma unroll
  for (int i = 0; i < 17; ++i) acc[i] = 0.f;
#pragma unroll 8
  for (int kk = 0; kk < 256; ++kk) {
    int k = kq * 256 + kk;
    float wv = w[(size_t)k * 6144];
#pragma unroll
    for (int i = 0; i < 17; ++i) acc[i] += sc[i * 1024 + k] * wv;
  }
  __syncthreads();
  float* red = (float*)lds;
#pragma unroll
  for (int i = 0; i < 17; ++i) red[(kq * 17 + i) * 64 + col] = acc[i];
  __syncthreads();
  float* mod = (float*)(p.ws + O_MOD) + (size_t)layer * 17 * 6144;
  for (int e = tid; e < 17 * 64; e += 256) {
    int bi = e >> 6, cc = e & 63;
    float s = red[(0 * 17 + bi) * 64 + cc] + red[(1 * 17 + bi) * 64 + cc] + red[(2 * 17 + bi) * 64 + cc] +
              red[(3 * 17 + bi) * 64 + cc];
    int nn = cg64 * 64 + cc;
    mod[bi * 6144 + nn] = s + p.ada_b[layer * 6144 + nn];
  }
}

DI void phase0a(const Params& p, char* lds) {
  int tid_ = VTID;
  asm volatile("" : "+v"(tid_));
  const int tid = tid_;
  for (int t = VB; t < 6544; t += VG) {
    if (t < 6096) {
      int layer = t / 3048, q = t % 3048;
      if (q < 704) {
        wtrans_tile(p.w_in + (size_t)layer * 1024 * 2736, 1024, 2736, (u16*)(p.ws + O_WIN + layer * SZ_WIN), WP, q / 44, q % 44,
                    nullptr, lds);
      } else if (q < 960) {
        q -= 704;
        wtrans_tile(p.w_out + (size_t)layer * 1024 * 1024, 1024, 1024, (u16*)(p.ws + O_WOUT + layer * SZ_WOUT), WP, q / 16, q % 16,
                    nullptr, lds);
      } else if (q < 1984) {
        q -= 960;
        wtrans_tile(p.w_ff1 + (size_t)layer * 1024 * 4096, 1024, 4096, (u16*)(p.ws + O_WFF1 + layer * SZ_WFF), WP, q / 64, q % 64,
                    nullptr, lds);
      } else if (q < 3008) {
        q -= 1984;
        wtrans_tile(p.w_ff2 + (size_t)layer * 4096 * 1024, 4096, 1024, (u16*)(p.ws + O_WFF2 + layer * SZ_WFF), WP2, q / 16, q % 16,
                    nullptr, lds);
      } else if (q < 3032) {
        q -= 3008;
        wtrans_tile(p.mla_w_uq + (size_t)layer * 256 * 384, 256, 384, (u16*)(p.ws + O_WUQ + layer * SZ_WUQ), 256, q / 6, q % 6,
                    p.mla_q_norm + layer * 256, lds);
      } else {
        q -= 3032;
        wtrans_tile(p.mla_w_ukv + (size_t)layer * 128 * 512, 128, 512, (u16*)(p.ws + O_WUKV + layer * SZ_WUKV), 128, q / 8, q % 8,
                    p.mla_kv_norm + layer * 128, lds);
      }
    } else if (t < 6288) {
      int q = t - 6096;
      ada_tile(p, q / 96, q % 96, lds);
    } else {
      int q = t - 6288;
      float2* tab = (float2*)(p.ws + O_TAB);
      for (int e = q * 1024 + tid; e < (q + 1) * 1024; e += 256) {
        int tok = e >> 6, i = e & 63;
        float ang;
        if (i < 32) {
          int f = i & 15;
          float inv = powf(10000.f, -(float)(2 * f) / 32.f);
          ang = (float)(i < 16 ? (tok >> 6) : (tok & 63)) * inv;
        } else if (i < 48) {
          int f = i - 32;
          float inv = powf(10000.f, -(float)(2 * f) / 32.f);
          ang = (float)tok * inv;
        } else {
          int f = (i - 48) & 7;
          float inv = powf(10000.f, -(float)(2 * f) / 16.f);
          ang = (float)((i - 48) < 8 ? (tok >> 6) : (tok & 63)) * inv;
        }
        float sn, cs;
        sincosf(ang, &sn, &cs);
        tab[e] = make_float2(cs, sn);
      }
    }
  }
}

DI void modulate_rows(const Params& p, int layer_mod, int nrows) {
  int tid_ = VTID;
  asm volatile("" : "+v"(tid_));
  const int tid = tid_, wave = tid >> 6, lane = tid & 63;
  const float* mod = (const float*)(p.ws + O_MOD) + (size_t)layer_mod * 17 * 6144;
  u16* act = (u16*)(p.ws + O_ACT);
  const int stride = VG * 4;
  for (int row0 = VB * 4 + wave; row0 < nrows; row0 += 2 * stride) {
    const int row1 = row0 + stride;
    const bool has1 = row1 < nrows;
    float4 va[4], vb[4];
#pragma unroll
    for (int i = 0; i < 4; ++i) {
      va[i] = *(const float4*)(xrow0(p, row0) + (i * 64 + lane) * 4);
      vb[i] = has1 ? *(const float4*)(xrow0(p, row1) + (i * 64 + lane) * 4) : make_float4(0.f, 0.f, 0.f, 0.f);
    }
#pragma unroll
    for (int rr = 0; rr < 2; ++rr) {
      if (rr == 1 && !has1) break;
      const int row = rr ? row1 : row0;
      const float* m = mod + rowb(row) * 6144;
#pragma unroll
      for (int i = 0; i < 4; ++i) {
        int col = (i * 64 + lane) * 4;
        float4 v = rr ? vb[i] : va[i];
        float4 sh = *(const float4*)(m + col);
        float4 sc = *(const float4*)(m + 1024 + col);
        uint2 o;
        o.x = pack2(v.x * (1.f + sc.x) + sh.x, v.y * (1.f + sc.y) + sh.y);
        o.y = pack2(v.z * (1.f + sc.z) + sh.z, v.w * (1.f + sc.w) + sh.w);
        *(uint2*)(act + (size_t)row * AP + col) = o;
      }
    }
  }
}

DI void ln_rows(const Params& p, const float* g, const float* bb, int nrows, int mod_layer, int sh_chunk, bool write_act) {
  int tid_ = VTID;
  asm volatile("" : "+v"(tid_));
  const int tid = tid_, wave = tid >> 6, lane = tid & 63;
  u16* act = (u16*)(p.ws + O_ACT);
  const int stride = VG * 4;
  for (int row0 = VB * 4 + wave; row0 < nrows; row0 += 2 * stride) {
    const int row1 = row0 + stride;
    const bool has1 = row1 < nrows;
    float4 va[4], vb[4];
    float sa = 0.f, sb = 0.f;
#pragma unroll
    for (int i = 0; i < 4; ++i) {
      va[i] = *(const float4*)(xrow(p, row0) + (i * 64 + lane) * 4);
      vb[i] = has1 ? *(const float4*)(xrow(p, row1) + (i * 64 + lane) * 4) : make_float4(0.f, 0.f, 0.f, 0.f);
    }
#pragma unroll
    for (int i = 0; i < 4; ++i) {
      sa += va[i].x + va[i].y + va[i].z + va[i].w;
      sb += vb[i].x + vb[i].y + vb[i].z + vb[i].w;
    }
    const float ma = wave_sum(sa) * (1.f / 1024.f), mb = wave_sum(sb) * (1.f / 1024.f);
    float qa = 0.f, qb = 0.f;
#pragma unroll
    for (int i = 0; i < 4; ++i) {
      va[i].x -= ma; va[i].y -= ma; va[i].z -= ma; va[i].w -= ma;
      vb[i].x -= mb; vb[i].y -= mb; vb[i].z -= mb; vb[i].w -= mb;
      qa += va[i].x * va[i].x + va[i].y * va[i].y + va[i].z * va[i].z + va[i].w * va[i].w;
      qb += vb[i].x * vb[i].x + vb[i].y * vb[i].y + vb[i].z * vb[i].z + vb[i].w * vb[i].w;
    }
    const float ra = rsqrtf(wave_sum(qa) * (1.f / 1024.f) + 1e-5f), rb = rsqrtf(wave_sum(qb) * (1.f / 1024.f) + 1e-5f);
#pragma unroll
    for (int rr = 0; rr < 2; ++rr) {
      if (rr == 1 && !has1) break;
      const int row = rr ? row1 : row0;
      const float rstd = rr ? rb : ra;
      float* dst = xrow(p, row);
      if (write_act && lane == 0) ((float2*)(p.ws + O_ST))[row] = make_float2(rr ? mb : ma, rstd);
      const float* m = (const float*)(p.ws + O_MOD) + (size_t)mod_layer * 17 * 6144 + rowb(row) * 6144 + sh_chunk * 1024;
#pragma unroll
      for (int i = 0; i < 4; ++i) {
        int col = (i * 64 + lane) * 4;
        float4 v = rr ? vb[i] : va[i];
        float4 gg = *(const float4*)(g + col);
        float4 bv = *(const float4*)(bb + col);
        float4 y;
        y.x = v.x * rstd * gg.x + bv.x; y.y = v.y * rstd * gg.y + bv.y;
        y.z = v.z * rstd * gg.z + bv.z; y.w = v.w * rstd * gg.w + bv.w;
        if (!write_act) *(float4*)(dst + col) = y;
        if (write_act) {
          float4 sh = *(const float4*)(m + col);
          float4 sc = *(const float4*)(m + 1024 + col);
          uint2 o;
          o.x = pack2(y.x * (1.f + sc.x) + sh.x, y.y * (1.f + sc.y) + sh.y);
          o.y = pack2(y.z * (1.f + sc.z) + sh.z, y.w * (1.f + sc.w) + sh.w);
          *(uint2*)(act + (size_t)row * AP + col) = o;
        }
      }
    }
  }
}

DI void gemm_phase(const Params& p, int layer, int mode, int nrows, char* lds_all) {
  int tid_ = threadIdx.x;
  asm volatile("" : "+v"(tid_));
  const int tid = tid_;
  const float* Cs = (const float*)lds_all;
  int ntn, K, lda, ldb;
  const u16 *A, *Bt;
  if (mode == 0) { ntn = 11; K = 1024; lda = AP; ldb = WP; A = (const u16*)(p.ws + O_ACT); Bt = (const u16*)(p.ws + O_WIN + layer * SZ_WIN); }
  else if (mode == 1) { ntn = 4; K = 1024; lda = AP; ldb = WP; A = (const u16*)(p.ws + O_ACT); Bt = (const u16*)(p.ws + O_WOUT + layer * SZ_WOUT); }
  else if (mode == 2) { ntn = 16; K = 1024; lda = AP; ldb = WP; A = (const u16*)(p.ws + O_ACT); Bt = (const u16*)(p.ws + O_WFF1 + layer * SZ_WFF); }
  else { ntn = 4; K = 4096; lda = HP; ldb = WP2; A = (const u16*)(p.ws + O_Z); Bt = (const u16*)(p.ws + O_WFF2 + layer * SZ_WFF); }
  const int ntm = nrows >> 8;
  const float* mod = (const float*)(p.ws + O_MOD) + (size_t)layer * 17 * 6144;
  const bool swz = (gridDim.x & 7) == 0;
  const int xcd = swz ? (blockIdx.x & 7) : 0, nx = swz ? 8 : 1;
  const int jb = swz ? (blockIdx.x >> 3) : blockIdx.x, nj = swz ? (gridDim.x >> 3) : gridDim.x;
  const int per = 2 * ntn, nsr = ntm >> 1;
  for (int i = jb;; i += nj) {
    const int srl = i / per, rem = i - srl * per;
    const int sr = xcd + nx * srl;
    if (sr >= nsr) break;
    const int tn = rem >> 1, tm = sr * 2 + (rem & 1);
    const int m0 = tm * 256, n0 = tn * 256;
    gemm_tile512(A + (size_t)m0 * lda, lda, Bt + (size_t)n0 * ldb, ldb, K, lds_all, [&](int half) {
      for (int idx = tid; idx < 128 * 64; idx += 512) {
        const int rr = idx >> 6, c4 = (idx & 63) * 4;
        const int row = m0 + half * 128 + rr, col = n0 + c4;
        float4 v = *(const float4*)(Cs + rr * CSW + c4);
        if (mode == 0) {
          uint2 o;
          o.x = pack2(v.x, v.y); o.y = pack2(v.z, v.w);
          *(uint2*)((u16*)(p.ws + O_Z) + (size_t)row * ZW + col) = o;
          if (n0 == C_BAB && c4 < 16) *(float4*)((float*)(p.ws + O_GRAW) + (size_t)row * 16 + c4) = v;
        } else if (mode == 2) {
          float a = fmaxf(v.x, 0.f), b = fmaxf(v.y, 0.f), c = fmaxf(v.z, 0.f), d = fmaxf(v.w, 0.f);
          uint2 o;
          o.x = pack2(a * a, b * b); o.y = pack2(c * c, d * d);
          *(uint2*)((u16*)(p.ws + O_Z) + (size_t)row * HP + col) = o;
        } else {
          const float* gate = mod + rowb(row) * 6144 + (mode == 1 ? 2 : 5) * 1024 + col;
          float4 gt = *(const float4*)gate;
          const float* res = (mode == 1 && layer == 0) ? xrow0(p, row) : xrow(p, row);
          float4 xr = *(const float4*)(res + col);
          if (!(mode == 1 && layer == 0)) {
            const float2 st = ((const float2*)(p.ws + O_ST))[row];
            const float* lg_ = (mode == 3) ? p.ln1_g + layer * DM : p.ln2_g + (layer - 1) * DM;
            const float* lb_ = (mode == 3) ? p.ln1_b + layer * DM : p.ln2_b + (layer - 1) * DM;
            const float4 lg4 = *(const float4*)(lg_ + col), lb4 = *(const float4*)(lb_ + col);
            xr.x = (xr.x - st.x) * st.y * lg4.x + lb4.x; xr.y = (xr.y - st.x) * st.y * lg4.y + lb4.y;
            xr.z = (xr.z - st.x) * st.y * lg4.z + lb4.z; xr.w = (xr.w - st.x) * st.y * lg4.w + lb4.w;
          }
          float4 o;
          o.x = DN_ALPHA * xr.x + gt.x * v.x; o.y = DN_ALPHA * xr.y + gt.y * v.y;
          o.z = DN_ALPHA * xr.z + gt.z * v.z; o.w = DN_ALPHA * xr.w + gt.w * v.w;
          *(float4*)(xrow(p, row) + col) = o;
        }
      }
    });
  }
}

DI void prep_swa(const Params& p, int tile) {
  int tid_ = VTID;
  asm volatile("" : "+v"(tid_));
  const int tid = tid_;
  const u16* Z = (const u16*)(p.ws + O_Z);
  const float4* tab = (const float4*)(p.ws + O_TAB);
  u16* QA = (u16*)(p.ws + O_QA);
  u16* KA = (u16*)(p.ws + O_KA);
  const int m0 = tile * 64;
  for (int jb = 0; jb < 6; jb += 3) {
    u32x4 x1[3], x2[3];
    float4 tb[3][4];
#pragma unroll
    for (int u = 0; u < 3; ++u) {
      const int id = tid + 256 * (jb + u), ri = id / 24, rem = id % 24, slot = rem >> 2, i8 = rem & 3;
      const int row = m0 + ri;
      const int base = slot < 4 ? C_AQ + slot * 64 : C_AK + (slot - 4) * 64;
      x1[u] = ldg16(Z + (size_t)row * ZW + base + i8 * 8);
      x2[u] = ldg16(Z + (size_t)row * ZW + base + 32 + i8 * 8);
      const int pos = row < NLAT ? (row & 4095) : 0;
#pragma unroll
      for (int e = 0; e < 4; ++e) tb[u][e] = tab[(pos * 64 + i8 * 8) / 2 + e];
    }
#pragma unroll
    for (int u = 0; u < 3; ++u) {
      const int id = tid + 256 * (jb + u), ri = id / 24, rem = id % 24, slot = rem >> 2, i8 = rem & 3;
      const int row = m0 + ri;
      const bool lat = row < NLAT;
      int b, pos;
      if (lat) { b = row >> 12; pos = row & 4095; } else { b = (row - NLAT) >> 8; pos = TT + ((row - NLAT) & 255); }
      float a1[8], a2[8], o1[8], o2[8];
      unpack8(x1[u], a1); unpack8(x2[u], a2);
      const float qs = slot < 4 ? 0.125f * LOG2E : 1.f;
#pragma unroll
      for (int e = 0; e < 4; ++e) {
        float c0 = lat ? tb[u][e].x : 1.f, s0 = lat ? tb[u][e].y : 0.f, c1 = lat ? tb[u][e].z : 1.f, s1 = lat ? tb[u][e].w : 0.f;
        o1[2 * e] = (a1[2 * e] * c0 - a2[2 * e] * s0) * qs;
        o2[2 * e] = (a1[2 * e] * s0 + a2[2 * e] * c0) * qs;
        o1[2 * e + 1] = (a1[2 * e + 1] * c1 - a2[2 * e + 1] * s1) * qs;
        o2[2 * e + 1] = (a1[2 * e + 1] * s1 + a2[2 * e + 1] * c1) * qs;
      }
      u16* d = slot < 4 ? QA + ((size_t)(b * 4 + slot) * NPOS + pos) * 64 : KA + ((size_t)(b * 2 + slot - 4) * NPOS + pos) * 64;
      *(u32x4*)(d + i8 * 8) = pack8(o1);
      *(u32x4*)(d + 32 + i8 * 8) = pack8(o2);
    }
  }
}

DI void prep_ret(const Params& p, int tile) {
  int tid_ = VTID;
  asm volatile("" : "+v"(tid_));
  const int tid = tid_;
  const u16* Z = (const u16*)(p.ws + O_Z);
  const float4* tab = (const float4*)(p.ws + O_TAB);
  u16* QC = (u16*)(p.ws + O_QC);
  u16* KC = (u16*)(p.ws + O_KC);
  const int m0 = tile * 64;
  u32x4 x1[4], x2[4];
  float4 tb[4][4];
#pragma unroll
  for (int u = 0; u < 4; ++u) {
    const int id = tid + 256 * u, ri = id >> 4, rem = id & 15, slot = rem >> 1, i8 = rem & 1;
    const int row = m0 + ri;
    const int base = C_CQ + slot * 32;
    x1[u] = ldg16(Z + (size_t)row * ZW + base + i8 * 8);
    x2[u] = ldg16(Z + (size_t)row * ZW + base + 16 + i8 * 8);
    const int pos = row < NLAT ? (row & 4095) : 0;
#pragma unroll
    for (int e = 0; e < 4; ++e) tb[u][e] = tab[(pos * 64 + 32 + i8 * 8) / 2 + e];
  }
#pragma unroll
  for (int u = 0; u < 4; ++u) {
    const int id = tid + 256 * u, ri = id >> 4, rem = id & 15, slot = rem >> 1, i8 = rem & 1;
    const int row = m0 + ri;
    const bool lat = row < NLAT;
    float a1[8], a2[8], o1[8], o2[8];
    unpack8(x1[u], a1); unpack8(x2[u], a2);
    const float qs = slot < 4 ? 0.17677669529663687f : 1.f;
#pragma unroll
    for (int e = 0; e < 4; ++e) {
      float c0 = lat ? tb[u][e].x : 1.f, s0 = lat ? tb[u][e].y : 0.f, c1 = lat ? tb[u][e].z : 1.f, s1 = lat ? tb[u][e].w : 0.f;
      o1[2 * e] = (a1[2 * e] * c0 - a2[2 * e] * s0) * qs;
      o2[2 * e] = (a1[2 * e] * s0 + a2[2 * e] * c0) * qs;
      o1[2 * e + 1] = (a1[2 * e + 1] * c1 - a2[2 * e + 1] * s1) * qs;
      o2[2 * e + 1] = (a1[2 * e + 1] * s1 + a2[2 * e + 1] * c1) * qs;
    }
    u16* d = slot < 4 ? QC + (size_t)row * 128 + slot * 32 : KC + (size_t)row * 128 + (slot - 4) * 32;
    *(u32x4*)(d + i8 * 8) = pack8(o1);
    *(u32x4*)(d + 16 + i8 * 8) = pack8(o2);
  }
}

DI void prep_dn(const Params& p, int layer, int tile, char* lds) {
  int tid_ = VTID;
  asm volatile("" : "+v"(tid_));
  const int tid = tid_;
  const u16* Z = (const u16*)(p.ws + O_Z);
  u16* QKVB = (u16*)(p.ws + O_QKVB);
  float* cw = (float*)lds;
  const int m0 = tile * 64;
  __syncthreads();
  for (int e = tid; e < 3840; e += 256) cw[e] = p.dn_conv_w[(size_t)layer * 3840 + e];
  __syncthreads();
  for (int jb = 0; jb < 24; jb += 4) {
    u32x4 xr[4][5];
#pragma unroll
    for (int u = 0; u < 4; ++u) {
      const int id = tid + 256 * (jb + u), ri = id / 96, ch8 = id % 96;
      const int row = m0 + ri;
      int tpos, seqn;
      if (row < NLAT) { tpos = row & 4095; seqn = TT; } else { tpos = (row - NLAT) & 255; seqn = LC; }
      const u16* zc = Z + (size_t)row * ZW + C_BQKV + ch8 * 8;
#pragma unroll
      for (int j = 0; j < 5; ++j) {
        const int tp = tpos + j - 2;
        u32x4 zz = {0u, 0u, 0u, 0u};
        xr[u][j] = (tp >= 0 && tp < seqn) ? ldg16(zc + (j - 2) * ZW) : zz;
      }
    }
#pragma unroll
    for (int u = 0; u < 4; ++u) {
      const int id = tid + 256 * (jb + u), ri = id / 96, ch8 = id % 96;
      const int row = m0 + ri;
      float acc[8];
#pragma unroll
      for (int e = 0; e < 8; ++e) acc[e] = 0.f;
#pragma unroll
      for (int j = 0; j < 5; ++j) {
        float x[8];
        unpack8(xr[u][j], x);
        const float4 w0 = *(const float4*)(cw + j * 768 + ch8 * 8), w1 = *(const float4*)(cw + j * 768 + ch8 * 8 + 4);
        acc[0] += x[0] * w0.x; acc[1] += x[1] * w0.y; acc[2] += x[2] * w0.z; acc[3] += x[3] * w0.w;
        acc[4] += x[4] * w1.x; acc[5] += x[5] * w1.y; acc[6] += x[6] * w1.z; acc[7] += x[7] * w1.w;
      }
      float ss = 0.f;
#pragma unroll
      for (int e = 0; e < 8; ++e) { acc[e] = siluf(acc[e]); ss += acc[e] * acc[e]; }
      ss += __shfl_xor(ss, 1); ss += __shfl_xor(ss, 2); ss += __shfl_xor(ss, 4);
      const int grp = ch8 >> 3;
      const float sc = grp < 8 ? rsqrtf(ss + 1e-6f) * (grp < 4 ? 0.125f : 1.f) : 1.f;
#pragma unroll
      for (int e = 0; e < 8; ++e) acc[e] *= sc;
      *(u32x4*)(QKVB + (size_t)row * 768 + ch8 * 8) = pack8(acc);
    }
  }
  const float* graw = (const float*)(p.ws + O_GRAW);
  float* g2 = (float*)(p.ws + O_G2);
  for (int e = tid; e < 64 * 8; e += 256) {
    int ri = e >> 3, dh = e & 7, dir = dh >> 2, hh = dh & 3;
    int row = m0 + ri;
    float ra = graw[(size_t)row * 16 + dir * 8 + hh], rb = graw[(size_t)row * 16 + dir * 8 + 4 + hh];
    float xx = ra + p.dn_dt_bias[layer * 8 + dh];
    float sp = xx > 20.f ? xx : log1pf(expf(xx));
    float lg = -expf(p.dn_a_log[layer * 8 + dh]) * sp;
    float beta = 1.f / (1.f + expf(-rb));
    g2[(size_t)row * 16 + dh] = lg;
    g2[(size_t)row * 16 + 8 + dh] = beta;
  }
}

DI void prep_mla(const Params& p, int layer, int tm, int which, int nt, char* lds) {
  int tid_ = VTID;
  asm volatile("" : "+v"(tid_));
  const int tid = tid_;
  const u16* Z = (const u16*)(p.ws + O_Z);
  const int m0 = tm * 256;
  float* rs = (float*)(lds + 128 * CSL * 4);
  const int KK = which == 0 ? 256 : 128;
  const int cbase = which == 0 ? C_DCQ : C_DCKV;
  __syncthreads();
  {
    const u16* src = Z + (size_t)(m0 + tid) * ZW + cbase;
    float s = 0.f;
    for (int i = 0; i < KK / 8; i += 4) {
      u32x4 u0 = ldg16(src + i * 8), u1 = ldg16(src + i * 8 + 8), u2 = ldg16(src + i * 8 + 16), u3 = ldg16(src + i * 8 + 24);
      float f[8];
      unpack8(u0, f);
#pragma unroll
      for (int e = 0; e < 8; ++e) s += f[e] * f[e];
      unpack8(u1, f);
#pragma unroll
      for (int e = 0; e < 8; ++e) s += f[e] * f[e];
      unpack8(u2, f);
#pragma unroll
      for (int e = 0; e < 8; ++e) s += f[e] * f[e];
      unpack8(u3, f);
#pragma unroll
      for (int e = 0; e < 8; ++e) s += f[e] * f[e];
    }
    rs[tid] = rsqrtf(s / (float)KK + 1e-6f);
  }
  const u16* Bt = which == 0 ? (const u16*)(p.ws + O_WUQ + layer * SZ_WUQ) + (size_t)nt * 128 * 256
                             : (const u16*)(p.ws + O_WUKV + layer * SZ_WUKV) + (size_t)nt * 128 * 128;
  const float* Cs = (const float*)lds;
  const float2* tab = (const float2*)(p.ws + O_TAB);
  gemm_tile(Z + (size_t)m0 * ZW + cbase, ZW, Bt, KK, KK, lds, [&](int half) {
    if (which == 0) {
      u16* QD = (u16*)(p.ws + O_QD);
      const float qs = 0.10206207261596575f * LOG2E;
      for (int idx = tid; idx < 128 * 32; idx += 256) {
        const int rr = idx >> 5, c4 = (idx & 31) * 4;
        const int row = m0 + half * 128 + rr;
        const float sc = rs[half * 128 + rr] * qs;
        float o[4];
#pragma unroll
        for (int j = 0; j < 4; ++j) {
          int cl = c4 + j, c = nt * 128 + cl, d = c % 96;
          float v = Cs[rr * CSL + cl];
          if (d >= 64 && row < NLAT) {
            int i = d - 64;
            if (i < 16) {
              float2 t = tab[(row & 4095) * 64 + 48 + i];
              float x2 = Cs[rr * CSL + cl + 16];
              v = v * t.x - x2 * t.y;
            } else {
              float2 t = tab[(row & 4095) * 64 + 48 + i - 16];
              float x1 = Cs[rr * CSL + cl - 16];
              v = x1 * t.y + v * t.x;
            }
          }
          o[j] = v * sc;
        }
        uint2 w;
        w.x = pack2(o[0], o[1]); w.y = pack2(o[2], o[3]);
        *(uint2*)(QD + (size_t)row * 384 + nt * 128 + c4) = w;
      }
    } else {
      u16* KVD = (u16*)(p.ws + O_KVD);
      for (int idx = tid; idx < 128 * 32; idx += 256) {
        const int rr = idx >> 5, c4 = (idx & 31) * 4;
        const int row = m0 + half * 128 + rr;
        const float sc = rs[half * 128 + rr];
        float4 v = *(const float4*)(Cs + rr * CSL + c4);
        uint2 w;
        w.x = pack2(v.x * sc, v.y * sc); w.y = pack2(v.z * sc, v.w * sc);
        *(uint2*)(KVD + (size_t)row * KVP + nt * 128 + c4) = w;
      }
    }
  });
  if (which == 1 && nt == 0) {
    u16* KR = (u16*)(p.ws + O_KR);
    for (int e = tid; e < 256 * 16; e += 256) {
      int rr = e >> 4, i = e & 15, row = m0 + rr;
      float cs = 1.f, sn = 0.f;
      if (row < NLAT) { float2 t = tab[(row & 4095) * 64 + 48 + i]; cs = t.x; sn = t.y; }
      float x1 = bf2f(Z[(size_t)row * ZW + C_DKR + i]), x2 = bf2f(Z[(size_t)row * ZW + C_DKR + 16 + i]);
      KR[(size_t)row * 32 + i] = f2bf(x1 * cs - x2 * sn);
      KR[(size_t)row * 32 + 16 + i] = f2bf(x1 * sn + x2 * cs);
    }
  }
}

DI void prep_phase(const Params& p, int layer, char* lds) {
  const int total = 3264 + 816 + 1088;
  for (int t = VB; t < total; t += VG) {
    if (t < 1088) prep_swa(p, t);
    else if (t < 2176) prep_ret(p, t - 1088);
    else if (t < 3264) prep_dn(p, layer, t - 2176, lds);
    else if (t < 3264 + 816) { int q = t - 3264; prep_mla(p, layer, q / 3, 0, q % 3, lds); }
    else { int q = t - 3264 - 816; prep_mla(p, layer, q / 4, 1, q % 4, lds); }
  }
}

struct Seg {
  const u16* k; const u16* k2; const u16* v;
  int ldk, ldk2, ldv, n, pos0, masked;
};

template <int DQK>
DI void attn_tile(const u16* __restrict__ q, int ldq, int qpos0, const Seg& s0, const Seg& s1, int nseg, bool has_sink,
                  float sinkl2, u16* __restrict__ out, int ldo, char* lds) {
  constexpr int KST = DQK + 8;
  constexpr int CPK = DQK / 8;
  constexpr int NKS = DQK / 16;
  constexpr int VST = 96;
  u16* Ks = (u16*)lds;
  u16* Vs = Ks + 64 * KST;
  int ltid_ = threadIdx.x;
  asm volatile("" : "+v"(ltid_));
  const int ltid = ltid_;
  const int tid = ltid & 255, wave = tid >> 6, lane = tid & 63, r = lane & 31, h = lane >> 5;
  const int qi = wave * 32 + r;
  bf16x8 qf[NKS];
#pragma unroll
  for (int ks = 0; ks < NKS; ++ks) qf[ks] = *(const bf16x8*)(q + (size_t)qi * ldq + ks * 16 + 8 * h);
  const int nt0 = s0.n >> 6;
  const int NT = nt0 + (nseg > 1 ? (s1.n >> 6) : 0);
  uint4 kreg0, kreg1 = make_uint4(0, 0, 0, 0), vreg0;
  uint4 krgB0, krgB1 = make_uint4(0, 0, 0, 0), vrgB0;
  const int kkey0 = ltid / CPK, kpart0 = ltid % CPK;
  const int kkey1 = (ltid + 512) / CPK, kpart1 = (ltid + 512) % CPK;
  const bool k1 = (CPK == 12) && (ltid < 256);
  const int vkey = ltid >> 3, vpart = ltid & 7;
  typedef __attribute__((address_space(3))) const char* lds_cptr;
  typedef short v4i16_t __attribute__((ext_vector_type(4)));
  const lds_cptr vp0 = (lds_cptr)Vs + (4 * h + ((lane & 15) >> 2)) * (VST * 2) + ((lane >> 4) & 1) * 32 + (lane & 3) * 8;
#define ATT_VTR(p) __builtin_bit_cast(s16x4, __builtin_amdgcn_ds_read_tr16_b64_v4i16((__attribute__((address_space(3))) v4i16_t*)(p)))
#define ATT_KSRC(sg, off, key, part) \
  (((part) < 8) ? (sg).k + (size_t)((off) + (key)) * (sg).ldk + (part) * 8 : (sg).k2 + (size_t)((off) + (key)) * (sg).ldk2 + ((part) - 8) * 8)
#define ATT_LOADX(i, K0, K1, V0)                                                            \
  {                                                                                         \
    const Seg& sgl = ((i) < nt0) ? s0 : s1;                                                 \
    const int offl = (((i) < nt0) ? (i) : (i) - nt0) << 6;                                  \
    K0 = *(const uint4*)ATT_KSRC(sgl, offl, kkey0, kpart0);                                 \
    if (k1) K1 = *(const uint4*)ATT_KSRC(sgl, offl, kkey1, kpart1);                         \
    V0 = *(const uint4*)(sgl.v + (size_t)(offl + vkey) * sgl.ldv + vpart * 8);              \
  }
  f32x16 o0 = zero16(), o1 = zero16();
  float m = -1e30f, l = 0.f;
#define ATT_STOREX(K0, K1, V0)                                               \
  {                                                                           \
    *(uint4*)(Ks + kkey0 * KST + kpart0 * 8) = K0;                            \
    if (k1) *(uint4*)(Ks + kkey1 * KST + kpart1 * 8) = K1;                    \
    *(uint4*)(Vs + vkey * VST + vpart * 8) = V0;                              \
  }
  auto compute = [&](int i) {
    const Seg& sg = (i < nt0) ? s0 : s1;
    const int off = ((i < nt0) ? i : i - nt0) << 6;
    f32x16 sa = zero16(), sb = zero16();
#pragma unroll
    for (int ks = 0; ks < NKS; ++ks) {
      bf16x8 a0 = *(const bf16x8*)(Ks + r * KST + ks * 16 + 8 * h);
      bf16x8 a1 = *(const bf16x8*)(Ks + (32 + r) * KST + ks * 16 + 8 * h);
      sa = MFMA(a0, qf[ks], sa);
      sb = MFMA(a1, qf[ks], sb);
    }
    if (sg.masked) {
      const int qpos = qpos0 + qi;
      const int kb = sg.pos0 + off;
#pragma unroll
      for (int g = 0; g < 16; ++g) {
        int d0 = kb + crow(g, h) - qpos, d1 = d0 + 32;
        if (d0 > 128 || d0 < -128) sa[g] = -INFINITY;
        if (d1 > 128 || d1 < -128) sb[g] = -INFINITY;
      }
    }
    float mx = sa[0];
#pragma unroll
    for (int g = 1; g < 16; ++g) mx = fmaxf(mx, sa[g]);
#pragma unroll
    for (int g = 0; g < 16; ++g) mx = fmaxf(mx, sb[g]);
    mx = fmaxf(mx, __shfl_xor(mx, 32));
    const float mn = fmaxf(m, mx);
    const float alpha = __builtin_amdgcn_exp2f(m - mn);
    m = mn;
    float ps = 0.f;
#pragma unroll
    for (int g = 0; g < 16; ++g) { sa[g] = __builtin_amdgcn_exp2f(sa[g] - mn); ps += sa[g]; }
#pragma unroll
    for (int g = 0; g < 16; ++g) { sb[g] = __builtin_amdgcn_exp2f(sb[g] - mn); ps += sb[g]; }
    l = l * alpha + ps;
#pragma unroll
    for (int g = 0; g < 16; ++g) { o0[g] *= alpha; o1[g] *= alpha; }
#pragma unroll
    for (int kt = 0; kt < 2; ++kt) {
#pragma unroll
      for (int s = 0; s < 2; ++s) {
        const f32x16& sv = kt == 0 ? sa : sb;
        uint4 pu;
        pu.x = pack2(sv[8 * s + 0], sv[8 * s + 1]); pu.y = pack2(sv[8 * s + 2], sv[8 * s + 3]);
        pu.z = pack2(sv[8 * s + 4], sv[8 * s + 5]); pu.w = pack2(sv[8 * s + 6], sv[8 * s + 7]);
        bf16x8 pf = __builtin_bit_cast(bf16x8, pu);
        const lds_cptr vp = vp0 + (kt * 32 + 16 * s) * (VST * 2);
        {
          s16x4 lo = ATT_VTR(vp);
          s16x4 hi = ATT_VTR(vp + 8 * VST * 2);
          bf16x8 vf = __builtin_shufflevector(lo, hi, 0, 1, 2, 3, 4, 5, 6, 7);
          o0 = MFMA(vf, pf, o0);
        }
        {
          s16x4 lo = ATT_VTR(vp + 64);
          s16x4 hi = ATT_VTR(vp + 8 * VST * 2 + 64);
          bf16x8 vf = __builtin_shufflevector(lo, hi, 0, 1, 2, 3, 4, 5, 6, 7);
          o1 = MFMA(vf, pf, o1);
        }
      }
    }
  };
  ATT_LOADX(0, kreg0, kreg1, vreg0);
  ATT_LOADX(1, krgB0, krgB1, vrgB0);
  for (int i = 0; i < NT; i += 2) {
    __syncthreads();
    ATT_STOREX(kreg0, kreg1, vreg0);
    __syncthreads();
    if (i + 2 < NT) ATT_LOADX(i + 2, kreg0, kreg1, vreg0);
    compute(i);
    __syncthreads();
    ATT_STOREX(krgB0, krgB1, vrgB0);
    __syncthreads();
    if (i + 3 < NT) ATT_LOADX(i + 3, krgB0, krgB1, vrgB0);
    compute(i + 1);
  }
  float lt = l + __shfl_xor(l, 32);
  if (has_sink) lt += __builtin_amdgcn_exp2f(sinkl2 - m);
  const float inv = 1.f / lt;
#pragma unroll
  for (int g = 0; g < 4; ++g) {
    uint2 w;
    w.x = pack2(o0[4 * g] * inv, o0[4 * g + 1] * inv); w.y = pack2(o0[4 * g + 2] * inv, o0[4 * g + 3] * inv);
    *(uint2*)(out + (size_t)qi * ldo + 8 * g + 4 * h) = w;
    w.x = pack2(o1[4 * g] * inv, o1[4 * g + 1] * inv); w.y = pack2(o1[4 * g + 2] * inv, o1[4 * g + 3] * inv);
    *(uint2*)(out + (size_t)qi * ldo + 32 + 8 * g + 4 * h) = w;
  }
}

DI void mla_attn(const Params& p, int idx, char* lds) {
  const u16* QD = (const u16*)(p.ws + O_QD);
  const u16* KVD = (const u16*)(p.ws + O_KVD);
  const u16* KR = (const u16*)(p.ws + O_KR);
  u16* act = (u16*)(p.ws + O_ACT);
  Seg lat, cx;
  int b, hh, row0;
  bool is_ctx = idx >= 2048;
  if (!is_ctx) { b = idx >> 7; hh = (idx >> 5) & 3; row0 = b * TT + (idx & 31) * 128; }
  else { int q = idx - 2048; b = q >> 3; hh = (q >> 1) & 3; row0 = NLAT + b * LC + (q & 1) * 128; }
  const size_t lr = (size_t)b * TT, cr = (size_t)NLAT + b * LC;
  lat.k = KVD + lr * KVP + hh * 128; lat.ldk = KVP; lat.k2 = KR + lr * 32; lat.ldk2 = 32; lat.v = KVD + lr * KVP + hh * 128 + 64;
  lat.ldv = KVP; lat.n = TT; lat.pos0 = 0; lat.masked = 0;
  cx.k = KVD + cr * KVP + hh * 128; cx.ldk = KVP; cx.k2 = KR + cr * 32; cx.ldk2 = 32; cx.v = KVD + cr * KVP + hh * 128 + 64;
  cx.ldv = KVP; cx.n = LC; cx.pos0 = 0; cx.masked = 0;
  const u16* q = QD + (size_t)row0 * 384 + hh * 96;
  u16* o = act + (size_t)row0 * AP + 768 + hh * 64;
  if (!is_ctx) attn_tile<96>(q, 384, 0, lat, cx, 2, false, 0.f, o, AP, lds);
  else attn_tile<96>(q, 384, 0, cx, cx, 1, false, 0.f, o, AP, lds);
}

DI void swa_attn(const Params& p, int layer, int idx, char* lds) {
  const u16* QA = (const u16*)(p.ws + O_QA);
  const u16* KA = (const u16*)(p.ws + O_KA);
  const u16* Z = (const u16*)(p.ws + O_Z);
  u16* act = (u16*)(p.ws + O_ACT);
  Seg loc, cx;
  int b, hh, row0, pos0q;
  bool is_ctx = idx >= 2048;
  int nb = 0;
  if (!is_ctx) { b = idx >> 7; hh = ((idx >> 6) & 1) * 2 + (idx & 1); nb = (idx >> 1) & 31; pos0q = nb * 128; row0 = b * TT + pos0q; }
  else { int q = idx - 2048; b = q >> 3; hh = (q >> 1) & 3; pos0q = TT + (q & 1) * 128; row0 = NLAT + b * LC + (q & 1) * 128; }
  const int hk = hh >> 1;
  const u16* kbase = KA + (size_t)(b * 2 + hk) * NPOS * 64;
  cx.k = kbase + (size_t)TT * 64; cx.ldk = 64; cx.k2 = cx.k; cx.ldk2 = 64;
  cx.v = Z + ((size_t)NLAT + b * LC) * ZW + C_AV + hk * 64; cx.ldv = ZW; cx.n = LC; cx.pos0 = 0; cx.masked = 0;
  const float sinkl2 = p.swa_sink[layer * 4 + hh] * LOG2E;
  const u16* q = QA + ((size_t)(b * 4 + hh) * NPOS + pos0q) * 64;
  u16* o = act + (size_t)row0 * AP + hh * 64;
  if (!is_ctx) {
    int ks = nb * 128 - 128; if (ks < 0) ks = 0;
    int ke = nb * 128 + 256; if (ke > TT) ke = TT;
    loc.k = kbase + (size_t)ks * 64; loc.ldk = 64; loc.k2 = loc.k; loc.ldk2 = 64;
    loc.v = Z + ((size_t)b * TT + ks) * ZW + C_AV + hk * 64; loc.ldv = ZW; loc.n = ke - ks; loc.pos0 = ks; loc.masked = 1;
    attn_tile<64>(q, 64, pos0q, loc, cx, 2, true, sinkl2, o, AP, lds);
  } else {
    attn_tile<64>(q, 64, 0, cx, cx, 1, true, sinkl2, o, AP, lds);
  }
}

constexpr int LS = 72;
template <int KS>
DI f32x16 mm64(const u16* A, int lda, const u16* Bt, int ldb, int wm, int wn, int r, int h) {
  f32x16 acc = zero16();
#pragma unroll
  for (int s = 0; s < KS; ++s) {
    bf16x8 a = *(const bf16x8*)(A + (wm * 32 + r) * lda + s * 16 + 8 * h);
    bf16x8 b = *(const bf16x8*)(Bt + (wn * 32 + r) * ldb + s * 16 + 8 * h);
    acc = MFMA(a, b, acc);
  }
  return acc;
}
DI void st_straight(u16* D, int ld, const f32x16& v, int wm, int wn, int r, int h) {
#pragma unroll
  for (int g = 0; g < 16; ++g) D[(wm * 32 + crow(g, h)) * ld + wn * 32 + r] = f2bf(v[g]);
}
DI void st_transp(u16* D, int ld, const f32x16& v, int wm, int wn, int r, int h) {
#pragma unroll
  for (int g = 0; g < 4; ++g) {
    uint2 w;
    w.x = pack2(v[4 * g], v[4 * g + 1]); w.y = pack2(v[4 * g + 2], v[4 * g + 3]);
    *(uint2*)(D + (wn * 32 + r) * ld + wm * 32 + 8 * g + 4 * h) = w;
  }
}

template <int KS>
DI f32x16 mm64t(const u16* AT, int lda, const u16* Bt, int ldb, int wm, int wn, int r, int h, int lane) {
  typedef __attribute__((address_space(3))) const char* lds_cptr;
  typedef short v4i16_t __attribute__((ext_vector_type(4)));
  const lds_cptr base = (lds_cptr)AT + ((lane & 15) >> 2) * (lda * 2) + (wm * 32 + ((lane >> 4) & 1) * 16) * 2 + (lane & 3) * 8;
  f32x16 acc = zero16();
#pragma unroll
  for (int s = 0; s < KS; ++s) {
    s16x4 lo = __builtin_bit_cast(s16x4, __builtin_amdgcn_ds_read_tr16_b64_v4i16((__attribute__((address_space(3))) v4i16_t*)(base + (16 * s + 8 * h) * (lda * 2))));
    s16x4 hi = __builtin_bit_cast(s16x4, __builtin_amdgcn_ds_read_tr16_b64_v4i16((__attribute__((address_space(3))) v4i16_t*)(base + (16 * s + 8 * h + 4) * (lda * 2))));
    bf16x8 a = __builtin_shufflevector(lo, hi, 0, 1, 2, 3, 4, 5, 6, 7);
    bf16x8 b = *(const bf16x8*)(Bt + (wn * 32 + r) * ldb + s * 16 + 8 * h);
    acc = MFMA(a, b, acc);
  }
  return acc;
}

template <int KS, bool ATR, bool BTR>
DI f32x16 mm64x(const u16* A, int lda, const u16* B, int ldb, int wm, int wn, int r, int h, int lane) {
  typedef __attribute__((address_space(3))) const char* lds_cptr;
  typedef short v4i16_t __attribute__((ext_vector_type(4)));
  const int sub = ((lane & 15) >> 2), cb = ((lane >> 4) & 1) * 16, pb = (lane & 3) * 8;
  const lds_cptr abase = (lds_cptr)A + sub * (lda * 2) + (wm * 32 + cb) * 2 + pb;
  const lds_cptr bbase = (lds_cptr)B + sub * (ldb * 2) + (wn * 32 + cb) * 2 + pb;
  f32x16 acc = zero16();
#pragma unroll
  for (int s = 0; s < KS; ++s) {
    bf16x8 a, b;
    if (ATR) {
      s16x4 lo = __builtin_bit_cast(s16x4, __builtin_amdgcn_ds_read_tr16_b64_v4i16((__attribute__((address_space(3))) v4i16_t*)(abase + (16 * s + 8 * h) * (lda * 2))));
      s16x4 hi = __builtin_bit_cast(s16x4, __builtin_amdgcn_ds_read_tr16_b64_v4i16((__attribute__((address_space(3))) v4i16_t*)(abase + (16 * s + 8 * h + 4) * (lda * 2))));
      a = __builtin_shufflevector(lo, hi, 0, 1, 2, 3, 4, 5, 6, 7);
    } else {
      a = *(const bf16x8*)(A + (wm * 32 + r) * lda + s * 16 + 8 * h);
    }
    if (BTR) {
      s16x4 lo = __builtin_bit_cast(s16x4, __builtin_amdgcn_ds_read_tr16_b64_v4i16((__attribute__((address_space(3))) v4i16_t*)(bbase + (16 * s + 8 * h) * (ldb * 2))));
      s16x4 hi = __builtin_bit_cast(s16x4, __builtin_amdgcn_ds_read_tr16_b64_v4i16((__attribute__((address_space(3))) v4i16_t*)(bbase + (16 * s + 8 * h + 4) * (ldb * 2))));
      b = __builtin_shufflevector(lo, hi, 0, 1, 2, 3, 4, 5, 6, 7);
    } else {
      b = *(const bf16x8*)(B + (wn * 32 + r) * ldb + s * 16 + 8 * h);
    }
    acc = MFMA(a, b, acc);
  }
  return acc;
}
DI void st8s(u16* dst, const uint4& v, float f) {
  uint4 o;
  o.x = pack2(bflo(v.x) * f, bfhi(v.x) * f); o.y = pack2(bflo(v.y) * f, bfhi(v.y) * f);
  o.z = pack2(bflo(v.z) * f, bfhi(v.z) * f); o.w = pack2(bflo(v.w) * f, bfhi(v.w) * f);
  *(uint4*)dst = o;
}

DI void dn_chain(const Params& p, int chain, char* lds) {
  int tid_ = VTID;
  asm volatile("" : "+v"(tid_));
  const int tid = tid_, wave = tid >> 6, lane = tid & 63, r = lane & 31, h = lane >> 5;
  const int wm = wave >> 1, wn = wave & 1;
  const int b = chain >> 3, hh = (chain >> 1) & 3, dir = chain & 1;
  u16* kA = (u16*)lds;
  u16* St = kA + 64 * LS;
  u16* R1 = St + 64 * LS;
  u16* R2 = R1 + 64 * LS;
  u16* R3 = R2 + 64 * LS;
  u16* R4 = R3 + 64 * LS;
  u16* R5 = R4 + 64 * LS;
  float* gc = (float*)(R5 + 64 * LS);
  float* bt = gc + 64;
  const u16* QKVB = (const u16*)(p.ws + O_QKVB);
  const float* G2 = (const float*)(p.ws + O_G2);
  u16* OUT = dir ? (u16*)(p.ws + O_OB) : (u16*)(p.ws + O_ACT) + 256;
  const int opitch = dir ? 256 : AP;
  __syncthreads();
  for (int e = tid; e < 64 * LS / 2; e += 256) ((u32*)St)[e] = 0u;
  f32x16 S = zero16();
  const int lc = tid >> 3, lp = (tid & 7) * 8;
  auto rowof = [&](int n, int c) -> int {
    int cn, base, len;
    if (n < 4) { cn = n; base = NLAT + b * LC; len = LC; } else { cn = n - 4; base = b * TT; len = TT; }
    int pos = cn * 64 + c;
    return base + (dir ? len - 1 - pos : pos);
  };
  uint4 pk0, pk1, pq0, pq1, pv0, pv1;
  float pg = 0.f, pb = 0.f;
#define DN_LOAD(n)                                                                      \
  {                                                                                     \
    const u16* s0_ = QKVB + (size_t)rowof((n), lc) * 768 + hh * 64 + lp;                \
    const u16* s1_ = QKVB + (size_t)rowof((n), lc + 32) * 768 + hh * 64 + lp;           \
    pq0 = *(const uint4*)s0_; pk0 = *(const uint4*)(s0_ + 256); pv0 = *(const uint4*)(s0_ + 512); \
    pq1 = *(const uint4*)s1_; pk1 = *(const uint4*)(s1_ + 256); pv1 = *(const uint4*)(s1_ + 512); \
    if (tid < 64) {                                                                     \
      const float* g_ = G2 + (size_t)rowof((n), tid) * 16 + dir * 4 + hh;               \
      pg = g_[0]; pb = g_[8];                                                           \
    }                                                                                   \
  }
  DN_LOAD(0);
  for (int n = 0; n < 68; ++n) {
    const uint4 ck0 = pk0, ck1 = pk1, cq0 = pq0, cq1 = pq1, cv0 = pv0, cv1 = pv1;
    float cgv = pg, cbv = pb;
    __syncthreads();
    if (tid < 64) {
      float v = cgv;
#pragma unroll
      for (int o = 1; o < 64; o <<= 1) { float t = __shfl_up(v, o); if (lane >= o) v += t; }
      gc[tid] = v; bt[tid] = cbv;
    }
    *(uint4*)(kA + lc * LS + lp) = ck0;
    *(uint4*)(kA + (lc + 32) * LS + lp) = ck1;
    if (n + 1 < 68) DN_LOAD(n + 1);
    __syncthreads();
    const float gl = gc[63];
    f32x16 T;
    {
      f32x16 kk = mm64<4>(kA, LS, kA, LS, wm, wn, r, h);
      const int s = wn * 32 + r;
      const float gs = gc[s];
#pragma unroll
      for (int g = 0; g < 16; ++g) {
        int c = wm * 32 + crow(g, h);
        float v = (s < c) ? bt[c] * kk[g] * __expf(gc[c] - gs) : 0.f;
        kk[g] = v;
        T[g] = (c == s) ? 1.f : (((c >> 1) == (s >> 1)) ? -v : 0.f);
      }
      st_transp(R1, LS, kk, wm, wn, r, h);
      st_transp(R2, LS, T, wm, wn, r, h);
    }
    __syncthreads();
    for (int k = 1; k < 6; ++k) {
      f32x16 M = mm64t<4>(R1, LS, R2, LS, wm, wn, r, h, lane);
      st_transp(R4, LS, M, wm, wn, r, h);
      __syncthreads();
      f32x16 X = mm64t<4>(R2, LS, R4, LS, wm, wn, r, h, lane);
      {
        const int s = wn * 32 + r;
#pragma unroll
        for (int g = 0; g < 16; ++g) {
          int c = wm * 32 + crow(g, h);
          if ((c >> (k + 1)) == (s >> (k + 1)) && (c >> k) != (s >> k)) T[g] -= X[g];
        }
      }
      __syncthreads();
      st_transp(R2, LS, T, wm, wn, r, h);
      __syncthreads();
    }
    {
      const float fb0 = bt[lc], fk0 = fb0 * __expf(gc[lc]);
      const float fb1 = bt[lc + 32], fk1 = fb1 * __expf(gc[lc + 32]);
      st8s(R1 + lc * LS + lp, ck0, fk0);
      st8s(R1 + (lc + 32) * LS + lp, ck1, fk1);
      st8s(R3 + lc * LS + lp, cv0, fb0);
      st8s(R3 + (lc + 32) * LS + lp, cv1, fb1);
    }
    __syncthreads();
    f32x16 W = mm64x<4, true, true>(R2, LS, R1, LS, wm, wn, r, h, lane);
    f32x16 U = mm64x<4, true, true>(R2, LS, R3, LS, wm, wn, r, h, lane);
    st_transp(R4, LS, W, wm, wn, r, h);
    __syncthreads();
    {
      f32x16 ws = mm64t<4>(R4, LS, St, LS, wm, wn, r, h, lane);
#pragma unroll
      for (int g = 0; g < 16; ++g) U[g] -= ws[g];
      st_transp(R1, LS, U, wm, wn, r, h);
    }
    *(uint4*)(R2 + lc * LS + lp) = cq0;
    *(uint4*)(R2 + (lc + 32) * LS + lp) = cq1;
    st8s(R5 + lc * LS + lp, ck0, __expf(gl - gc[lc]));
    st8s(R5 + (lc + 32) * LS + lp, ck1, __expf(gl - gc[lc + 32]));
    __syncthreads();
    {
      f32x16 qk = mm64<4>(R2, LS, kA, LS, wm, wn, r, h);
      const int s = wn * 32 + r;
      const float gs = gc[s];
#pragma unroll
      for (int g = 0; g < 16; ++g) {
        int c = wm * 32 + crow(g, h);
        qk[g] = (s <= c) ? qk[g] * __expf(gc[c] - gs) : 0.f;
      }
      st_transp(R3, LS, qk, wm, wn, r, h);
    }
    __syncthreads();
    {
      f32x16 o1 = mm64<4>(R2, LS, St, LS, wm, wn, r, h);
      f32x16 o2 = mm64t<4>(R3, LS, R1, LS, wm, wn, r, h, lane);
      f32x16 sn = mm64x<4, true, false>(R5, LS, R1, LS, wm, wn, r, h, lane);
      const float egl = __expf(gl);
#pragma unroll
      for (int g = 0; g < 16; ++g) {
        int c = wm * 32 + crow(g, h);
        float ov = o1[g] * __expf(gc[c]) + o2[g];
        OUT[(size_t)rowof(n, c) * opitch + hh * 64 + wn * 32 + r] = f2bf(ov);
        S[g] = S[g] * egl + sn[g];
      }
    }
    __syncthreads();
    st_transp(St, LS, S, wm, wn, r, h);
  }
}

DI void ret_chain(const Params& p, int layer, int chain, char* lds) {
  int tid_ = VTID;
  asm volatile("" : "+v"(tid_));
  const int tid = tid_, wave = tid >> 6, lane = tid & 63, r = lane & 31, h = lane >> 5;
  const int wm = wave >> 1, wn = wave & 1;
  const int b = chain >> 3, hh = (chain >> 1) & 3, dir = chain & 1;
  constexpr int L4 = 40;
  u16* qA = (u16*)lds;
  u16* kA = qA + 64 * L4;
  u16* ks = kA + 64 * L4;
  u16* vs = ks + 64 * LS;
  u16* QK = vs + 64 * LS;
  u16* Rt = QK + 64 * LS;
  const u16* QC = (const u16*)(p.ws + O_QC);
  const u16* KC = (const u16*)(p.ws + O_KC);
  const u16* Z = (const u16*)(p.ws + O_Z);
  u16* OUT = dir ? (u16*)(p.ws + O_ORB) : (u16*)(p.ws + O_ACT) + 512;
  const int opitch = dir ? 256 : AP;
  const int lc = tid >> 2, lp4 = (tid & 3) * 8;
  const int vc = tid >> 3, vp = (tid & 7) * 8;
  const float lg = log1pf(-expf(p.ret_l1m[layer * 8 + dir * 4 + hh]));
  f32x16 R = zero16();
  auto rowof = [&](int n, int c) -> int {
    int cn, base, len;
    if (n < 4) { cn = n; base = NLAT + b * LC; len = LC; } else { cn = n - 4; base = b * TT; len = TT; }
    int pos = cn * 64 + c;
    return base + (dir ? len - 1 - pos : pos);
  };
  uint4 pq, pk, pv0, pv1;
#define RET_LOAD(n)                                                                                   \
  {                                                                                                   \
    const int row_ = rowof((n), lc);                                                                  \
    pq = *(const uint4*)(QC + (size_t)row_ * 128 + hh * 32 + lp4);                                    \
    pk = *(const uint4*)(KC + (size_t)row_ * 128 + hh * 32 + lp4);                                    \
    pv0 = *(const uint4*)(Z + (size_t)rowof((n), vc) * ZW + C_CV + hh * 64 + vp);                     \
    pv1 = *(const uint4*)(Z + (size_t)rowof((n), vc + 32) * ZW + C_CV + hh * 64 + vp);                \
  }
  RET_LOAD(0);
  for (int n = 0; n < 68; ++n) {
    __syncthreads();
    *(uint4*)(qA + lc * L4 + lp4) = pq;
    *(uint4*)(kA + lc * L4 + lp4) = pk;
    st8s(ks + lc * L4 + lp4, pk, __expf((float)(63 - lc) * lg));
    *(uint4*)(vs + vc * LS + vp) = pv0;
    *(uint4*)(vs + (vc + 32) * LS + vp) = pv1;
    if (wm == 0) st_transp(Rt, L4, R, wm, wn, r, h);
    if (n + 1 < 68) RET_LOAD(n + 1);
    __syncthreads();
    {
      f32x16 qk = mm64<2>(qA, L4, kA, L4, wm, wn, r, h);
      const int s = wn * 32 + r;
#pragma unroll
      for (int g = 0; g < 16; ++g) {
        int c = wm * 32 + crow(g, h);
        qk[g] = (s <= c) ? qk[g] * __expf((float)(c - s) * lg) : 0.f;
      }
      st_transp(QK, LS, qk, wm, wn, r, h);
    }
    __syncthreads();
    {
      f32x16 o1 = mm64x<4, true, true>(QK, LS, vs, LS, wm, wn, r, h, lane);
      f32x16 o2 = mm64<2>(qA, L4, Rt, L4, wm, wn, r, h);
      const float gch = __expf(64.f * lg);
#pragma unroll
      for (int g = 0; g < 16; ++g) {
        int c = wm * 32 + crow(g, h);
        float ov = o1[g] + __expf((float)(c + 1) * lg) * o2[g];
        OUT[(size_t)rowof(n, c) * opitch + hh * 64 + wn * 32 + r] = f2bf(ov);
      }
      if (wm == 0) {
        f32x16 rn = mm64x<4, true, true>(ks, L4, vs, LS, wm, wn, r, h, lane);
#pragma unroll
        for (int g = 0; g < 16; ++g) R[g] = R[g] * gch + rn[g];
      }
    }
  }
}

DI void mixer_phase(const Params& p, int layer, char* lds, char* lds_all, int* s_tile) {
  int* cnt = (int*)(p.ws + O_CNT) + layer;
  const int nattn = layer == 0 ? 2176 : 2048;
  const int total = 128 + 128 + 2 * nattn;
  for (;;) {
    __syncthreads();
    if (threadIdx.x == 0) *s_tile = atomicAdd(cnt, 1);
    __syncthreads();
    const int t = 2 * (*s_tile) + VHALF;
    if (t >= total) break;
    if (t < 128) dn_chain(p, t, lds);
    else if (t < 256) ret_chain(p, layer, t - 128, lds);
    else if (t < 256 + nattn) mla_attn(p, t - 256, lds_all);
    else swa_attn(p, layer, t - 256 - nattn, lds_all);
  }
}

DI void dn_finalize(const Params& p, int layer, int nrows) {
  int tid_ = VTID;
  asm volatile("" : "+v"(tid_));
  const int tid = tid_;
  const u16* OB = (const u16*)(p.ws + O_OB);
  const u16* Z = (const u16*)(p.ws + O_Z);
  u16* act = (u16*)(p.ws + O_ACT);
  const int ntask = nrows * 32, stride = VG * 256;
  for (int id0 = VB * 256 + tid; id0 < ntask; id0 += 4 * stride) {
    u32x4 a[4], b[4], z[4];
#pragma unroll
    for (int u = 0; u < 4; ++u) {
      const int id = id0 + u * stride;
      const bool ok = id < ntask;
      const int row = ok ? (id >> 5) : 0, c8 = id & 31;
      a[u] = ldg16(act + (size_t)row * AP + 256 + c8 * 8);
      b[u] = ldg16(OB + (size_t)row * 256 + c8 * 8);
      z[u] = ldg16(Z + (size_t)row * ZW + C_BZ + c8 * 8);
    }
#pragma unroll
    for (int u = 0; u < 4; ++u) {
      const int id = id0 + u * stride;
      const int row = id >> 5, c8 = id & 31;
      float fa[8], fb[8], fz[8], o[8];
      unpack8(a[u], fa); unpack8(b[u], fb); unpack8(z[u], fz);
      float ss = 0.f;
#pragma unroll
      for (int e = 0; e < 8; ++e) { o[e] = fa[e] + fb[e]; ss += o[e] * o[e]; }
      ss += __shfl_xor(ss, 1); ss += __shfl_xor(ss, 2); ss += __shfl_xor(ss, 4);
      const float rn = rsqrtf(ss * (1.f / 64.f) + 1e-6f);
      const float4 g0 = *(const float4*)(p.dn_norm_g + layer * 64 + (c8 & 7) * 8), g1 = *(const float4*)(p.dn_norm_g + layer * 64 + (c8 & 7) * 8 + 4);
      const float gg[8] = {g0.x, g0.y, g0.z, g0.w, g1.x, g1.y, g1.z, g1.w};
#pragma unroll
      for (int e = 0; e < 8; ++e) o[e] = o[e] * rn * gg[e] * siluf(fz[e]);
      if (id < ntask) *(u32x4*)(act + (size_t)row * AP + 256 + c8 * 8) = pack8(o);
    }
  }
  const u16* ORB = (const u16*)(p.ws + O_ORB);
  for (int id0 = VB * 256 + tid; id0 < ntask; id0 += 4 * stride) {
    u32x4 a[4], b[4], z[4];
#pragma unroll
    for (int u = 0; u < 4; ++u) {
      const int id = id0 + u * stride;
      const bool ok = id < ntask;
      const int row = ok ? (id >> 5) : 0, c8 = id & 31;
      a[u] = ldg16(act + (size_t)row * AP + 512 + c8 * 8);
      b[u] = ldg16(ORB + (size_t)row * 256 + c8 * 8);
      z[u] = ldg16(Z + (size_t)row * ZW + C_CG + c8 * 8);
    }
#pragma unroll
    for (int u = 0; u < 4; ++u) {
      const int id = id0 + u * stride;
      const int row = id >> 5, c8 = id & 31;
      float fa[8], fb[8], fz[8], o[8];
      unpack8(a[u], fa); unpack8(b[u], fb); unpack8(z[u], fz);
      float sm = 0.f;
#pragma unroll
      for (int e = 0; e < 8; ++e) { o[e] = fa[e] + fb[e]; sm += o[e]; }
      sm += __shfl_xor(sm, 1); sm += __shfl_xor(sm, 2); sm += __shfl_xor(sm, 4);
      const float mean = sm * (1.f / 64.f);
      float ss = 0.f;
#pragma unroll
      for (int e = 0; e < 8; ++e) { o[e] -= mean; ss += o[e] * o[e]; }
      ss += __shfl_xor(ss, 1); ss += __shfl_xor(ss, 2); ss += __shfl_xor(ss, 4);
      const float rn = rsqrtf(ss * (1.f / 64.f) + 1e-6f);
      const float4 g0 = *(const float4*)(p.ret_norm_g + layer * 256 + c8 * 8), g1 = *(const float4*)(p.ret_norm_g + layer * 256 + c8 * 8 + 4);
      const float gg[8] = {g0.x, g0.y, g0.z, g0.w, g1.x, g1.y, g1.z, g1.w};
#pragma unroll
      for (int e = 0; e < 8; ++e) o[e] = o[e] * rn * gg[e] * siluf(fz[e]);
      if (id < ntask) *(u32x4*)(act + (size_t)row * AP + 512 + c8 * 8) = pack8(o);
    }
  }
}

DI void gbar(const Params& p, unsigned& target) {
  unsigned* bar = (unsigned*)(p.ws + O_CNT + 128);
  target += gridDim.x;
  __syncthreads();
  if (threadIdx.x == 0) {
    __builtin_amdgcn_fence(__ATOMIC_RELEASE, "agent");
    __hip_atomic_fetch_add(bar, 1u, __ATOMIC_RELAXED, __HIP_MEMORY_SCOPE_AGENT);
    while (__hip_atomic_load(bar, __ATOMIC_RELAXED, __HIP_MEMORY_SCOPE_AGENT) < target) __builtin_amdgcn_s_sleep(2);
    __builtin_amdgcn_fence(__ATOMIC_ACQUIRE, "agent");
  }
  __syncthreads();
}

__global__ void __launch_bounds__(512, 2) fwd_megakernel(Params p) {
  __shared__ __attribute__((aligned(16))) char lds_all[2 * LDS_BYTES];
  __shared__ int s_tile;
  char* lds = lds_all + VHALF * LDS_BYTES;
  cg::grid_group grid = cg::this_grid();
  if (p.ws == nullptr) grid.sync();
  unsigned bt = 0;
  phase0a(p, lds);
  gbar(p, bt);
  modulate_rows(p, 0, ROWS);
  gbar(p, bt);
  for (int layer = 0; layer < 2; ++layer) {
    const int nrows = layer == 0 ? ROWS : NLAT;
    gemm_phase(p, layer, 0, ROWS, lds_all);
    gbar(p, bt);
    prep_phase(p, layer, lds);
    gbar(p, bt);
    mixer_phase(p, layer, lds, lds_all, &s_tile);
    gbar(p, bt);
    dn_finalize(p, layer, nrows);
    gbar(p, bt);
    gemm_phase(p, layer, 1, nrows, lds_all);
    gbar(p, bt);
    ln_rows(p, p.ln1_g + layer * DM, p.ln1_b + layer * DM, nrows, layer, 3, true);
    gbar(p, bt);
    gemm_phase(p, layer, 2, nrows, lds_all);
    gbar(p, bt);
    gemm_phase(p, layer, 3, nrows, lds_all);
    gbar(p, bt);
    ln_rows(p, p.ln2_g + layer * DM, p.ln2_b + layer * DM, nrows, layer == 0 ? 1 : 0, 0, layer == 0);
    if (layer == 0) gbar(p, bt);
  }
}

extern "C" void kernel_launch(void* const* d_in, const int* in_sizes, int n_in, void* d_out, int out_size, void* d_ws,
                              size_t ws_size, hipStream_t stream) {
  static int grid_blocks = 0;
  if (!grid_blocks) {
    int dev = 0, cus = 0, per_cu = 0;
    hipGetDevice(&dev);
    hipDeviceGetAttribute(&cus, hipDeviceAttributeMultiprocessorCount, dev);
    hipOccupancyMaxActiveBlocksPerMultiprocessor(&per_cu, fwd_megakernel, 512, 0);
    if (per_cu < 1) per_cu = 1;
    if (per_cu > 1) per_cu = 1;
    grid_blocks = cus * per_cu;
    if (ws_size < WS_END) fprintf(stderr, "kernel_launch: workspace too small: %zu < %zu\n", ws_size, (size_t)WS_END);
  }
  Params p{};
  const float** f = (const float**)&p;
  for (int i = 0; i < 25; ++i) f[i] = (const float*)d_in[i];
  p.out = (float*)d_out;
  p.ws = (unsigned char*)d_ws;
  hipMemsetAsync((char*)d_ws + O_CNT, 0, 256, stream);
  void* args[] = {&p};
  hipError_t e = hipLaunchCooperativeKernel((void*)fwd_megakernel, dim3(grid_blocks), dim3(512), args, 0, stream);
  if (e != hipSuccess) fprintf(stderr, "cooperative launch failed: %s (grid %d)\n", hipGetErrorString(e), grid_blocks);
}
```

```cpp
#include <hip/hip_runtime.h>
#include <hip/hip_cooperative_groups.h>
#include <cstdio>
namespace cg = cooperative_groups;

#define DI __device__ __forceinline__
typedef unsigned short u16;
typedef unsigned int u32;
using bf16x8 = __attribute__((ext_vector_type(8))) short;
using s16x4 = __attribute__((ext_vector_type(4))) short;
using f32x16 = __attribute__((ext_vector_type(16))) float;
typedef __bf16 bfv2 __attribute__((ext_vector_type(2)));
typedef float flv2 __attribute__((ext_vector_type(2)));
#define MFMA(a, b, c) __builtin_amdgcn_mfma_f32_32x32x16_bf16((a), (b), (c), 0, 0, 0)
#define VHALF ((int)__builtin_amdgcn_readfirstlane((int)(threadIdx.x >> 8)))
#define VTID ((int)(threadIdx.x & 255))
#define VB ((int)(blockIdx.x * 2 + VHALF))
#define VG ((int)(gridDim.x * 2))

constexpr int NB = 16, TT = 4096, LC = 256, DM = 1024, NLAT = NB * TT, NCTX = NB * LC, ROWS = NLAT + NCTX;
constexpr int ZW = 2816, DFF = 4096, NPOS = TT + LC;
constexpr int AP = 1152;
constexpr int WP = 1152;
constexpr int WP2 = 4224;
constexpr int HP = 4224;
constexpr int KVP = 576;
constexpr float LOG2E = 1.4426950408889634f;
constexpr float DN_ALPHA = 1.4142135623730951f;
constexpr int C_AQ = 0, C_AK = 256, C_AV = 384, C_BQKV = 512, C_BZ = 1280, C_BAB = 1536, C_CQ = 1552, C_CK = 1680,
              C_CV = 1808, C_CG = 2064, C_DCQ = 2320, C_DCKV = 2576, C_DKR = 2704;

constexpr size_t al256(size_t x) { return (x + 255) & ~size_t(255); }
constexpr size_t SZ_WIN = (size_t)ZW * WP * 2, SZ_WOUT = (size_t)DM * WP * 2, SZ_WFF = (size_t)DFF * WP * 2,
                 SZ_WUQ = 384 * 256 * 2, SZ_WUKV = 512 * 128 * 2;
constexpr size_t O_WIN = 0;
constexpr size_t O_WOUT = O_WIN + 2 * SZ_WIN;
constexpr size_t O_WFF1 = O_WOUT + 2 * SZ_WOUT;
constexpr size_t O_WFF2 = O_WFF1 + 2 * SZ_WFF;
constexpr size_t O_WUQ = O_WFF2 + 2 * SZ_WFF;
constexpr size_t O_WUKV = O_WUQ + 2 * SZ_WUQ;
constexpr size_t O_MOD = O_WUKV + 2 * SZ_WUKV;
constexpr size_t O_TAB = al256(O_MOD + 2 * 17 * 6144 * 4);
constexpr size_t O_CNT = O_TAB + (size_t)TT * 64 * 8;
constexpr size_t O_GRAW = O_CNT + 256;
constexpr size_t O_G2 = O_GRAW + (size_t)ROWS * 16 * 4;
constexpr size_t O_XC = O_G2 + (size_t)ROWS * 16 * 4;
constexpr size_t O_ACT = O_XC + (size_t)NCTX * DM * 4;
constexpr size_t O_Z = O_ACT + (size_t)ROWS * AP * 2;
constexpr size_t O_QA = O_Z + (size_t)ROWS * ZW * 2;
constexpr size_t O_KA = O_QA + (size_t)NB * 4 * NPOS * 64 * 2;
constexpr size_t O_QD = O_KA + (size_t)NB * 2 * NPOS * 64 * 2;
constexpr size_t O_KVD = O_QD + (size_t)ROWS * 384 * 2;
constexpr size_t O_KR = O_KVD + (size_t)ROWS * KVP * 2;
constexpr size_t O_QKVB = O_KR + (size_t)ROWS * 32 * 2;
constexpr size_t O_OB = O_QKVB + (size_t)ROWS * 768 * 2;
constexpr size_t O_QC = O_OB + (size_t)ROWS * 256 * 2;
constexpr size_t O_KC = O_QC + (size_t)ROWS * 128 * 2;
constexpr size_t O_ORB = O_KC + (size_t)ROWS * 128 * 2;
constexpr size_t O_ST = O_ORB + (size_t)ROWS * 256 * 2;
constexpr size_t WS_END = O_ST + (size_t)ROWS * 8;
static_assert(O_Z + (size_t)ROWS * HP * 2 <= WS_END, "hid alias");
static_assert((size_t)DM * WP2 * 2 <= SZ_WFF, "ff2 weights");
static_assert(WS_END <= (size_t)1073741824, "workspace");

constexpr int LDS_BYTES = 73728;

struct Params {
  const float *x, *c, *ctx, *c_ctx, *ada_w, *ada_b, *w_in, *swa_sink, *dn_conv_w, *dn_a_log, *dn_dt_bias, *dn_norm_g,
      *ret_l1m, *ret_norm_g, *mla_q_norm, *mla_w_uq, *mla_kv_norm, *mla_w_ukv, *w_out, *ln1_g, *ln1_b, *w_ff1, *w_ff2,
      *ln2_g, *ln2_b;
  float* out;
  unsigned char* ws;
};

DI u16 f2bf(float x) { return __builtin_bit_cast(u16, (__bf16)x); }
DI float bf2f(u16 v) { return __uint_as_float(((u32)v) << 16); }
DI u32 pack2(float a, float b) {
  flv2 f = {a, b};
  bfv2 v = __builtin_convertvector(f, bfv2);
  return __builtin_bit_cast(u32, v);
}
DI float bflo(u32 u) { return __uint_as_float(u << 16); }
DI float bfhi(u32 u) { return __uint_as_float(u & 0xffff0000u); }
DI int crow(int reg, int h) { return (reg & 3) + 8 * (reg >> 2) + 4 * h; }
DI float wave_sum(float v) {
#pragma unroll
  for (int o = 32; o >= 1; o >>= 1) v += __shfl_xor(v, o);
  return v;
}
DI float siluf(float x) { return x / (1.f + __expf(-x)); }
DI f32x16 zero16() {
  f32x16 z;
#pragma unroll
  for (int i = 0; i < 16; ++i) z[i] = 0.f;
  return z;
}

DI void scat8s(u16* base, int stride, const uint4& v, float f) {
  base[0 * stride] = f2bf(bflo(v.x) * f); base[1 * stride] = f2bf(bfhi(v.x) * f);
  base[2 * stride] = f2bf(bflo(v.y) * f); base[3 * stride] = f2bf(bfhi(v.y) * f);
  base[4 * stride] = f2bf(bflo(v.z) * f); base[5 * stride] = f2bf(bfhi(v.z) * f);
  base[6 * stride] = f2bf(bflo(v.w) * f); base[7 * stride] = f2bf(bfhi(v.w) * f);
}
DI void scat8r(u16* base, int stride, const uint4& v) {
  base[0 * stride] = (u16)(v.x & 0xffffu); base[1 * stride] = (u16)(v.x >> 16);
  base[2 * stride] = (u16)(v.y & 0xffffu); base[3 * stride] = (u16)(v.y >> 16);
  base[4 * stride] = (u16)(v.z & 0xffffu); base[5 * stride] = (u16)(v.z >> 16);
  base[6 * stride] = (u16)(v.w & 0xffffu); base[7 * stride] = (u16)(v.w >> 16);
}
DI float sumsq8(const uint4& u) {
  float s = 0.f, a;
  a = bflo(u.x); s += a * a; a = bfhi(u.x); s += a * a;
  a = bflo(u.y); s += a * a; a = bfhi(u.y); s += a * a;
  a = bflo(u.z); s += a * a; a = bfhi(u.z); s += a * a;
  a = bflo(u.w); s += a * a; a = bfhi(u.w); s += a * a;
  return s;
}
typedef u32 u32x4 __attribute__((ext_vector_type(4)));
DI u32x4 ldg16(const u16* p) { return *(const u32x4*)p; }
DI void unpack8(const u32x4& u, float* f) {
  f[0] = bflo(u[0]); f[1] = bfhi(u[0]); f[2] = bflo(u[1]); f[3] = bfhi(u[1]);
  f[4] = bflo(u[2]); f[5] = bfhi(u[2]); f[6] = bflo(u[3]); f[7] = bfhi(u[3]);
}
DI u32x4 pack8(const float* f) {
  u32x4 o;
  o[0] = pack2(f[0], f[1]); o[1] = pack2(f[2], f[3]); o[2] = pack2(f[4], f[5]); o[3] = pack2(f[6], f[7]);
  return o;
}
DI float* xrow(const Params& p, int row) {
  return row < NLAT ? p.out + (size_t)row * DM : (float*)(p.ws + O_XC) + (size_t)(row - NLAT) * DM;
}
DI const float* xrow0(const Params& p, int row) {
  return row < NLAT ? p.x + (size_t)row * DM : p.ctx + (size_t)(row - NLAT) * DM;
}
DI int rowb(int row) { return row < NLAT ? (row >> 12) : 16; }

constexpr int CSL = 132;
constexpr int GS = 72;
template <typename Epi>
DI void gemm_tile(const u16* __restrict__ A, int lda, const u16* __restrict__ Bt, int ldb, int K, char* lds, Epi epi) {
  u16* As = (u16*)lds;
  u16* Bs = As + 256 * GS;
  float* Cs = (float*)lds;
  int tid_ = VTID;
  asm volatile("" : "+v"(tid_));
  const int tid = tid_, wave = tid >> 6, lane = tid & 63, r = lane & 31, h = lane >> 5;
  const int wm = wave >> 1, wn = wave & 1;
  f32x16 acc[4][2];
#pragma unroll
  for (int i = 0; i < 4; ++i)
#pragma unroll
    for (int j = 0; j < 2; ++j) acc[i][j] = zero16();
  const int lrow = tid >> 3, lcol = (tid & 7) * 8;
  const u16* Ap = A + (size_t)lrow * lda + lcol;
  const u16* Bp = Bt + (size_t)lrow * ldb + lcol;
  u16* Aw = As + lrow * GS + lcol;
  u16* Bw = Bs + lrow * GS + lcol;
  u32x4 ra[8], rb[4];
#define GT_LOAD(k0)                                                                 \
  {                                                                                 \
    _Pragma("unroll") for (int i_ = 0; i_ < 8; ++i_) ra[i_] = ldg16(Ap + (size_t)(i_ * 32) * lda + (k0)); \
    _Pragma("unroll") for (int i_ = 0; i_ < 4; ++i_) rb[i_] = ldg16(Bp + (size_t)(i_ * 32) * ldb + (k0)); \
  }
#define GT_STORE()                                                                  \
  {                                                                                 \
    _Pragma("unroll") for (int i_ = 0; i_ < 8; ++i_) *(u32x4*)(Aw + i_ * 32 * GS) = ra[i_]; \
    _Pragma("unroll") for (int i_ = 0; i_ < 4; ++i_) *(u32x4*)(Bw + i_ * 32 * GS) = rb[i_]; \
  }
#define GT_COMPUTE()                                                                              \
  _Pragma("unroll") for (int ks = 0; ks < 4; ++ks) {                                              \
    bf16x8 fa[4], fb[2];                                                                          \
    _Pragma("unroll") for (int i_ = 0; i_ < 4; ++i_)                                              \
      fa[i_] = *(const bf16x8*)(As + (wm * 128 + i_ * 32 + r) * GS + ks * 16 + 8 * h);            \
    _Pragma("unroll") for (int j_ = 0; j_ < 2; ++j_)                                              \
      fb[j_] = *(const bf16x8*)(Bs + (wn * 64 + j_ * 32 + r) * GS + ks * 16 + 8 * h);             \
    _Pragma("unroll") for (int i_ = 0; i_ < 4; ++i_)                                              \
      _Pragma("unroll") for (int j_ = 0; j_ < 2; ++j_) acc[i_][j_] = MFMA(fa[i_], fb[j_], acc[i_][j_]); \
  }
  const int nk = K >> 6;
  GT_LOAD(0);
  for (int kt = 0; kt + 1 < nk; ++kt) {
    __syncthreads();
    GT_STORE();
    __syncthreads();
    GT_LOAD((kt + 1) << 6);
    GT_COMPUTE();
  }
  __syncthreads();
  GT_STORE();
  __syncthreads();
  GT_COMPUTE();
#pragma unroll 1
  for (int half = 0; half < 2; ++half) {
    __syncthreads();
    if (wm == half) {
#pragma unroll
      for (int i = 0; i < 4; ++i)
#pragma unroll
        for (int j = 0; j < 2; ++j)
#pragma unroll
          for (int g = 0; g < 16; ++g) Cs[(i * 32 + crow(g, h)) * CSL + wn * 64 + j * 32 + r] = acc[i][j][g];
    }
    __syncthreads();
    epi(half);
  }
}

constexpr int CSW = 264;
template <typename Epi>
DI void gemm_tile512(const u16* __restrict__ A, int lda, const u16* __restrict__ Bt, int ldb, int K, char* lds_all, Epi epi) {
  constexpr int STG = 2 * 256 * GS;
  u16* S0 = (u16*)lds_all;
  float* Cs = (float*)lds_all;
  int tid_ = threadIdx.x;
  asm volatile("" : "+v"(tid_));
  const int tid = tid_, wave = tid >> 6, lane = tid & 63, r = lane & 31, h = lane >> 5;
  const int wm = wave >> 2, wn = wave & 3;
  f32x16 acc[4][2];
#pragma unroll
  for (int i = 0; i < 4; ++i)
#pragma unroll
    for (int j = 0; j < 2; ++j) acc[i][j] = zero16();
  const int lrow = tid >> 3, lcol = (tid & 7) * 8;
  const u16* Ap = A + (size_t)lrow * lda + lcol;
  const u16* Bp = Bt + (size_t)lrow * ldb + lcol;
  u16* Sw = S0 + lrow * GS + lcol;
  u32x4 ra[4], rb[4];
#define G5_LOAD(k0)                                                                 \
  {                                                                                 \
    _Pragma("unroll") for (int i_ = 0; i_ < 4; ++i_) ra[i_] = ldg16(Ap + (size_t)(i_ * 64) * lda + (k0)); \
    _Pragma("unroll") for (int i_ = 0; i_ < 4; ++i_) rb[i_] = ldg16(Bp + (size_t)(i_ * 64) * ldb + (k0)); \
  }
#define G5_STORE(s)                                                                 \
  {                                                                                 \
    _Pragma("unroll") for (int i_ = 0; i_ < 4; ++i_) *(u32x4*)(Sw + (s) * STG + i_ * 64 * GS) = ra[i_]; \
    _Pragma("unroll") for (int i_ = 0; i_ < 4; ++i_) *(u32x4*)(Sw + (s) * STG + 256 * GS + i_ * 64 * GS) = rb[i_]; \
  }
#define G5_COMPUTE(s)                                                                             \
  {                                                                                               \
    const u16* As_ = S0 + (s) * STG;                                                              \
    const u16* Bs_ = As_ + 256 * GS;                                                              \
    _Pragma("unroll") for (int ks = 0; ks < 4; ++ks) {                                            \
      bf16x8 fa[4], fb[2];                                                                        \
      _Pragma("unroll") for (int i_ = 0; i_ < 4; ++i_)                                            \
        fa[i_] = *(const bf16x8*)(As_ + (wm * 128 + i_ * 32 + r) * GS + ks * 16 + 8 * h);         \
      _Pragma("unroll") for (int j_ = 0; j_ < 2; ++j_)                                            \
        fb[j_] = *(const bf16x8*)(Bs_ + (wn * 64 + j_ * 32 + r) * GS + ks * 16 + 8 * h);          \
      _Pragma("unroll") for (int i_ = 0; i_ < 4; ++i_)                                            \
        _Pragma("unroll") for (int j_ = 0; j_ < 2; ++j_) acc[i_][j_] = MFMA(fa[i_], fb[j_], acc[i_][j_]); \
    }                                                                                             \
  }
  const int nk = K >> 6;
  __syncthreads();
  G5_LOAD(0);
  G5_STORE(0);
  G5_LOAD(64);
  __syncthreads();
  for (int kt = 0; kt + 2 < nk; ++kt) {
    const int cur = kt & 1;
    G5_STORE(cur ^ 1);
    G5_LOAD((kt + 2) << 6);
    G5_COMPUTE(cur);
    __syncthreads();
  }
  {
    const int cur = (nk - 2) & 1;
    G5_STORE(cur ^ 1);
    G5_COMPUTE(cur);
    __syncthreads();
    G5_COMPUTE(cur ^ 1);
  }
#pragma unroll 1
  for (int half = 0; half < 2; ++half) {
    __syncthreads();
    if (wm == half) {
#pragma unroll
      for (int i = 0; i < 4; ++i)
#pragma unroll
        for (int j = 0; j < 2; ++j)
#pragma unroll
          for (int g = 0; g < 16; ++g) Cs[(i * 32 + crow(g, h)) * CSW + wn * 64 + j * 32 + r] = acc[i][j][g];
    }
    __syncthreads();
    epi(half);
  }
}

DI void wtrans_tile(const float* __restrict__ src, int K, int N, u16* __restrict__ dst, int ldw, int tk, int tn,
                    const float* __restrict__ kscale, char* lds) {
  float* t = (float*)lds;
  int tid_ = VTID;
  asm volatile("" : "+v"(tid_));
  const int tid = tid_, j = tid & 63, i0 = tid >> 6;
  const int k0 = tk * 64, n0 = tn * 64;
  __syncthreads();
#pragma unroll
  for (int q = 0; q < 16; ++q) {
    int i = i0 + 4 * q;
    float v = (n0 + j < N) ? src[(size_t)(k0 + i) * N + n0 + j] : 0.f;
    if (kscale) v *= kscale[k0 + i];
    t[i * 65 + j] = v;
  }
  __syncthreads();
#pragma unroll 4
  for (int q = 0; q < 16; ++q) {
    int jj = i0 + 4 * q;
    dst[(size_t)(n0 + jj) * ldw + k0 + j] = f2bf(t[j * 65 + jj]);
  }
}

DI void ada_tile(const Params& p, int layer, int cg64, char* lds) {
  float* sc = (float*)lds;
  int tid_ = VTID;
  asm volatile("" : "+v"(tid_));
  const int tid = tid_;
  __syncthreads();
  for (int e = tid; e < 17 * 1024; e += 256) {
    int bi = e >> 10, k = e & 1023;
    float v = bi < 16 ? p.c[bi * 1024 + k] : p.c_ctx[k];
    sc[e] = siluf(v);
  }
  __syncthreads();
  const int col = tid & 63, kq = tid >> 6;
  const int n = cg64 * 64 + col;
  const float* w = p.ada_w + (size_t)layer * 1024 * 6144 + n;
  float acc[17];
#pragma unroll
  for (int i = 0; i < 17; ++i) acc[i] = 0.f;
#pragma unroll 8
  for (int kk = 0; kk < 256; ++kk) {
    int k = kq * 256 + kk;
    float wv = w[(size_t)k * 6144];
#pragma unroll
    for (int i = 0; i < 17; ++i) acc[i] += sc[i * 1024 + k] * wv;
  }
  __syncthreads();
  float* red = (float*)lds;
#pragma unroll
  for (int i = 0; i < 17; ++i) red[(kq * 17 + i) * 64 + col] = acc[i];
  __syncthreads();
  float* mod = (float*)(p.ws + O_MOD) + (size_t)layer * 17 * 6144;
  for (int e = tid; e < 17 * 64; e += 256) {
    int bi = e >> 6, cc = e & 63;
    float s = red[(0 * 17 + bi) * 64 + cc] + red[(1 * 17 + bi) * 64 + cc] + red[(2 * 17 + bi) * 64 + cc] +
              red[(3 * 17 + bi) * 64 + cc];
    int nn = cg64 * 64 + cc;
    mod[bi * 6144 + nn] = s + p.ada_b[layer * 6144 + nn];
  }
}

DI void wtile(const Params& p, int layer, int q, char* lds) {
  if (q < 704) {
    wtrans_tile(p.w_in + (size_t)layer * 1024 * 2736, 1024, 2736, (u16*)(p.ws + O_WIN + layer * SZ_WIN), WP, q / 44, q % 44,
                nullptr, lds);
  } else if (q < 960) {
    q -= 704;
    wtrans_tile(p.w_out + (size_t)layer * 1024 * 1024, 1024, 1024, (u16*)(p.ws + O_WOUT + layer * SZ_WOUT), WP, q / 16, q % 16,
                nullptr, lds);
  } else if (q < 1984) {
    q -= 960;
    wtrans_tile(p.w_ff1 + (size_t)layer * 1024 * 4096, 1024, 4096, (u16*)(p.ws + O_WFF1 + layer * SZ_WFF), WP, q / 64, q % 64,
                nullptr, lds);
  } else if (q < 3008) {
    q -= 1984;
    wtrans_tile(p.w_ff2 + (size_t)layer * 4096 * 1024, 4096, 1024, (u16*)(p.ws + O_WFF2 + layer * SZ_WFF), WP2, q / 16, q % 16,
                nullptr, lds);
  } else if (q < 3032) {
    q -= 3008;
    wtrans_tile(p.mla_w_uq + (size_t)layer * 256 * 384, 256, 384, (u16*)(p.ws + O_WUQ + layer * SZ_WUQ), 256, q / 6, q % 6,
                p.mla_q_norm + layer * 256, lds);
  } else {
    q -= 3032;
    wtrans_tile(p.mla_w_ukv + (size_t)layer * 128 * 512, 128, 512, (u16*)(p.ws + O_WUKV + layer * SZ_WUKV), 128, q / 8, q % 8,
                p.mla_kv_norm + layer * 128, lds);
  }
}
DI void wtile_deferred(const Params& p, int d, char* lds) {
  if (d < 2304) wtile(p, 0, 704 + d, lds);
  else wtile(p, 1, d - 2304, lds);
}

DI void phase0a(const Params& p, char* lds) {
  int tid_ = VTID;
  asm volatile("" : "+v"(tid_));
  const int tid = tid_;
  for (int t = VB; t < 1192; t += VG) {
    if (t < 744) {
      wtile(p, 0, t < 704 ? t : 3008 + (t - 704), lds);
    } else if (t < 936) {
      int q = t - 744;
      ada_tile(p, q / 96, q % 96, lds);
    } else {
      int q = t - 936;
      float2* tab = (float2*)(p.ws + O_TAB);
      for (int e = q * 1024 + tid; e < (q + 1) * 1024; e += 256) {
        int tok = e >> 6, i = e & 63;
        float ang;
        if (i < 32) {
          int f = i & 15;
          float inv = powf(10000.f, -(float)(2 * f) / 32.f);
          ang = (float)(i < 16 ? (tok >> 6) : (tok & 63)) * inv;
        } else if (i < 48) {
          int f = i - 32;
          float inv = powf(10000.f, -(float)(2 * f) / 32.f);
          ang = (float)tok * inv;
        } else {
          int f = (i - 48) & 7;
          float inv = powf(10000.f, -(float)(2 * f) / 16.f);
          ang = (float)((i - 48) < 8 ? (tok >> 6) : (tok & 63)) * inv;
        }
        float sn, cs;
        sincosf(ang, &sn, &cs);
        tab[e] = make_float2(cs, sn);
      }
    }
  }
}

DI void modulate_rows(const Params& p, int layer_mod, int nrows) {
  int tid_ = VTID;
  asm volatile("" : "+v"(tid_));
  const int tid = tid_, wave = tid >> 6, lane = tid & 63;
  const float* mod = (const float*)(p.ws + O_MOD) + (size_t)layer_mod * 17 * 6144;
  u16* act = (u16*)(p.ws + O_ACT);
  const int stride = VG * 4;
  for (int row0 = VB * 4 + wave; row0 < nrows; row0 += 2 * stride) {
    const int row1 = row0 + stride;
    const bool has1 = row1 < nrows;
    float4 va[4], vb[4];
#pragma unroll
    for (int i = 0; i < 4; ++i) {
      va[i] = *(const float4*)(xrow0(p, row0) + (i * 64 + lane) * 4);
      vb[i] = has1 ? *(const float4*)(xrow0(p, row1) + (i * 64 + lane) * 4) : make_float4(0.f, 0.f, 0.f, 0.f);
    }
#pragma unroll
    for (int rr = 0; rr < 2; ++rr) {
      if (rr == 1 && !has1) break;
      const int row = rr ? row1 : row0;
      const float* m = mod + rowb(row) * 6144;
#pragma unroll
      for (int i = 0; i < 4; ++i) {
        int col = (i * 64 + lane) * 4;
        float4 v = rr ? vb[i] : va[i];
        float4 sh = *(const float4*)(m + col);
        float4 sc = *(const float4*)(m + 1024 + col);
        uint2 o;
        o.x = pack2(v.x * (1.f + sc.x) + sh.x, v.y * (1.f + sc.y) + sh.y);
        o.y = pack2(v.z * (1.f + sc.z) + sh.z, v.w * (1.f + sc.w) + sh.w);
        *(uint2*)(act + (size_t)row * AP + col) = o;
      }
    }
  }
}

DI void ln_rows(const Params& p, const float* g, const float* bb, int nrows, int mod_layer, int sh_chunk, bool write_act) {
  int tid_ = VTID;
  asm volatile("" : "+v"(tid_));
  const int tid = tid_, wave = tid >> 6, lane = tid & 63;
  u16* act = (u16*)(p.ws + O_ACT);
  const int stride = VG * 4;
  for (int row0 = VB * 4 + wave; row0 < nrows; row0 += 2 * stride) {
    const int row1 = row0 + stride;
    const bool has1 = row1 < nrows;
    float4 va[4], vb[4];
    float sa = 0.f, sb = 0.f;
#pragma unroll
    for (int i = 0; i < 4; ++i) {
      va[i] = *(const float4*)(xrow(p, row0) + (i * 64 + lane) * 4);
      vb[i] = has1 ? *(const float4*)(xrow(p, row1) + (i * 64 + lane) * 4) : make_float4(0.f, 0.f, 0.f, 0.f);
    }
#pragma unroll
    for (int i = 0; i < 4; ++i) {
      sa += va[i].x + va[i].y + va[i].z + va[i].w;
      sb += vb[i].x + vb[i].y + vb[i].z + vb[i].w;
    }
    const float ma = wave_sum(sa) * (1.f / 1024.f), mb = wave_sum(sb) * (1.f / 1024.f);
    float qa = 0.f, qb = 0.f;
#pragma unroll
    for (int i = 0; i < 4; ++i) {
      va[i].x -= ma; va[i].y -= ma; va[i].z -= ma; va[i].w -= ma;
      vb[i].x -= mb; vb[i].y -= mb; vb[i].z -= mb; vb[i].w -= mb;
      qa += va[i].x * va[i].x + va[i].y * va[i].y + va[i].z * va[i].z + va[i].w * va[i].w;
      qb += vb[i].x * vb[i].x + vb[i].y * vb[i].y + vb[i].z * vb[i].z + vb[i].w * vb[i].w;
    }
    const float ra = rsqrtf(wave_sum(qa) * (1.f / 1024.f) + 1e-5f), rb = rsqrtf(wave_sum(qb) * (1.f / 1024.f) + 1e-5f);
#pragma unroll
    for (int rr = 0; rr < 2; ++rr) {
      if (rr == 1 && !has1) break;
      const int row = rr ? row1 : row0;
      const float rstd = rr ? rb : ra;
      float* dst = xrow(p, row);
      if (write_act && lane == 0) ((float2*)(p.ws + O_ST))[row] = make_float2(rr ? mb : ma, rstd);
      const float* m = (const float*)(p.ws + O_MOD) + (size_t)mod_layer * 17 * 6144 + rowb(row) * 6144 + sh_chunk * 1024;
#pragma unroll
      for (int i = 0; i < 4; ++i) {
        int col = (i * 64 + lane) * 4;
        float4 v = rr ? vb[i] : va[i];
        float4 gg = *(const float4*)(g + col);
        float4 bv = *(const float4*)(bb + col);
        float4 y;
        y.x = v.x * rstd * gg.x + bv.x; y.y = v.y * rstd * gg.y + bv.y;
        y.z = v.z * rstd * gg.z + bv.z; y.w = v.w * rstd * gg.w + bv.w;
        if (!write_act) *(float4*)(dst + col) = y;
        if (write_act) {
          float4 sh = *(const float4*)(m + col);
          float4 sc = *(const float4*)(m + 1024 + col);
          uint2 o;
          o.x = pack2(y.x * (1.f + sc.x) + sh.x, y.y * (1.f + sc.y) + sh.y);
          o.y = pack2(y.z * (1.f + sc.z) + sh.z, y.w * (1.f + sc.w) + sh.w);
          *(uint2*)(act + (size_t)row * AP + col) = o;
        }
      }
    }
  }
}

DI void gemm_phase(const Params& p, int layer, int mode, int nrows, char* lds_all) {
  int tid_ = threadIdx.x;
  asm volatile("" : "+v"(tid_));
  const int tid = tid_;
  const float* Cs = (const float*)lds_all;
  int ntn, K, lda, ldb;
  const u16 *A, *Bt;
  if (mode == 0) { ntn = 11; K = 1024; lda = AP; ldb = WP; A = (const u16*)(p.ws + O_ACT); Bt = (const u16*)(p.ws + O_WIN + layer * SZ_WIN); }
  else if (mode == 1) { ntn = 4; K = 1024; lda = AP; ldb = WP; A = (const u16*)(p.ws + O_ACT); Bt = (const u16*)(p.ws + O_WOUT + layer * SZ_WOUT); }
  else if (mode == 2) { ntn = 16; K = 1024; lda = AP; ldb = WP; A = (const u16*)(p.ws + O_ACT); Bt = (const u16*)(p.ws + O_WFF1 + layer * SZ_WFF); }
  else { ntn = 4; K = 4096; lda = HP; ldb = WP2; A = (const u16*)(p.ws + O_Z); Bt = (const u16*)(p.ws + O_WFF2 + layer * SZ_WFF); }
  const int ntm = nrows >> 8;
  const float* mod = (const float*)(p.ws + O_MOD) + (size_t)layer * 17 * 6144;
  const bool swz = (gridDim.x & 7) == 0;
  const int xcd = swz ? (blockIdx.x & 7) : 0, nx = swz ? 8 : 1;
  const int jb = swz ? (blockIdx.x >> 3) : blockIdx.x, nj = swz ? (gridDim.x >> 3) : gridDim.x;
  const int per = 2 * ntn, nsr = ntm >> 1;
  for (int i = jb;; i += nj) {
    const int srl = i / per, rem = i - srl * per;
    const int sr = xcd + nx * srl;
    if (sr >= nsr) break;
    const int tn = rem >> 1, tm = sr * 2 + (rem & 1);
    const int m0 = tm * 256, n0 = tn * 256;
    gemm_tile512(A + (size_t)m0 * lda, lda, Bt + (size_t)n0 * ldb, ldb, K, lds_all, [&](int half) {
      for (int idx = tid; idx < 128 * 64; idx += 512) {
        const int rr = idx >> 6, c4 = (idx & 63) * 4;
        const int row = m0 + half * 128 + rr, col = n0 + c4;
        float4 v = *(const float4*)(Cs + rr * CSW + c4);
        if (mode == 0) {
          uint2 o;
          o.x = pack2(v.x, v.y); o.y = pack2(v.z, v.w);
          *(uint2*)((u16*)(p.ws + O_Z) + (size_t)row * ZW + col) = o;
          if (n0 == C_BAB && c4 < 16) *(float4*)((float*)(p.ws + O_GRAW) + (size_t)row * 16 + c4) = v;
        } else if (mode == 2) {
          float a = fmaxf(v.x, 0.f), b = fmaxf(v.y, 0.f), c = fmaxf(v.z, 0.f), d = fmaxf(v.w, 0.f);
          uint2 o;
          o.x = pack2(a * a, b * b); o.y = pack2(c * c, d * d);
          *(uint2*)((u16*)(p.ws + O_Z) + (size_t)row * HP + col) = o;
        } else {
          const float* gate = mod + rowb(row) * 6144 + (mode == 1 ? 2 : 5) * 1024 + col;
          float4 gt = *(const float4*)gate;
          const float* res = (mode == 1 && layer == 0) ? xrow0(p, row) : xrow(p, row);
          float4 xr = *(const float4*)(res + col);
          if (!(mode == 1 && layer == 0)) {
            const float2 st = ((const float2*)(p.ws + O_ST))[row];
            const float* lg_ = (mode == 3) ? p.ln1_g + layer * DM : p.ln2_g + (layer - 1) * DM;
            const float* lb_ = (mode == 3) ? p.ln1_b + layer * DM : p.ln2_b + (layer - 1) * DM;
            const float4 lg4 = *(const float4*)(lg_ + col), lb4 = *(const float4*)(lb_ + col);
            xr.x = (xr.x - st.x) * st.y * lg4.x + lb4.x; xr.y = (xr.y - st.x) * st.y * lg4.y + lb4.y;
            xr.z = (xr.z - st.x) * st.y * lg4.z + lb4.z; xr.w = (xr.w - st.x) * st.y * lg4.w + lb4.w;
          }
          float4 o;
          o.x = DN_ALPHA * xr.x + gt.x * v.x; o.y = DN_ALPHA * xr.y + gt.y * v.y;
          o.z = DN_ALPHA * xr.z + gt.z * v.z; o.w = DN_ALPHA * xr.w + gt.w * v.w;
          *(float4*)(xrow(p, row) + col) = o;
        }
      }
    });
  }
}

DI void prep_swa(const Params& p, int tile) {
  int tid_ = VTID;
  asm volatile("" : "+v"(tid_));
  const int tid = tid_;
  const u16* Z = (const u16*)(p.ws + O_Z);
  const float4* tab = (const float4*)(p.ws + O_TAB);
  u16* QA = (u16*)(p.ws + O_QA);
  u16* KA = (u16*)(p.ws + O_KA);
  const int m0 = tile * 64;
  for (int jb = 0; jb < 6; jb += 3) {
    u32x4 x1[3], x2[3];
    float4 tb[3][4];
#pragma unroll
    for (int u = 0; u < 3; ++u) {
      const int id = tid + 256 * (jb + u), ri = id / 24, rem = id % 24, slot = rem >> 2, i8 = rem & 3;
      const int row = m0 + ri;
      const int base = slot < 4 ? C_AQ + slot * 64 : C_AK + (slot - 4) * 64;
      x1[u] = ldg16(Z + (size_t)row * ZW + base + i8 * 8);
      x2[u] = ldg16(Z + (size_t)row * ZW + base + 32 + i8 * 8);
      const int pos = row < NLAT ? (row & 4095) : 0;
#pragma unroll
      for (int e = 0; e < 4; ++e) tb[u][e] = tab[(pos * 64 + i8 * 8) / 2 + e];
    }
#pragma unroll
    for (int u = 0; u < 3; ++u) {
      const int id = tid + 256 * (jb + u), ri = id / 24, rem = id % 24, slot = rem >> 2, i8 = rem & 3;
      const int row = m0 + ri;
      const bool lat = row < NLAT;
      int b, pos;
      if (lat) { b = row >> 12; pos = row & 4095; } else { b = (row - NLAT) >> 8; pos = TT + ((row - NLAT) & 255); }
      float a1[8], a2[8], o1[8], o2[8];
      unpack8(x1[u], a1); unpack8(x2[u], a2);
      const float qs = slot < 4 ? 0.125f * LOG2E : 1.f;
#pragma unroll
      for (int e = 0; e < 4; ++e) {
        float c0 = lat ? tb[u][e].x : 1.f, s0 = lat ? tb[u][e].y : 0.f, c1 = lat ? tb[u][e].z : 1.f, s1 = lat ? tb[u][e].w : 0.f;
        o1[2 * e] = (a1[2 * e] * c0 - a2[2 * e] * s0) * qs;
        o2[2 * e] = (a1[2 * e] * s0 + a2[2 * e] * c0) * qs;
        o1[2 * e + 1] = (a1[2 * e + 1] * c1 - a2[2 * e + 1] * s1) * qs;
        o2[2 * e + 1] = (a1[2 * e + 1] * s1 + a2[2 * e + 1] * c1) * qs;
      }
      u16* d = slot < 4 ? QA + ((size_t)(b * 4 + slot) * NPOS + pos) * 64 : KA + ((size_t)(b * 2 + slot - 4) * NPOS + pos) * 64;
      *(u32x4*)(d + i8 * 8) = pack8(o1);
      *(u32x4*)(d + 32 + i8 * 8) = pack8(o2);
    }
  }
}

DI void prep_ret(const Params& p, int tile) {
  int tid_ = VTID;
  asm volatile("" : "+v"(tid_));
  const int tid = tid_;
  const u16* Z = (const u16*)(p.ws + O_Z);
  const float4* tab = (const float4*)(p.ws + O_TAB);
  u16* QC = (u16*)(p.ws + O_QC);
  u16* KC = (u16*)(p.ws + O_KC);
  const int m0 = tile * 64;
  u32x4 x1[4], x2[4];
  float4 tb[4][4];
#pragma unroll
  for (int u = 0; u < 4; ++u) {
    const int id = tid + 256 * u, ri = id >> 4, rem = id & 15, slot = rem >> 1, i8 = rem & 1;
    const int row = m0 + ri;
    const int base = C_CQ + slot * 32;
    x1[u] = ldg16(Z + (size_t)row * ZW + base + i8 * 8);
    x2[u] = ldg16(Z + (size_t)row * ZW + base + 16 + i8 * 8);
    const int pos = row < NLAT ? (row & 4095) : 0;
#pragma unroll
    for (int e = 0; e < 4; ++e) tb[u][e] = tab[(pos * 64 + 32 + i8 * 8) / 2 + e];
  }
#pragma unroll
  for (int u = 0; u < 4; ++u) {
    const int id = tid + 256 * u, ri = id >> 4, rem = id & 15, slot = rem >> 1, i8 = rem & 1;
    const int row = m0 + ri;
    const bool lat = row < NLAT;
    float a1[8], a2[8], o1[8], o2[8];
    unpack8(x1[u], a1); unpack8(x2[u], a2);
    const float qs = slot < 4 ? 0.17677669529663687f : 1.f;
#pragma unroll
    for (int e = 0; e < 4; ++e) {
      float c0 = lat ? tb[u][e].x : 1.f, s0 = lat ? tb[u][e].y : 0.f, c1 = lat ? tb[u][e].z : 1.f, s1 = lat ? tb[u][e].w : 0.f;
      o1[2 * e] = (a1[2 * e] * c0 - a2[2 * e] * s0) * qs;
      o2[2 * e] = (a1[2 * e] * s0 + a2[2 * e] * c0) * qs;
      o1[2 * e + 1] = (a1[2 * e + 1] * c1 - a2[2 * e + 1] * s1) * qs;
      o2[2 * e + 1] = (a1[2 * e + 1] * s1 + a2[2 * e + 1] * c1) * qs;
    }
    u16* d = slot < 4 ? QC + (size_t)row * 128 + slot * 32 : KC + (size_t)row * 128 + (slot - 4) * 32;
    *(u32x4*)(d + i8 * 8) = pack8(o1);
    *(u32x4*)(d + 16 + i8 * 8) = pack8(o2);
  }
}

DI void prep_dn(const Params& p, int layer, int tile, char* lds) {
  int tid_ = VTID;
  asm volatile("" : "+v"(tid_));
  const int tid = tid_;
  const u16* Z = (const u16*)(p.ws + O_Z);
  u16* QKVB = (u16*)(p.ws + O_QKVB);
  float* cw = (float*)lds;
  const int m0 = tile * 64;
  __syncthreads();
  for (int e = tid; e < 3840; e += 256) cw[e] = p.dn_conv_w[(size_t)layer * 3840 + e];
  __syncthreads();
  for (int jb = 0; jb < 24; jb += 4) {
    u32x4 xr[4][5];
#pragma unroll
    for (int u = 0; u < 4; ++u) {
      const int id = tid + 256 * (jb + u), ri = id / 96, ch8 = id % 96;
      const int row = m0 + ri;
      int tpos, seqn;
      if (row < NLAT) { tpos = row & 4095; seqn = TT; } else { tpos = (row - NLAT) & 255; seqn = LC; }
      const u16* zc = Z + (size_t)row * ZW + C_BQKV + ch8 * 8;
#pragma unroll
      for (int j = 0; j < 5; ++j) {
        const int tp = tpos + j - 2;
        u32x4 zz = {0u, 0u, 0u, 0u};
        xr[u][j] = (tp >= 0 && tp < seqn) ? ldg16(zc + (j - 2) * ZW) : zz;
      }
    }
#pragma unroll
    for (int u = 0; u < 4; ++u) {
      const int id = tid + 256 * (jb + u), ri = id / 96, ch8 = id % 96;
      const int row = m0 + ri;
      float acc[8];
#pragma unroll
      for (int e = 0; e < 8; ++e) acc[e] = 0.f;
#pragma unroll
      for (int j = 0; j < 5; ++j) {
        float x[8];
        unpack8(xr[u][j], x);
        const float4 w0 = *(const float4*)(cw + j * 768 + ch8 * 8), w1 = *(const float4*)(cw + j * 768 + ch8 * 8 + 4);
        acc[0] += x[0] * w0.x; acc[1] += x[1] * w0.y; acc[2] += x[2] * w0.z; acc[3] += x[3] * w0.w;
        acc[4] += x[4] * w1.x; acc[5] += x[5] * w1.y; acc[6] += x[6] * w1.z; acc[7] += x[7] * w1.w;
      }
      float ss = 0.f;
#pragma unroll
      for (int e = 0; e < 8; ++e) { acc[e] = siluf(acc[e]); ss += acc[e] * acc[e]; }
      ss += __shfl_xor(ss, 1); ss += __shfl_xor(ss, 2); ss += __shfl_xor(ss, 4);
      const int grp = ch8 >> 3;
      const float sc = grp < 8 ? rsqrtf(ss + 1e-6f) * (grp < 4 ? 0.125f : 1.f) : 1.f;
#pragma unroll
      for (int e = 0; e < 8; ++e) acc[e] *= sc;
      *(u32x4*)(QKVB + (size_t)row * 768 + ch8 * 8) = pack8(acc);
    }
  }
  const float* graw = (const float*)(p.ws + O_GRAW);
  float* g2 = (float*)(p.ws + O_G2);
  for (int e = tid; e < 64 * 8; e += 256) {
    int ri = e >> 3, dh = e & 7, dir = dh >> 2, hh = dh & 3;
    int row = m0 + ri;
    float ra = graw[(size_t)row * 16 + dir * 8 + hh], rb = graw[(size_t)row * 16 + dir * 8 + 4 + hh];
    float xx = ra + p.dn_dt_bias[layer * 8 + dh];
    float sp = xx > 20.f ? xx : log1pf(expf(xx));
    float lg = -expf(p.dn_a_log[layer * 8 + dh]) * sp;
    float beta = 1.f / (1.f + expf(-rb));
    g2[(size_t)row * 16 + dh] = lg;
    g2[(size_t)row * 16 + 8 + dh] = beta;
  }
}

DI void prep_mla(const Params& p, int layer, int tm, int which, int nt, char* lds) {
  int tid_ = VTID;
  asm volatile("" : "+v"(tid_));
  const int tid = tid_;
  const u16* Z = (const u16*)(p.ws + O_Z);
  const int m0 = tm * 256;
  float* rs = (float*)(lds + 128 * CSL * 4);
  const int KK = which == 0 ? 256 : 128;
  const int cbase = which == 0 ? C_DCQ : C_DCKV;
  __syncthreads();
  {
    const u16* src = Z + (size_t)(m0 + tid) * ZW + cbase;
    float s = 0.f;
    for (int i = 0; i < KK / 8; i += 4) {
      u32x4 u0 = ldg16(src + i * 8), u1 = ldg16(src + i * 8 + 8), u2 = ldg16(src + i * 8 + 16), u3 = ldg16(src + i * 8 + 24);
      float f[8];
      unpack8(u0, f);
#pragma unroll
      for (int e = 0; e < 8; ++e) s += f[e] * f[e];
      unpack8(u1, f);
#pragma unroll
      for (int e = 0; e < 8; ++e) s += f[e] * f[e];
      unpack8(u2, f);
#pragma unroll
      for (int e = 0; e < 8; ++e) s += f[e] * f[e];
      unpack8(u3, f);
#pragma unroll
      for (int e = 0; e < 8; ++e) s += f[e] * f[e];
    }
    rs[tid] = rsqrtf(s / (float)KK + 1e-6f);
  }
  const u16* Bt = which == 0 ? (const u16*)(p.ws + O_WUQ + layer * SZ_WUQ) + (size_t)nt * 128 * 256
                             : (const u16*)(p.ws + O_WUKV + layer * SZ_WUKV) + (size_t)nt * 128 * 128;
  const float* Cs = (const float*)lds;
  const float2* tab = (const float2*)(p.ws + O_TAB);
  gemm_tile(Z + (size_t)m0 * ZW + cbase, ZW, Bt, KK, KK, lds, [&](int half) {
    if (which == 0) {
      u16* QD = (u16*)(p.ws + O_QD);
      const float qs = 0.10206207261596575f * LOG2E;
      for (int idx = tid; idx < 128 * 32; idx += 256) {
        const int rr = idx >> 5, c4 = (idx & 31) * 4;
        const int row = m0 + half * 128 + rr;
        const float sc = rs[half * 128 + rr] * qs;
        float o[4];
#pragma unroll
        for (int j = 0; j < 4; ++j) {
          int cl = c4 + j, c = nt * 128 + cl, d = c % 96;
          float v = Cs[rr * CSL + cl];
          if (d >= 64 && row < NLAT) {
            int i = d - 64;
            if (i < 16) {
              float2 t = tab[(row & 4095) * 64 + 48 + i];
              float x2 = Cs[rr * CSL + cl + 16];
              v = v * t.x - x2 * t.y;
            } else {
              float2 t = tab[(row & 4095) * 64 + 48 + i - 16];
              float x1 = Cs[rr * CSL + cl - 16];
              v = x1 * t.y + v * t.x;
            }
          }
          o[j] = v * sc;
        }
        uint2 w;
        w.x = pack2(o[0], o[1]); w.y = pack2(o[2], o[3]);
        *(uint2*)(QD + (size_t)row * 384 + nt * 128 + c4) = w;
      }
    } else {
      u16* KVD = (u16*)(p.ws + O_KVD);
      for (int idx = tid; idx < 128 * 32; idx += 256) {
        const int rr = idx >> 5, c4 = (idx & 31) * 4;
        const int row = m0 + half * 128 + rr;
        const float sc = rs[half * 128 + rr];
        float4 v = *(const float4*)(Cs + rr * CSL + c4);
        uint2 w;
        w.x = pack2(v.x * sc, v.y * sc); w.y = pack2(v.z * sc, v.w * sc);
        *(uint2*)(KVD + (size_t)row * KVP + nt * 128 + c4) = w;
      }
    }
  });
  if (which == 1 && nt == 0) {
    u16* KR = (u16*)(p.ws + O_KR);
    for (int e = tid; e < 256 * 16; e += 256) {
      int rr = e >> 4, i = e & 15, row = m0 + rr;
      float cs = 1.f, sn = 0.f;
      if (row < NLAT) { float2 t = tab[(row & 4095) * 64 + 48 + i]; cs = t.x; sn = t.y; }
      float x1 = bf2f(Z[(size_t)row * ZW + C_DKR + i]), x2 = bf2f(Z[(size_t)row * ZW + C_DKR + 16 + i]);
      KR[(size_t)row * 32 + i] = f2bf(x1 * cs - x2 * sn);
      KR[(size_t)row * 32 + 16 + i] = f2bf(x1 * sn + x2 * cs);
    }
  }
}

DI void prep_phase(const Params& p, int layer, char* lds) {
  const int total = 3264 + 816 + 1088;
  for (int t = VB; t < total; t += VG) {
    if (t < 1088) prep_swa(p, t);
    else if (t < 2176) prep_ret(p, t - 1088);
    else if (t < 3264) prep_dn(p, layer, t - 2176, lds);
    else if (t < 3264 + 816) { int q = t - 3264; prep_mla(p, layer, q / 3, 0, q % 3, lds); }
    else { int q = t - 3264 - 816; prep_mla(p, layer, q / 4, 1, q % 4, lds); }
  }
}

struct Seg {
  const u16* k; const u16* k2; const u16* v;
  int ldk, ldk2, ldv, n, pos0, masked;
};

template <int DQK>
DI void attn_tile(const u16* __restrict__ q, int ldq, int qpos0, const Seg& s0, const Seg& s1, int nseg, bool has_sink,
                  float sinkl2, u16* __restrict__ out, int ldo, char* lds) {
  constexpr int KST = DQK + 8;
  constexpr int CPK = DQK / 8;
  constexpr int NKS = DQK / 16;
  constexpr int VST = 96;
  u16* Ks = (u16*)lds;
  u16* Vs = Ks + 64 * KST;
  int ltid_ = threadIdx.x;
  asm volatile("" : "+v"(ltid_));
  const int ltid = ltid_;
  const int tid = ltid & 255, wave = tid >> 6, lane = tid & 63, r = lane & 31, h = lane >> 5;
  const int qi = wave * 32 + r;
  bf16x8 qf[NKS];
#pragma unroll
  for (int ks = 0; ks < NKS; ++ks) qf[ks] = *(const bf16x8*)(q + (size_t)qi * ldq + ks * 16 + 8 * h);
  const int nt0 = s0.n >> 6;
  const int NT = nt0 + (nseg > 1 ? (s1.n >> 6) : 0);
  uint4 kreg0, kreg1 = make_uint4(0, 0, 0, 0), vreg0;
  uint4 krgB0, krgB1 = make_uint4(0, 0, 0, 0), vrgB0;
  const int kkey0 = ltid / CPK, kpart0 = ltid % CPK;
  const int kkey1 = (ltid + 512) / CPK, kpart1 = (ltid + 512) % CPK;
  const bool k1 = (CPK == 12) && (ltid < 256);
  const int vkey = ltid >> 3, vpart = ltid & 7;
  typedef __attribute__((address_space(3))) const char* lds_cptr;
  typedef short v4i16_t __attribute__((ext_vector_type(4)));
  const lds_cptr vp0 = (lds_cptr)Vs + (4 * h + ((lane & 15) >> 2)) * (VST * 2) + ((lane >> 4) & 1) * 32 + (lane & 3) * 8;
#define ATT_VTR(p) __builtin_bit_cast(s16x4, __builtin_amdgcn_ds_read_tr16_b64_v4i16((__attribute__((address_space(3))) v4i16_t*)(p)))
#define ATT_KSRC(sg, off, key, part) \
  (((part) < 8) ? (sg).k + (size_t)((off) + (key)) * (sg).ldk + (part) * 8 : (sg).k2 + (size_t)((off) + (key)) * (sg).ldk2 + ((part) - 8) * 8)
#define ATT_LOADX(i, K0, K1, V0)                                                            \
  {                                                                                         \
    const Seg& sgl = ((i) < nt0) ? s0 : s1;                                                 \
    const int offl = (((i) < nt0) ? (i) : (i) - nt0) << 6;                                  \
    K0 = *(const uint4*)ATT_KSRC(sgl, offl, kkey0, kpart0);                                 \
    if (k1) K1 = *(const uint4*)ATT_KSRC(sgl, offl, kkey1, kpart1);                         \
    V0 = *(const uint4*)(sgl.v + (size_t)(offl + vkey) * sgl.ldv + vpart * 8);              \
  }
  f32x16 o0 = zero16(), o1 = zero16();
  float m = -1e30f, l = 0.f;
#define ATT_STOREX(K0, K1, V0)                                               \
  {                                                                           \
    *(uint4*)(Ks + kkey0 * KST + kpart0 * 8) = K0;                            \
    if (k1) *(uint4*)(Ks + kkey1 * KST + kpart1 * 8) = K1;                    \
    *(uint4*)(Vs + vkey * VST + vpart * 8) = V0;                              \
  }
  auto compute = [&](int i) {
    const Seg& sg = (i < nt0) ? s0 : s1;
    const int off = ((i < nt0) ? i : i - nt0) << 6;
    f32x16 sa = zero16(), sb = zero16();
#pragma unroll
    for (int ks = 0; ks < NKS; ++ks) {
      bf16x8 a0 = *(const bf16x8*)(Ks + r * KST + ks * 16 + 8 * h);
      bf16x8 a1 = *(const bf16x8*)(Ks + (32 + r) * KST + ks * 16 + 8 * h);
      sa = MFMA(a0, qf[ks], sa);
      sb = MFMA(a1, qf[ks], sb);
    }
    if (sg.masked) {
      const int qpos = qpos0 + qi;
      const int kb = sg.pos0 + off;
#pragma unroll
      for (int g = 0; g < 16; ++g) {
        int d0 = kb + crow(g, h) - qpos, d1 = d0 + 32;
        if (d0 > 128 || d0 < -128) sa[g] = -INFINITY;
        if (d1 > 128 || d1 < -128) sb[g] = -INFINITY;
      }
    }
    float mx = sa[0];
#pragma unroll
    for (int g = 1; g < 16; ++g) mx = fmaxf(mx, sa[g]);
#pragma unroll
    for (int g = 0; g < 16; ++g) mx = fmaxf(mx, sb[g]);
    mx = fmaxf(mx, __shfl_xor(mx, 32));
    const float mn = fmaxf(m, mx);
    const float alpha = __builtin_amdgcn_exp2f(m - mn);
    m = mn;
    float ps = 0.f;
#pragma unroll
    for (int g = 0; g < 16; ++g) { sa[g] = __builtin_amdgcn_exp2f(sa[g] - mn); ps += sa[g]; }
#pragma unroll
    for (int g = 0; g < 16; ++g) { sb[g] = __builtin_amdgcn_exp2f(sb[g] - mn); ps += sb[g]; }
    l = l * alpha + ps;
#pragma unroll
    for (int g = 0; g < 16; ++g) { o0[g] *= alpha; o1[g] *= alpha; }
#pragma unroll
    for (int kt = 0; kt < 2; ++kt) {
#pragma unroll
      for (int s = 0; s < 2; ++s) {
        const f32x16& sv = kt == 0 ? sa : sb;
        uint4 pu;
        pu.x = pack2(sv[8 * s + 0], sv[8 * s + 1]); pu.y = pack2(sv[8 * s + 2], sv[8 * s + 3]);
        pu.z = pack2(sv[8 * s + 4], sv[8 * s + 5]); pu.w = pack2(sv[8 * s + 6], sv[8 * s + 7]);
        bf16x8 pf = __builtin_bit_cast(bf16x8, pu);
        const lds_cptr vp = vp0 + (kt * 32 + 16 * s) * (VST * 2);
        {
          s16x4 lo = ATT_VTR(vp);
          s16x4 hi = ATT_VTR(vp + 8 * VST * 2);
          bf16x8 vf = __builtin_shufflevector(lo, hi, 0, 1, 2, 3, 4, 5, 6, 7);
          o0 = MFMA(vf, pf, o0);
        }
        {
          s16x4 lo = ATT_VTR(vp + 64);
          s16x4 hi = ATT_VTR(vp + 8 * VST * 2 + 64);
          bf16x8 vf = __builtin_shufflevector(lo, hi, 0, 1, 2, 3, 4, 5, 6, 7);
          o1 = MFMA(vf, pf, o1);
        }
      }
    }
  };
  ATT_LOADX(0, kreg0, kreg1, vreg0);
  ATT_LOADX(1, krgB0, krgB1, vrgB0);
  for (int i = 0; i < NT; i += 2) {
    __syncthreads();
    ATT_STOREX(kreg0, kreg1, vreg0);
    __syncthreads();
    if (i + 2 < NT) ATT_LOADX(i + 2, kreg0, kreg1, vreg0);
    compute(i);
    __syncthreads();
    ATT_STOREX(krgB0, krgB1, vrgB0);
    __syncthreads();
    if (i + 3 < NT) ATT_LOADX(i + 3, krgB0, krgB1, vrgB0);
    compute(i + 1);
  }
  float lt = l + __shfl_xor(l, 32);
  if (has_sink) lt += __builtin_amdgcn_exp2f(sinkl2 - m);
  const float inv = 1.f / lt;
#pragma unroll
  for (int g = 0; g < 4; ++g) {
    uint2 w;
    w.x = pack2(o0[4 * g] * inv, o0[4 * g + 1] * inv); w.y = pack2(o0[4 * g + 2] * inv, o0[4 * g + 3] * inv);
    *(uint2*)(out + (size_t)qi * ldo + 8 * g + 4 * h) = w;
    w.x = pack2(o1[4 * g] * inv, o1[4 * g + 1] * inv); w.y = pack2(o1[4 * g + 2] * inv, o1[4 * g + 3] * inv);
    *(uint2*)(out + (size_t)qi * ldo + 32 + 8 * g + 4 * h) = w;
  }
}

DI void mla_attn(const Params& p, int idx, char* lds) {
  const u16* QD = (const u16*)(p.ws + O_QD);
  const u16* KVD = (const u16*)(p.ws + O_KVD);
  const u16* KR = (const u16*)(p.ws + O_KR);
  u16* act = (u16*)(p.ws + O_ACT);
  Seg lat, cx;
  int b, hh, row0;
  bool is_ctx = idx >= 2048;
  if (!is_ctx) { b = idx >> 7; hh = (idx >> 5) & 3; row0 = b * TT + (idx & 31) * 128; }
  else { int q = idx - 2048; b = q >> 3; hh = (q >> 1) & 3; row0 = NLAT + b * LC + (q & 1) * 128; }
  const size_t lr = (size_t)b * TT, cr = (size_t)NLAT + b * LC;
  lat.k = KVD + lr * KVP + hh * 128; lat.ldk = KVP; lat.k2 = KR + lr * 32; lat.ldk2 = 32; lat.v = KVD + lr * KVP + hh * 128 + 64;
  lat.ldv = KVP; lat.n = TT; lat.pos0 = 0; lat.masked = 0;
  cx.k = KVD + cr * KVP + hh * 128; cx.ldk = KVP; cx.k2 = KR + cr * 32; cx.ldk2 = 32; cx.v = KVD + cr * KVP + hh * 128 + 64;
  cx.ldv = KVP; cx.n = LC; cx.pos0 = 0; cx.masked = 0;
  const u16* q = QD + (size_t)row0 * 384 + hh * 96;
  u16* o = act + (size_t)row0 * AP + 768 + hh * 64;
  if (!is_ctx) attn_tile<96>(q, 384, 0, lat, cx, 2, false, 0.f, o, AP, lds);
  else attn_tile<96>(q, 384, 0, cx, cx, 1, false, 0.f, o, AP, lds);
}

DI void swa_attn(const Params& p, int layer, int idx, char* lds) {
  const u16* QA = (const u16*)(p.ws + O_QA);
  const u16* KA = (const u16*)(p.ws + O_KA);
  const u16* Z = (const u16*)(p.ws + O_Z);
  u16* act = (u16*)(p.ws + O_ACT);
  Seg loc, cx;
  int b, hh, row0, pos0q;
  bool is_ctx = idx >= 2048;
  int nb = 0;
  if (!is_ctx) { b = idx >> 7; hh = ((idx >> 6) & 1) * 2 + (idx & 1); nb = (idx >> 1) & 31; pos0q = nb * 128; row0 = b * TT + pos0q; }
  else { int q = idx - 2048; b = q >> 3; hh = (q >> 1) & 3; pos0q = TT + (q & 1) * 128; row0 = NLAT + b * LC + (q & 1) * 128; }
  const int hk = hh >> 1;
  const u16* kbase = KA + (size_t)(b * 2 + hk) * NPOS * 64;
  cx.k = kbase + (size_t)TT * 64; cx.ldk = 64; cx.k2 = cx.k; cx.ldk2 = 64;
  cx.v = Z + ((size_t)NLAT + b * LC) * ZW + C_AV + hk * 64; cx.ldv = ZW; cx.n = LC; cx.pos0 = 0; cx.masked = 0;
  const float sinkl2 = p.swa_sink[layer * 4 + hh] * LOG2E;
  const u16* q = QA + ((size_t)(b * 4 + hh) * NPOS + pos0q) * 64;
  u16* o = act + (size_t)row0 * AP + hh * 64;
  if (!is_ctx) {
    int ks = nb * 128 - 128; if (ks < 0) ks = 0;
    int ke = nb * 128 + 256; if (ke > TT) ke = TT;
    loc.k = kbase + (size_t)ks * 64; loc.ldk = 64; loc.k2 = loc.k; loc.ldk2 = 64;
    loc.v = Z + ((size_t)b * TT + ks) * ZW + C_AV + hk * 64; loc.ldv = ZW; loc.n = ke - ks; loc.pos0 = ks; loc.masked = 1;
    attn_tile<64>(q, 64, pos0q, loc, cx, 2, true, sinkl2, o, AP, lds);
  } else {
    attn_tile<64>(q, 64, 0, cx, cx, 1, true, sinkl2, o, AP, lds);
  }
}

constexpr int LS = 72;
template <int KS>
DI f32x16 mm64(const u16* A, int lda, const u16* Bt, int ldb, int wm, int wn, int r, int h) {
  f32x16 acc = zero16();
#pragma unroll
  for (int s = 0; s < KS; ++s) {
    bf16x8 a = *(const bf16x8*)(A + (wm * 32 + r) * lda + s * 16 + 8 * h);
    bf16x8 b = *(const bf16x8*)(Bt + (wn * 32 + r) * ldb + s * 16 + 8 * h);
    acc = MFMA(a, b, acc);
  }
  return acc;
}
DI void st_straight(u16* D, int ld, const f32x16& v, int wm, int wn, int r, int h) {
#pragma unroll
  for (int g = 0; g < 16; ++g) D[(wm * 32 + crow(g, h)) * ld + wn * 32 + r] = f2bf(v[g]);
}
DI void st_transp(u16* D, int ld, const f32x16& v, int wm, int wn, int r, int h) {
#pragma unroll
  for (int g = 0; g < 4; ++g) {
    uint2 w;
    w.x = pack2(v[4 * g], v[4 * g + 1]); w.y = pack2(v[4 * g + 2], v[4 * g + 3]);
    *(uint2*)(D + (wn * 32 + r) * ld + wm * 32 + 8 * g + 4 * h) = w;
  }
}

template <int KS>
DI f32x16 mm64t(const u16* AT, int lda, const u16* Bt, int ldb, int wm, int wn, int r, int h, int lane) {
  typedef __attribute__((address_space(3))) const char* lds_cptr;
  typedef short v4i16_t __attribute__((ext_vector_type(4)));
  const lds_cptr base = (lds_cptr)AT + ((lane & 15) >> 2) * (lda * 2) + (wm * 32 + ((lane >> 4) & 1) * 16) * 2 + (lane & 3) * 8;
  f32x16 acc = zero16();
#pragma unroll
  for (int s = 0; s < KS; ++s) {
    s16x4 lo = __builtin_bit_cast(s16x4, __builtin_amdgcn_ds_read_tr16_b64_v4i16((__attribute__((address_space(3))) v4i16_t*)(base + (16 * s + 8 * h) * (lda * 2))));
    s16x4 hi = __builtin_bit_cast(s16x4, __builtin_amdgcn_ds_read_tr16_b64_v4i16((__attribute__((address_space(3))) v4i16_t*)(base + (16 * s + 8 * h + 4) * (lda * 2))));
    bf16x8 a = __builtin_shufflevector(lo, hi, 0, 1, 2, 3, 4, 5, 6, 7);
    bf16x8 b = *(const bf16x8*)(Bt + (wn * 32 + r) * ldb + s * 16 + 8 * h);
    acc = MFMA(a, b, acc);
  }
  return acc;
}

template <int KS, bool ATR, bool BTR>
DI f32x16 mm64x(const u16* A, int lda, const u16* B, int ldb, int wm, int wn, int r, int h, int lane) {
  typedef __attribute__((address_space(3))) const char* lds_cptr;
  typedef short v4i16_t __attribute__((ext_vector_type(4)));
  const int sub = ((lane & 15) >> 2), cb = ((lane >> 4) & 1) * 16, pb = (lane & 3) * 8;
  const lds_cptr abase = (lds_cptr)A + sub * (lda * 2) + (wm * 32 + cb) * 2 + pb;
  const lds_cptr bbase = (lds_cptr)B + sub * (ldb * 2) + (wn * 32 + cb) * 2 + pb;
  f32x16 acc = zero16();
#pragma unroll
  for (int s = 0; s < KS; ++s) {
    bf16x8 a, b;
    if (ATR) {
      s16x4 lo = __builtin_bit_cast(s16x4, __builtin_amdgcn_ds_read_tr16_b64_v4i16((__attribute__((address_space(3))) v4i16_t*)(abase + (16 * s + 8 * h) * (lda * 2))));
      s16x4 hi = __builtin_bit_cast(s16x4, __builtin_amdgcn_ds_read_tr16_b64_v4i16((__attribute__((address_space(3))) v4i16_t*)(abase + (16 * s + 8 * h + 4) * (lda * 2))));
      a = __builtin_shufflevector(lo, hi, 0, 1, 2, 3, 4, 5, 6, 7);
    } else {
      a = *(const bf16x8*)(A + (wm * 32 + r) * lda + s * 16 + 8 * h);
    }
    if (BTR) {
      s16x4 lo = __builtin_bit_cast(s16x4, __builtin_amdgcn_ds_read_tr16_b64_v4i16((__attribute__((address_space(3))) v4i16_t*)(bbase + (16 * s + 8 * h) * (ldb * 2))));
      s16x4 hi = __builtin_bit_cast(s16x4, __builtin_amdgcn_ds_read_tr16_b64_v4i16((__attribute__((address_space(3))) v4i16_t*)(bbase + (16 * s + 8 * h + 4) * (ldb * 2))));
      b = __builtin_shufflevector(lo, hi, 0, 1, 2, 3, 4, 5, 6, 7);
    } else {
      b = *(const bf16x8*)(B + (wn * 32 + r) * ldb + s * 16 + 8 * h);
    }
    acc = MFMA(a, b, acc);
  }
  return acc;
}
DI void st8s(u16* dst, const uint4& v, float f) {
  uint4 o;
  o.x = pack2(bflo(v.x) * f, bfhi(v.x) * f); o.y = pack2(bflo(v.y) * f, bfhi(v.y) * f);
  o.z = pack2(bflo(v.z) * f, bfhi(v.z) * f); o.w = pack2(bflo(v.w) * f, bfhi(v.w) * f);
  *(uint4*)dst = o;
}

DI void dn_chain(const Params& p, int chain, char* lds) {
  int tid_ = VTID;
  asm volatile("" : "+v"(tid_));
  const int tid = tid_, wave = tid >> 6, lane = tid & 63, r = lane & 31, h = lane >> 5;
  const int wm = wave >> 1, wn = wave & 1;
  const int b = chain >> 3, hh = (chain >> 1) & 3, dir = chain & 1;
  u16* kA = (u16*)lds;
  u16* St = kA + 64 * LS;
  u16* R1 = St + 64 * LS;
  u16* R2 = R1 + 64 * LS;
  u16* R3 = R2 + 64 * LS;
  u16* R4 = R3 + 64 * LS;
  u16* R5 = R4 + 64 * LS;
  float* gc = (float*)(R5 + 64 * LS);
  float* bt = gc + 64;
  const u16* QKVB = (const u16*)(p.ws + O_QKVB);
  const float* G2 = (const float*)(p.ws + O_G2);
  u16* OUT = dir ? (u16*)(p.ws + O_OB) : (u16*)(p.ws + O_ACT) + 256;
  const int opitch = dir ? 256 : AP;
  __syncthreads();
  for (int e = tid; e < 64 * LS / 2; e += 256) ((u32*)St)[e] = 0u;
  f32x16 S = zero16();
  const int lc = tid >> 3, lp = (tid & 7) * 8;
  auto rowof = [&](int n, int c) -> int {
    int cn, base, len;
    if (n < 4) { cn = n; base = NLAT + b * LC; len = LC; } else { cn = n - 4; base = b * TT; len = TT; }
    int pos = cn * 64 + c;
    return base + (dir ? len - 1 - pos : pos);
  };
  uint4 pk0, pk1, pq0, pq1, pv0, pv1;
  float pg = 0.f, pb = 0.f;
#define DN_LOAD(n)                                                                      \
  {                                                                                     \
    const u16* s0_ = QKVB + (size_t)rowof((n), lc) * 768 + hh * 64 + lp;                \
    const u16* s1_ = QKVB + (size_t)rowof((n), lc + 32) * 768 + hh * 64 + lp;           \
    pq0 = *(const uint4*)s0_; pk0 = *(const uint4*)(s0_ + 256); pv0 = *(const uint4*)(s0_ + 512); \
    pq1 = *(const uint4*)s1_; pk1 = *(const uint4*)(s1_ + 256); pv1 = *(const uint4*)(s1_ + 512); \
    if (tid < 64) {                                                                     \
      const float* g_ = G2 + (size_t)rowof((n), tid) * 16 + dir * 4 + hh;               \
      pg = g_[0]; pb = g_[8];                                                           \
    }                                                                                   \
  }
  DN_LOAD(0);
  for (int n = 0; n < 68; ++n) {
    const uint4 ck0 = pk0, ck1 = pk1, cq0 = pq0, cq1 = pq1, cv0 = pv0, cv1 = pv1;
    float cgv = pg, cbv = pb;
    __syncthreads();
    if (tid < 64) {
      float v = cgv;
#pragma unroll
      for (int o = 1; o < 64; o <<= 1) { float t = __shfl_up(v, o); if (lane >= o) v += t; }
      gc[tid] = v; bt[tid] = cbv;
    }
    *(uint4*)(kA + lc * LS + lp) = ck0;
    *(uint4*)(kA + (lc + 32) * LS + lp) = ck1;
    if (n + 1 < 68) DN_LOAD(n + 1);
    __syncthreads();
    const float gl = gc[63];
    f32x16 T;
    {
      f32x16 kk = mm64<4>(kA, LS, kA, LS, wm, wn, r, h);
      const int s = wn * 32 + r;
      const float gs = gc[s];
#pragma unroll
      for (int g = 0; g < 16; ++g) {
        int c = wm * 32 + crow(g, h);
        float v = (s < c) ? bt[c] * kk[g] * __expf(gc[c] - gs) : 0.f;
        kk[g] = v;
        T[g] = (c == s) ? 1.f : (((c >> 1) == (s >> 1)) ? -v : 0.f);
      }
      st_transp(R1, LS, kk, wm, wn, r, h);
      st_transp(R2, LS, T, wm, wn, r, h);
    }
    __syncthreads();
    for (int k = 1; k < 6; ++k) {
      f32x16 M = mm64t<4>(R1, LS, R2, LS, wm, wn, r, h, lane);
      st_transp(R4, LS, M, wm, wn, r, h);
      __syncthreads();
      f32x16 X = mm64t<4>(R2, LS, R4, LS, wm, wn, r, h, lane);
      {
        const int s = wn * 32 + r;
#pragma unroll
        for (int g = 0; g < 16; ++g) {
          int c = wm * 32 + crow(g, h);
          if ((c >> (k + 1)) == (s >> (k + 1)) && (c >> k) != (s >> k)) T[g] -= X[g];
        }
      }
      __syncthreads();
      st_transp(R2, LS, T, wm, wn, r, h);
      __syncthreads();
    }
    {
      const float fb0 = bt[lc], fk0 = fb0 * __expf(gc[lc]);
      const float fb1 = bt[lc + 32], fk1 = fb1 * __expf(gc[lc + 32]);
      st8s(R1 + lc * LS + lp, ck0, fk0);
      st8s(R1 + (lc + 32) * LS + lp, ck1, fk1);
      st8s(R3 + lc * LS + lp, cv0, fb0);
      st8s(R3 + (lc + 32) * LS + lp, cv1, fb1);
    }
    __syncthreads();
    f32x16 W = mm64x<4, true, true>(R2, LS, R1, LS, wm, wn, r, h, lane);
    f32x16 U = mm64x<4, true, true>(R2, LS, R3, LS, wm, wn, r, h, lane);
    st_transp(R4, LS, W, wm, wn, r, h);
    __syncthreads();
    {
      f32x16 ws = mm64t<4>(R4, LS, St, LS, wm, wn, r, h, lane);
#pragma unroll
      for (int g = 0; g < 16; ++g) U[g] -= ws[g];
      st_transp(R1, LS, U, wm, wn, r, h);
    }
    *(uint4*)(R2 + lc * LS + lp) = cq0;
    *(uint4*)(R2 + (lc + 32) * LS + lp) = cq1;
    st8s(R5 + lc * LS + lp, ck0, __expf(gl - gc[lc]));
    st8s(R5 + (lc + 32) * LS + lp, ck1, __expf(gl - gc[lc + 32]));
    __syncthreads();
    {
      f32x16 qk = mm64<4>(R2, LS, kA, LS, wm, wn, r, h);
      const int s = wn * 32 + r;
      const float gs = gc[s];
#pragma unroll
      for (int g = 0; g < 16; ++g) {
        int c = wm * 32 + crow(g, h);
        qk[g] = (s <= c) ? qk[g] * __expf(gc[c] - gs) : 0.f;
      }
      st_transp(R3, LS, qk, wm, wn, r, h);
    }
    __syncthreads();
    {
      f32x16 o1 = mm64<4>(R2, LS, St, LS, wm, wn, r, h);
      f32x16 o2 = mm64t<4>(R3, LS, R1, LS, wm, wn, r, h, lane);
      f32x16 sn = mm64x<4, true, false>(R5, LS, R1, LS, wm, wn, r, h, lane);
      const float egl = __expf(gl);
#pragma unroll
      for (int g = 0; g < 16; ++g) {
        int c = wm * 32 + crow(g, h);
        float ov = o1[g] * __expf(gc[c]) + o2[g];
        OUT[(size_t)rowof(n, c) * opitch + hh * 64 + wn * 32 + r] = f2bf(ov);
        S[g] = S[g] * egl + sn[g];
      }
    }
    __syncthreads();
    st_transp(St, LS, S, wm, wn, r, h);
  }
}

DI void ret_chain(const Params& p, int layer, int chain, char* lds) {
  int tid_ = VTID;
  asm volatile("" : "+v"(tid_));
  const int tid = tid_, wave = tid >> 6, lane = tid & 63, r = lane & 31, h = lane >> 5;
  const int wm = wave >> 1, wn = wave & 1;
  const int b = chain >> 3, hh = (chain >> 1) & 3, dir = chain & 1;
  constexpr int L4 = 40;
  u16* qA = (u16*)lds;
  u16* kA = qA + 64 * L4;
  u16* ks = kA + 64 * L4;
  u16* vs = ks + 64 * LS;
  u16* QK = vs + 64 * LS;
  u16* Rt = QK + 64 * LS;
  const u16* QC = (const u16*)(p.ws + O_QC);
  const u16* KC = (const u16*)(p.ws + O_KC);
  const u16* Z = (const u16*)(p.ws + O_Z);
  u16* OUT = dir ? (u16*)(p.ws + O_ORB) : (u16*)(p.ws + O_ACT) + 512;
  const int opitch = dir ? 256 : AP;
  const int lc = tid >> 2, lp4 = (tid & 3) * 8;
  const int vc = tid >> 3, vp = (tid & 7) * 8;
  const float lg = log1pf(-expf(p.ret_l1m[layer * 8 + dir * 4 + hh]));
  f32x16 R = zero16();
  auto rowof = [&](int n, int c) -> int {
    int cn, base, len;
    if (n < 4) { cn = n; base = NLAT + b * LC; len = LC; } else { cn = n - 4; base = b * TT; len = TT; }
    int pos = cn * 64 + c;
    return base + (dir ? len - 1 - pos : pos);
  };
  uint4 pq, pk, pv0, pv1;
#define RET_LOAD(n)                                                                                   \
  {                                                                                                   \
    const int row_ = rowof((n), lc);                                                                  \
    pq = *(const uint4*)(QC + (size_t)row_ * 128 + hh * 32 + lp4);                                    \
    pk = *(const uint4*)(KC + (size_t)row_ * 128 + hh * 32 + lp4);                                    \
    pv0 = *(const uint4*)(Z + (size_t)rowof((n), vc) * ZW + C_CV + hh * 64 + vp);                     \
    pv1 = *(const uint4*)(Z + (size_t)rowof((n), vc + 32) * ZW + C_CV + hh * 64 + vp);                \
  }
  RET_LOAD(0);
  for (int n = 0; n < 68; ++n) {
    __syncthreads();
    *(uint4*)(qA + lc * L4 + lp4) = pq;
    *(uint4*)(kA + lc * L4 + lp4) = pk;
    st8s(ks + lc * L4 + lp4, pk, __expf((float)(63 - lc) * lg));
    *(uint4*)(vs + vc * LS + vp) = pv0;
    *(uint4*)(vs + (vc + 32) * LS + vp) = pv1;
    if (wm == 0) st_transp(Rt, L4, R, wm, wn, r, h);
    if (n + 1 < 68) RET_LOAD(n + 1);
    __syncthreads();
    {
      f32x16 qk = mm64<2>(qA, L4, kA, L4, wm, wn, r, h);
      const int s = wn * 32 + r;
#pragma unroll
      for (int g = 0; g < 16; ++g) {
        int c = wm * 32 + crow(g, h);
        qk[g] = (s <= c) ? qk[g] * __expf((float)(c - s) * lg) : 0.f;
      }
      st_transp(QK, LS, qk, wm, wn, r, h);
    }
    __syncthreads();
    {
      f32x16 o1 = mm64x<4, true, true>(QK, LS, vs, LS, wm, wn, r, h, lane);
      f32x16 o2 = mm64<2>(qA, L4, Rt, L4, wm, wn, r, h);
      const float gch = __expf(64.f * lg);
#pragma unroll
      for (int g = 0; g < 16; ++g) {
        int c = wm * 32 + crow(g, h);
        float ov = o1[g] + __expf((float)(c + 1) * lg) * o2[g];
        OUT[(size_t)rowof(n, c) * opitch + hh * 64 + wn * 32 + r] = f2bf(ov);
      }
      if (wm == 0) {
        f32x16 rn = mm64x<4, true, true>(ks, L4, vs, LS, wm, wn, r, h, lane);
#pragma unroll
        for (int g = 0; g < 16; ++g) R[g] = R[g] * gch + rn[g];
      }
    }
  }
}

DI void pair_finalize(const Params& p, int layer, int kind, int b, int hh) {
  int ltid_ = threadIdx.x;
  asm volatile("" : "+v"(ltid_));
  const int ltid = ltid_;
  const u16* Z = (const u16*)(p.ws + O_Z);
  const u16* BW = (const u16*)(p.ws + (kind ? O_ORB : O_OB));
  u16* act = (u16*)(p.ws + O_ACT);
  const int acol = kind ? 512 : 256, zcol = kind ? C_CG : C_BZ;
  const float* gp = kind ? p.ret_norm_g + layer * 256 + hh * 64 + (ltid & 7) * 8 : p.dn_norm_g + layer * 64 + (ltid & 7) * 8;
  const float4 g0 = *(const float4*)gp, g1 = *(const float4*)(gp + 4);
  const float gg[8] = {g0.x, g0.y, g0.z, g0.w, g1.x, g1.y, g1.z, g1.w};
  const int c8 = hh * 8 + (ltid & 7);
  __syncthreads();
#pragma unroll 1
  for (int j0 = 0; j0 < 68; j0 += 4) {
    u32x4 a[4], bw[4], z[4];
#pragma unroll
    for (int u = 0; u < 4; ++u) {
      const int rr = (ltid + 512 * (j0 + u)) >> 3;
      const int row = rr < TT ? b * TT + rr : NLAT + b * LC + (rr - TT);
      a[u] = ldg16(act + (size_t)row * AP + acol + c8 * 8);
      bw[u] = ldg16(BW + (size_t)row * 256 + c8 * 8);
      z[u] = ldg16(Z + (size_t)row * ZW + zcol + c8 * 8);
    }
#pragma unroll
    for (int u = 0; u < 4; ++u) {
      const int rr = (ltid + 512 * (j0 + u)) >> 3;
      const int row = rr < TT ? b * TT + rr : NLAT + b * LC + (rr - TT);
      float fa[8], fb[8], fz[8], o[8];
      unpack8(a[u], fa); unpack8(bw[u], fb); unpack8(z[u], fz);
      float sm = 0.f;
#pragma unroll
      for (int e = 0; e < 8; ++e) { o[e] = fa[e] + fb[e]; sm += o[e]; }
      sm += __shfl_xor(sm, 1); sm += __shfl_xor(sm, 2); sm += __shfl_xor(sm, 4);
      const float mean = kind ? sm * (1.f / 64.f) : 0.f;
      float ss = 0.f;
#pragma unroll
      for (int e = 0; e < 8; ++e) { o[e] -= mean; ss += o[e] * o[e]; }
      ss += __shfl_xor(ss, 1); ss += __shfl_xor(ss, 2); ss += __shfl_xor(ss, 4);
      const float rn = rsqrtf(ss * (1.f / 64.f) + 1e-6f);
#pragma unroll
      for (int e = 0; e < 8; ++e) o[e] = o[e] * rn * gg[e] * siluf(fz[e]);
      *(u32x4*)(act + (size_t)row * AP + acol + c8 * 8) = pack8(o);
    }
  }
}

DI void mixer_phase(const Params& p, int layer, char* lds, char* lds_all, int* s_tile) {
  int* cnt = (int*)(p.ws + O_CNT) + layer;
  const int nattn = layer == 0 ? 2176 : 2048;
  const int nwork = 128 + 128 + 2 * nattn;
  const int total = nwork + (layer == 0 ? 5352 : 0);
  for (;;) {
    __syncthreads();
    if (threadIdx.x == 0) *s_tile = atomicAdd(cnt, 1);
    __syncthreads();
    const int t = 2 * (*s_tile) + VHALF;
    if (t >= total) break;
    if (t < 128) { dn_chain(p, t, lds); pair_finalize(p, layer, 0, t >> 3, (t >> 1) & 3); }
    else if (t < 256) { ret_chain(p, layer, t - 128, lds); pair_finalize(p, layer, 1, (t - 128) >> 3, ((t - 128) >> 1) & 3); }
    else if (t < 256 + nattn) mla_attn(p, t - 256, lds_all);
    else if (t < nwork) swa_attn(p, layer, t - 256 - nattn, lds_all);
    else wtile_deferred(p, t - nwork, lds);
  }
}

DI void dn_finalize(const Params& p, int layer, int nrows) {
  int tid_ = VTID;
  asm volatile("" : "+v"(tid_));
  const int tid = tid_;
  const u16* OB = (const u16*)(p.ws + O_OB);
  const u16* Z = (const u16*)(p.ws + O_Z);
  u16* act = (u16*)(p.ws + O_ACT);
  const int ntask = nrows * 32, stride = VG * 256;
  for (int id0 = VB * 256 + tid; id0 < ntask; id0 += 4 * stride) {
    u32x4 a[4], b[4], z[4];
#pragma unroll
    for (int u = 0; u < 4; ++u) {
      const int id = id0 + u * stride;
      const bool ok = id < ntask;
      const int row = ok ? (id >> 5) : 0, c8 = id & 31;
      a[u] = ldg16(act + (size_t)row * AP + 256 + c8 * 8);
      b[u] = ldg16(OB + (size_t)row * 256 + c8 * 8);
      z[u] = ldg16(Z + (size_t)row * ZW + C_BZ + c8 * 8);
    }
#pragma unroll
    for (int u = 0; u < 4; ++u) {
      const int id = id0 + u * stride;
      const int row = id >> 5, c8 = id & 31;
      float fa[8], fb[8], fz[8], o[8];
      unpack8(a[u], fa); unpack8(b[u], fb); unpack8(z[u], fz);
      float ss = 0.f;
#pragma unroll
      for (int e = 0; e < 8; ++e) { o[e] = fa[e] + fb[e]; ss += o[e] * o[e]; }
      ss += __shfl_xor(ss, 1); ss += __shfl_xor(ss, 2); ss += __shfl_xor(ss, 4);
      const float rn = rsqrtf(ss * (1.f / 64.f) + 1e-6f);
      const float4 g0 = *(const float4*)(p.dn_norm_g + layer * 64 + (c8 & 7) * 8), g1 = *(const float4*)(p.dn_norm_g + layer * 64 + (c8 & 7) * 8 + 4);
      const float gg[8] = {g0.x, g0.y, g0.z, g0.w, g1.x, g1.y, g1.z, g1.w};
#pragma unroll
      for (int e = 0; e < 8; ++e) o[e] = o[e] * rn * gg[e] * siluf(fz[e]);
      if (id < ntask) *(u32x4*)(act + (size_t)row * AP + 256 + c8 * 8) = pack8(o);
    }
  }
  const u16* ORB = (const u16*)(p.ws + O_ORB);
  for (int id0 = VB * 256 + tid; id0 < ntask; id0 += 4 * stride) {
    u32x4 a[4], b[4], z[4];
#pragma unroll
    for (int u = 0; u < 4; ++u) {
      const int id = id0 + u * stride;
      const bool ok = id < ntask;
      const int row = ok ? (id >> 5) : 0, c8 = id & 31;
      a[u] = ldg16(act + (size_t)row * AP + 512 + c8 * 8);
      b[u] = ldg16(ORB + (size_t)row * 256 + c8 * 8);
      z[u] = ldg16(Z + (size_t)row * ZW + C_CG + c8 * 8);
    }
#pragma unroll
    for (int u = 0; u < 4; ++u) {
      const int id = id0 + u * stride;
      const int row = id >> 5, c8 = id & 31;
      float fa[8], fb[8], fz[8], o[8];
      unpack8(a[u], fa); unpack8(b[u], fb); unpack8(z[u], fz);
      float sm = 0.f;
#pragma unroll
      for (int e = 0; e < 8; ++e) { o[e] = fa[e] + fb[e]; sm += o[e]; }
      sm += __shfl_xor(sm, 1); sm += __shfl_xor(sm, 2); sm += __shfl_xor(sm, 4);
      const float mean = sm * (1.f / 64.f);
      float ss = 0.f;
#pragma unroll
      for (int e = 0; e < 8; ++e) { o[e] -= mean; ss += o[e] * o[e]; }
      ss += __shfl_xor(ss, 1); ss += __shfl_xor(ss, 2); ss += __shfl_xor(ss, 4);
      const float rn = rsqrtf(ss * (1.f / 64.f) + 1e-6f);
      const float4 g0 = *(const float4*)(p.ret_norm_g + layer * 256 + c8 * 8), g1 = *(const float4*)(p.ret_norm_g + layer * 256 + c8 * 8 + 4);
      const float gg[8] = {g0.x, g0.y, g0.z, g0.w, g1.x, g1.y, g1.z, g1.w};
#pragma unroll
      for (int e = 0; e < 8; ++e) o[e] = o[e] * rn * gg[e] * siluf(fz[e]);
      if (id < ntask) *(u32x4*)(act + (size_t)row * AP + 512 + c8 * 8) = pack8(o);
    }
  }
}

DI void gbar(const Params& p, unsigned& target) {
  unsigned* bar = (unsigned*)(p.ws + O_CNT + 128);
  target += gridDim.x;
  __syncthreads();
  if (threadIdx.x == 0) {
    __builtin_amdgcn_fence(__ATOMIC_RELEASE, "agent");
    __hip_atomic_fetch_add(bar, 1u, __ATOMIC_RELAXED, __HIP_MEMORY_SCOPE_AGENT);
    while (__hip_atomic_load(bar, __ATOMIC_RELAXED, __HIP_MEMORY_SCOPE_AGENT) < target) __builtin_amdgcn_s_sleep(2);
    __builtin_amdgcn_fence(__ATOMIC_ACQUIRE, "agent");
  }
  __syncthreads();
}

__global__ void __launch_bounds__(512, 2) fwd_megakernel(Params p) {
  __shared__ __attribute__((aligned(16))) char lds_all[2 * LDS_BYTES];
  __shared__ int s_tile;
  char* lds = lds_all + VHALF * LDS_BYTES;
  cg::grid_group grid = cg::this_grid();
  if (p.ws == nullptr) grid.sync();
  unsigned bt = 0;
  phase0a(p, lds);
  gbar(p, bt);
  modulate_rows(p, 0, ROWS);
  gbar(p, bt);
  for (int layer = 0; layer < 2; ++layer) {
    const int nrows = layer == 0 ? ROWS : NLAT;
    gemm_phase(p, layer, 0, ROWS, lds_all);
    gbar(p, bt);
    prep_phase(p, layer, lds);
    gbar(p, bt);
    mixer_phase(p, layer, lds, lds_all, &s_tile);
    gbar(p, bt);
    gemm_phase(p, layer, 1, nrows, lds_all);
    gbar(p, bt);
    ln_rows(p, p.ln1_g + layer * DM, p.ln1_b + layer * DM, nrows, layer, 3, true);
    gbar(p, bt);
    gemm_phase(p, layer, 2, nrows, lds_all);
    gbar(p, bt);
    gemm_phase(p, layer, 3, nrows, lds_all);
    gbar(p, bt);
    ln_rows(p, p.ln2_g + layer * DM, p.ln2_b + layer * DM, nrows, layer == 0 ? 1 : 0, 0, layer == 0);
    if (layer == 0) gbar(p, bt);
  }
}

extern "C" void kernel_launch(void* const* d_in, const int* in_sizes, int n_in, void* d_out, int out_size, void* d_ws,
                              size_t ws_size, hipStream_t stream) {
  static int grid_blocks = 0;
  if (!grid_blocks) {
    int dev = 0, cus = 0, per_cu = 0;
    hipGetDevice(&dev);
    hipDeviceGetAttribute(&cus, hipDeviceAttributeMultiprocessorCount, dev);
    hipOccupancyMaxActiveBlocksPerMultiprocessor(&per_cu, fwd_megakernel, 512, 0);
    if (per_cu < 1) per_cu = 1;
    if (per_cu > 1) per_cu = 1;
    grid_blocks = cus * per_cu;
    if (ws_size < WS_END) fprintf(stderr, "kernel_launch: workspace too small: %zu < %zu\n", ws_size, (size_t)WS_END);
  }
  Params p{};
  const float** f = (const float**)&p;
  for (int i = 0; i < 25; ++i) f[i] = (const float*)d_in[i];
  p.out = (float*)d_out;
  p.ws = (unsigned char*)d_ws;
  hipMemsetAsync((char*)d_ws + O_CNT, 0, 256, stream);
  void* args[] = {&p};
  hipError_t e = hipLaunchCooperativeKernel((void*)fwd_megakernel, dim3(grid_blocks), dim3(512), args, 0, stream);
  if (e != hipSuccess) fprintf(stderr, "cooperative launch failed: %s (grid %d)\n", hipGetErrorString(e), grid_blocks);
}
```

```cpp
#include <hip/hip_runtime.h>
#include <hip/hip_cooperative_groups.h>
#include <cstdio>
namespace cg = cooperative_groups;

#define DI __device__ __forceinline__
typedef unsigned short u16;
typedef unsigned int u32;
using bf16x8 = __attribute__((ext_vector_type(8))) short;
using s16x4 = __attribute__((ext_vector_type(4))) short;
using f32x16 = __attribute__((ext_vector_type(16))) float;
typedef __bf16 bfv2 __attribute__((ext_vector_type(2)));
typedef float flv2 __attribute__((ext_vector_type(2)));
#define MFMA(a, b, c) __builtin_amdgcn_mfma_f32_32x32x16_bf16((a), (b), (c), 0, 0, 0)
#define VHALF ((int)__builtin_amdgcn_readfirstlane((int)(threadIdx.x >> 8)))
#define VTID ((int)(threadIdx.x & 255))
#define VB ((int)(blockIdx.x * 2 + VHALF))
#define VG ((int)(gridDim.x * 2))

constexpr int NB = 16, TT = 4096, LC = 256, DM = 1024, NLAT = NB * TT, NCTX = NB * LC, ROWS = NLAT + NCTX;
constexpr int ZW = 2816, DFF = 4096, NPOS = TT + LC;
constexpr int AP = 1152;
constexpr int WP = 1152;
constexpr int WP2 = 4224;
constexpr int HP = 4224;
constexpr int KVP = 576;
constexpr float LOG2E = 1.4426950408889634f;
constexpr float DN_ALPHA = 1.4142135623730951f;
constexpr int C_AQ = 0, C_AK = 256, C_AV = 384, C_BQKV = 512, C_BZ = 1280, C_BAB = 1536, C_CQ = 1552, C_CK = 1680,
              C_CV = 1808, C_CG = 2064, C_DCQ = 2320, C_DCKV = 2576, C_DKR = 2704;

constexpr size_t al256(size_t x) { return (x + 255) & ~size_t(255); }
constexpr size_t SZ_WIN = (size_t)ZW * WP * 2, SZ_WOUT = (size_t)DM * WP * 2, SZ_WFF = (size_t)DFF * WP * 2,
                 SZ_WUQ = 384 * 256 * 2, SZ_WUKV = 512 * 128 * 2;
constexpr size_t O_WIN = 0;
constexpr size_t O_WOUT = O_WIN + 2 * SZ_WIN;
constexpr size_t O_WFF1 = O_WOUT + 2 * SZ_WOUT;
constexpr size_t O_WFF2 = O_WFF1 + 2 * SZ_WFF;
constexpr size_t O_WUQ = O_WFF2 + 2 * SZ_WFF;
constexpr size_t O_WUKV = O_WUQ + 2 * SZ_WUQ;
constexpr size_t O_MOD = O_WUKV + 2 * SZ_WUKV;
constexpr size_t O_TAB = al256(O_MOD + 2 * 17 * 6144 * 4);
constexpr size_t O_CNT = O_TAB + (size_t)TT * 64 * 8;
constexpr size_t O_GRAW = O_CNT + 256;
constexpr size_t O_G2 = O_GRAW + (size_t)ROWS * 16 * 4;
constexpr size_t O_XC = O_G2 + (size_t)ROWS * 16 * 4;
constexpr size_t O_ACT = O_XC + (size_t)NCTX * DM * 4;
constexpr size_t O_Z = O_ACT + (size_t)ROWS * AP * 2;
constexpr size_t O_QA = O_Z + (size_t)ROWS * ZW * 2;
constexpr size_t O_KA = O_QA + (size_t)NB * 4 * NPOS * 64 * 2;
constexpr size_t O_QD = O_KA + (size_t)NB * 2 * NPOS * 64 * 2;
constexpr size_t O_KVD = O_QD + (size_t)ROWS * 384 * 2;
constexpr size_t O_KR = O_KVD + (size_t)ROWS * KVP * 2;
constexpr size_t O_QKVB = O_KR + (size_t)ROWS * 32 * 2;
constexpr size_t O_OB = O_QKVB + (size_t)ROWS * 768 * 2;
constexpr size_t O_QC = O_OB + (size_t)ROWS * 256 * 2;
constexpr size_t O_KC = O_QC + (size_t)ROWS * 128 * 2;
constexpr size_t O_ORB = O_KC + (size_t)ROWS * 128 * 2;
constexpr size_t O_ST = O_ORB + (size_t)ROWS * 256 * 2;
constexpr size_t WS_END = O_ST + (size_t)ROWS * 8;
static_assert(O_Z + (size_t)ROWS * HP * 2 <= WS_END, "hid alias");
static_assert((size_t)DM * WP2 * 2 <= SZ_WFF, "ff2 weights");
static_assert(WS_END <= (size_t)1073741824, "workspace");

constexpr int LDS_BYTES = 73728;

struct Params {
  const float *x, *c, *ctx, *c_ctx, *ada_w, *ada_b, *w_in, *swa_sink, *dn_conv_w, *dn_a_log, *dn_dt_bias, *dn_norm_g,
      *ret_l1m, *ret_norm_g, *mla_q_norm, *mla_w_uq, *mla_kv_norm, *mla_w_ukv, *w_out, *ln1_g, *ln1_b, *w_ff1, *w_ff2,
      *ln2_g, *ln2_b;
  float* out;
  unsigned char* ws;
};

DI u16 f2bf(float x) { return __builtin_bit_cast(u16, (__bf16)x); }
DI float bf2f(u16 v) { return __uint_as_float(((u32)v) << 16); }
DI u32 pack2(float a, float b) {
  flv2 f = {a, b};
  bfv2 v = __builtin_convertvector(f, bfv2);
  return __builtin_bit_cast(u32, v);
}
DI float bflo(u32 u) { return __uint_as_float(u << 16); }
DI float bfhi(u32 u) { return __uint_as_float(u & 0xffff0000u); }
DI int crow(int reg, int h) { return (reg & 3) + 8 * (reg >> 2) + 4 * h; }
DI float wave_sum(float v) {
#pragma unroll
  for (int o = 32; o >= 1; o >>= 1) v += __shfl_xor(v, o);
  return v;
}
DI float siluf(float x) { return x / (1.f + __expf(-x)); }
DI f32x16 zero16() {
  f32x16 z;
#pragma unroll
  for (int i = 0; i < 16; ++i) z[i] = 0.f;
  return z;
}

DI void scat8s(u16* base, int stride, const uint4& v, float f) {
  base[0 * stride] = f2bf(bflo(v.x) * f); base[1 * stride] = f2bf(bfhi(v.x) * f);
  base[2 * stride] = f2bf(bflo(v.y) * f); base[3 * stride] = f2bf(bfhi(v.y) * f);
  base[4 * stride] = f2bf(bflo(v.z) * f); base[5 * stride] = f2bf(bfhi(v.z) * f);
  base[6 * stride] = f2bf(bflo(v.w) * f); base[7 * stride] = f2bf(bfhi(v.w) * f);
}
DI void scat8r(u16* base, int stride, const uint4& v) {
  base[0 * stride] = (u16)(v.x & 0xffffu); base[1 * stride] = (u16)(v.x >> 16);
  base[2 * stride] = (u16)(v.y & 0xffffu); base[3 * stride] = (u16)(v.y >> 16);
  base[4 * stride] = (u16)(v.z & 0xffffu); base[5 * stride] = (u16)(v.z >> 16);
  base[6 * stride] = (u16)(v.w & 0xffffu); base[7 * stride] = (u16)(v.w >> 16);
}
DI float sumsq8(const uint4& u) {
  float s = 0.f, a;
  a = bflo(u.x); s += a * a; a = bfhi(u.x); s += a * a;
  a = bflo(u.y); s += a * a; a = bfhi(u.y); s += a * a;
  a = bflo(u.z); s += a * a; a = bfhi(u.z); s += a * a;
  a = bflo(u.w); s += a * a; a = bfhi(u.w); s += a * a;
  return s;
}
typedef u32 u32x4 __attribute__((ext_vector_type(4)));
DI u32x4 ldg16(const u16* p) { return *(const u32x4*)p; }
DI void unpack8(const u32x4& u, float* f) {
  f[0] = bflo(u[0]); f[1] = bfhi(u[0]); f[2] = bflo(u[1]); f[3] = bfhi(u[1]);
  f[4] = bflo(u[2]); f[5] = bfhi(u[2]); f[6] = bflo(u[3]); f[7] = bfhi(u[3]);
}
DI u32x4 pack8(const float* f) {
  u32x4 o;
  o[0] = pack2(f[0], f[1]); o[1] = pack2(f[2], f[3]); o[2] = pack2(f[4], f[5]); o[3] = pack2(f[6], f[7]);
  return o;
}
DI float* xrow(const Params& p, int row) {
  return row < NLAT ? p.out + (size_t)row * DM : (float*)(p.ws + O_XC) + (size_t)(row - NLAT) * DM;
}
DI const float* xrow0(const Params& p, int row) {
  return row < NLAT ? p.x + (size_t)row * DM : p.ctx + (size_t)(row - NLAT) * DM;
}
DI int rowb(int row) { return row < NLAT ? (row >> 12) : 16; }

constexpr int CSL = 132;
constexpr int GS = 72;
template <typename Epi>
DI void gemm_tile(const u16* __restrict__ A, int lda, const u16* __restrict__ Bt, int ldb, int K, char* lds, Epi epi) {
  u16* As = (u16*)lds;
  u16* Bs = As + 256 * GS;
  float* Cs = (float*)lds;
  int tid_ = VTID;
  asm volatile("" : "+v"(tid_));
  const int tid = tid_, wave = tid >> 6, lane = tid & 63, r = lane & 31, h = lane >> 5;
  const int wm = wave >> 1, wn = wave & 1;
  f32x16 acc[4][2];
#pragma unroll
  for (int i = 0; i < 4; ++i)
#pragma unroll
    for (int j = 0; j < 2; ++j) acc[i][j] = zero16();
  const int lrow = tid >> 3, lcol = (tid & 7) * 8;
  const u16* Ap = A + (size_t)lrow * lda + lcol;
  const u16* Bp = Bt + (size_t)lrow * ldb + lcol;
  u16* Aw = As + lrow * GS + lcol;
  u16* Bw = Bs + lrow * GS + lcol;
  u32x4 ra[8], rb[4];
#define GT_LOAD(k0)                                                                 \
  {                                                                                 \
    _Pragma("unroll") for (int i_ = 0; i_ < 8; ++i_) ra[i_] = ldg16(Ap + (size_t)(i_ * 32) * lda + (k0)); \
    _Pragma("unroll") for (int i_ = 0; i_ < 4; ++i_) rb[i_] = ldg16(Bp + (size_t)(i_ * 32) * ldb + (k0)); \
  }
#define GT_STORE()                                                                  \
  {                                                                                 \
    _Pragma("unroll") for (int i_ = 0; i_ < 8; ++i_) *(u32x4*)(Aw + i_ * 32 * GS) = ra[i_]; \
    _Pragma("unroll") for (int i_ = 0; i_ < 4; ++i_) *(u32x4*)(Bw + i_ * 32 * GS) = rb[i_]; \
  }
#define GT_COMPUTE()                                                                              \
  _Pragma("unroll") for (int ks = 0; ks < 4; ++ks) {                                              \
    bf16x8 fa[4], fb[2];                                                                          \
    _Pragma("unroll") for (int i_ = 0; i_ < 4; ++i_)                                              \
      fa[i_] = *(const bf16x8*)(As + (wm * 128 + i_ * 32 + r) * GS + ks * 16 + 8 * h);            \
    _Pragma("unroll") for (int j_ = 0; j_ < 2; ++j_)                                              \
      fb[j_] = *(const bf16x8*)(Bs + (wn * 64 + j_ * 32 + r) * GS + ks * 16 + 8 * h);             \
    _Pragma("unroll") for (int i_ = 0; i_ < 4; ++i_)                                              \
      _Pragma("unroll") for (int j_ = 0; j_ < 2; ++j_) acc[i_][j_] = MFMA(fa[i_], fb[j_], acc[i_][j_]); \
  }
  const int nk = K >> 6;
  GT_LOAD(0);
  for (int kt = 0; kt + 1 < nk; ++kt) {
    __syncthreads();
    GT_STORE();
    __syncthreads();
    GT_LOAD((kt + 1) << 6);
    GT_COMPUTE();
  }
  __syncthreads();
  GT_STORE();
  __syncthreads();
  GT_COMPUTE();
#pragma unroll 1
  for (int half = 0; half < 2; ++half) {
    __syncthreads();
    if (wm == half) {
#pragma unroll
      for (int i = 0; i < 4; ++i)
#pragma unroll
        for (int j = 0; j < 2; ++j)
#pragma unroll
          for (int g = 0; g < 16; ++g) Cs[(i * 32 + crow(g, h)) * CSL + wn * 64 + j * 32 + r] = acc[i][j][g];
    }
    __syncthreads();
    epi(half);
  }
}

constexpr int CSW = 264;
template <typename Epi>
DI void gemm_tile512(const u16* __restrict__ A, int lda, const u16* __restrict__ Bt, int ldb, int K, char* lds_all, Epi epi) {
  constexpr int STG = 2 * 256 * GS;
  u16* S0 = (u16*)lds_all;
  float* Cs = (float*)lds_all;
  int tid_ = threadIdx.x;
  asm volatile("" : "+v"(tid_));
  const int tid = tid_, wave = tid >> 6, lane = tid & 63, r = lane & 31, h = lane >> 5;
  const int wm = wave >> 2, wn = wave & 3;
  f32x16 acc[4][2];
#pragma unroll
  for (int i = 0; i < 4; ++i)
#pragma unroll
    for (int j = 0; j < 2; ++j) acc[i][j] = zero16();
  const int lrow = tid >> 3, lcol = (tid & 7) * 8;
  const u16* Ap = A + (size_t)lrow * lda + lcol;
  const u16* Bp = Bt + (size_t)lrow * ldb + lcol;
  u16* Sw = S0 + lrow * GS + lcol;
  u32x4 ra[4], rb[4];
#define G5_LOAD(k0)                                                                 \
  {                                                                                 \
    _Pragma("unroll") for (int i_ = 0; i_ < 4; ++i_) ra[i_] = ldg16(Ap + (size_t)(i_ * 64) * lda + (k0)); \
    _Pragma("unroll") for (int i_ = 0; i_ < 4; ++i_) rb[i_] = ldg16(Bp + (size_t)(i_ * 64) * ldb + (k0)); \
  }
#define G5_STORE(s)                                                                 \
  {                                                                                 \
    _Pragma("unroll") for (int i_ = 0; i_ < 4; ++i_) *(u32x4*)(Sw + (s) * STG + i_ * 64 * GS) = ra[i_]; \
    _Pragma("unroll") for (int i_ = 0; i_ < 4; ++i_) *(u32x4*)(Sw + (s) * STG + 256 * GS + i_ * 64 * GS) = rb[i_]; \
  }
#define G5_COMPUTE(s)                                                                             \
  {                                                                                               \
    __builtin_amdgcn_iglp_opt(1);         \
    const u16* As_ = S0 + (s) * STG;                                                              \
    const u16* Bs_ = As_ + 256 * GS;                                                              \
    _Pragma("unroll") for (int ks = 0; ks < 4; ++ks) {                                            \
      bf16x8 fa[4], fb[2];                                                                        \
      _Pragma("unroll") for (int i_ = 0; i_ < 4; ++i_)                                            \
        fa[i_] = *(const bf16x8*)(As_ + (wm * 128 + i_ * 32 + r) * GS + ks * 16 + 8 * h);         \
      _Pragma("unroll") for (int j_ = 0; j_ < 2; ++j_)                                            \
        fb[j_] = *(const bf16x8*)(Bs_ + (wn * 64 + j_ * 32 + r) * GS + ks * 16 + 8 * h);          \
      _Pragma("unroll") for (int i_ = 0; i_ < 4; ++i_)                                            \
        _Pragma("unroll") for (int j_ = 0; j_ < 2; ++j_) acc[i_][j_] = MFMA(fa[i_], fb[j_], acc[i_][j_]); \
    }                                                                                             \
  }
  const int nk = K >> 6;
  __syncthreads();
  G5_LOAD(0);
  G5_STORE(0);
  G5_LOAD(64);
  __syncthreads();
  for (int kt = 0; kt + 2 < nk; ++kt) {
    const int cur = kt & 1;
    G5_STORE(cur ^ 1);
    G5_LOAD((kt + 2) << 6);
    G5_COMPUTE(cur);
    __syncthreads();
  }
  {
    const int cur = (nk - 2) & 1;
    G5_STORE(cur ^ 1);
    G5_COMPUTE(cur);
    __syncthreads();
    G5_COMPUTE(cur ^ 1);
  }
#pragma unroll 1
  for (int half = 0; half < 2; ++half) {
    __syncthreads();
    if (wm == half) {
#pragma unroll
      for (int i = 0; i < 4; ++i)
#pragma unroll
        for (int j = 0; j < 2; ++j)
#pragma unroll
          for (int g = 0; g < 16; ++g) Cs[(i * 32 + crow(g, h)) * CSW + wn * 64 + j * 32 + r] = acc[i][j][g];
    }
    __syncthreads();
    epi(half);
  }
}

DI void wtrans_tile(const float* __restrict__ src, int K, int N, u16* __restrict__ dst, int ldw, int tk, int tn,
                    const float* __restrict__ kscale, char* lds) {
  float* t = (float*)lds;
  int tid_ = VTID;
  asm volatile("" : "+v"(tid_));
  const int tid = tid_, j = tid & 63, i0 = tid >> 6;
  const int k0 = tk * 64, n0 = tn * 64;
  __syncthreads();
#pragma unroll
  for (int q = 0; q < 16; ++q) {
    int i = i0 + 4 * q;
    float v = (n0 + j < N) ? src[(size_t)(k0 + i) * N + n0 + j] : 0.f;
    if (kscale) v *= kscale[k0 + i];
    t[i * 65 + j] = v;
  }
  __syncthreads();
#pragma unroll 4
  for (int q = 0; q < 16; ++q) {
    int jj = i0 + 4 * q;
    dst[(size_t)(n0 + jj) * ldw + k0 + j] = f2bf(t[j * 65 + jj]);
  }
}

DI void ada_tile(const Params& p, int layer, int cg64, char* lds) {
  float* sc = (float*)lds;
  int tid_ = VTID;
  asm volatile("" : "+v"(tid_));
  const int tid = tid_;
  __syncthreads();
  for (int e = tid; e < 17 * 1024; e += 256) {
    int bi = e >> 10, k = e & 1023;
    float v = bi < 16 ? p.c[bi * 1024 + k] : p.c_ctx[k];
    sc[e] = siluf(v);
  }
  __syncthreads();
  const int col = tid & 63, kq = tid >> 6;
  const int n = cg64 * 64 + col;
  const float* w = p.ada_w + (size_t)layer * 1024 * 6144 + n;
  float acc[17];
#pragma unroll
  for (int i = 0; i < 17; ++i) acc[i] = 0.f;
#pragma unroll 8
  for (int kk = 0; kk < 256; ++kk) {
    int k = kq * 256 + kk;
    float wv = w[(size_t)k * 6144];
#pragma unroll
    for (int i = 0; i < 17; ++i) acc[i] += sc[i * 1024 + k] * wv;
  }
  __syncthreads();
  float* red = (float*)lds;
#pragma unroll
  for (int i = 0; i < 17; ++i) red[(kq * 17 + i) * 64 + col] = acc[i];
  __syncthreads();
  float* mod = (float*)(p.ws + O_MOD) + (size_t)layer * 17 * 6144;
  for (int e = tid; e < 17 * 64; e += 256) {
    int bi = e >> 6, cc = e & 63;
    float s = red[(0 * 17 + bi) * 64 + cc] + red[(1 * 17 + bi) * 64 + cc] + red[(2 * 17 + bi) * 64 + cc] +
              red[(3 * 17 + bi) * 64 + cc];
    int nn = cg64 * 64 + cc;
    mod[bi * 6144 + nn] = s + p.ada_b[layer * 6144 + nn];
  }
}

DI void wtile(const Params& p, int layer, int q, char* lds) {
  if (q < 704) {
    wtrans_tile(p.w_in + (size_t)layer * 1024 * 2736, 1024, 2736, (u16*)(p.ws + O_WIN + layer * SZ_WIN), WP, q / 44, q % 44,
                nullptr, lds);
  } else if (q < 960) {
    q -= 704;
    wtrans_tile(p.w_out + (size_t)layer * 1024 * 1024, 1024, 1024, (u16*)(p.ws + O_WOUT + layer * SZ_WOUT), WP, q / 16, q % 16,
                nullptr, lds);
  } else if (q < 1984) {
    q -= 960;
    wtrans_tile(p.w_ff1 + (size_t)layer * 1024 * 4096, 1024, 4096, (u16*)(p.ws + O_WFF1 + layer * SZ_WFF), WP, q / 64, q % 64,
                nullptr, lds);
  } else if (q < 3008) {
    q -= 1984;
    wtrans_tile(p.w_ff2 + (size_t)layer * 4096 * 1024, 4096, 1024, (u16*)(p.ws + O_WFF2 + layer * SZ_WFF), WP2, q / 16, q % 16,
                nullptr, lds);
  } else if (q < 3032) {
    q -= 3008;
    wtrans_tile(p.mla_w_uq + (size_t)layer * 256 * 384, 256, 384, (u16*)(p.ws + O_WUQ + layer * SZ_WUQ), 256, q / 6, q % 6,
                p.mla_q_norm + layer * 256, lds);
  } else {
    q -= 3032;
    wtrans_tile(p.mla_w_ukv + (size_t)layer * 128 * 512, 128, 512, (u16*)(p.ws + O_WUKV + layer * SZ_WUKV), 128, q / 8, q % 8,
                p.mla_kv_norm + layer * 128, lds);
  }
}
DI void wtile_deferred(const Params& p, int d, char* lds) {
  if (d < 2304) wtile(p, 0, 704 + d, lds);
  else wtile(p, 1, d - 2304, lds);
}

DI void phase0a(const Params& p, char* lds) {
  int tid_ = VTID;
  asm volatile("" : "+v"(tid_));
  const int tid = tid_;
  for (int t = VB; t < 1192; t += VG) {
    if (t < 744) {
      wtile(p, 0, t < 704 ? t : 3008 + (t - 704), lds);
    } else if (t < 936) {
      int q = t - 744;
      ada_tile(p, q / 96, q % 96, lds);
    } else {
      int q = t - 936;
      float2* tab = (float2*)(p.ws + O_TAB);
      for (int e = q * 1024 + tid; e < (q + 1) * 1024; e += 256) {
        int tok = e >> 6, i = e & 63;
        float ang;
        if (i < 32) {
          int f = i & 15;
          float inv = powf(10000.f, -(float)(2 * f) / 32.f);
          ang = (float)(i < 16 ? (tok >> 6) : (tok & 63)) * inv;
        } else if (i < 48) {
          int f = i - 32;
          float inv = powf(10000.f, -(float)(2 * f) / 32.f);
          ang = (float)tok * inv;
        } else {
          int f = (i - 48) & 7;
          float inv = powf(10000.f, -(float)(2 * f) / 16.f);
          ang = (float)((i - 48) < 8 ? (tok >> 6) : (tok & 63)) * inv;
        }
        float sn, cs;
        sincosf(ang, &sn, &cs);
        tab[e] = make_float2(cs, sn);
      }
    }
  }
}

DI void modulate_rows(const Params& p, int layer_mod, int nrows) {
  int tid_ = VTID;
  asm volatile("" : "+v"(tid_));
  const int tid = tid_, wave = tid >> 6, lane = tid & 63;
  const float* mod = (const float*)(p.ws + O_MOD) + (size_t)layer_mod * 17 * 6144;
  u16* act = (u16*)(p.ws + O_ACT);
  const int stride = VG * 4;
  for (int row0 = VB * 4 + wave; row0 < nrows; row0 += 2 * stride) {
    const int row1 = row0 + stride;
    const bool has1 = row1 < nrows;
    float4 va[4], vb[4];
#pragma unroll
    for (int i = 0; i < 4; ++i) {
      va[i] = *(const float4*)(xrow0(p, row0) + (i * 64 + lane) * 4);
      vb[i] = has1 ? *(const float4*)(xrow0(p, row1) + (i * 64 + lane) * 4) : make_float4(0.f, 0.f, 0.f, 0.f);
    }
#pragma unroll
    for (int rr = 0; rr < 2; ++rr) {
      if (rr == 1 && !has1) break;
      const int row = rr ? row1 : row0;
      const float* m = mod + rowb(row) * 6144;
#pragma unroll
      for (int i = 0; i < 4; ++i) {
        int col = (i * 64 + lane) * 4;
        float4 v = rr ? vb[i] : va[i];
        float4 sh = *(const float4*)(m + col);
        float4 sc = *(const float4*)(m + 1024 + col);
        uint2 o;
        o.x = pack2(v.x * (1.f + sc.x) + sh.x, v.y * (1.f + sc.y) + sh.y);
        o.y = pack2(v.z * (1.f + sc.z) + sh.z, v.w * (1.f + sc.w) + sh.w);
        *(uint2*)(act + (size_t)row * AP + col) = o;
      }
    }
  }
}

DI void ln_rows(const Params& p, const float* g, const float* bb, int nrows, int mod_layer, int sh_chunk, bool write_act) {
  int tid_ = VTID;
  asm volatile("" : "+v"(tid_));
  const int tid = tid_, wave = tid >> 6, lane = tid & 63;
  u16* act = (u16*)(p.ws + O_ACT);
  const int stride = VG * 4;
  for (int row0 = VB * 4 + wave; row0 < nrows; row0 += 2 * stride) {
    const int row1 = row0 + stride;
    const bool has1 = row1 < nrows;
    float4 va[4], vb[4];
    float sa = 0.f, sb = 0.f;
#pragma unroll
    for (int i = 0; i < 4; ++i) {
      va[i] = *(const float4*)(xrow(p, row0) + (i * 64 + lane) * 4);
      vb[i] = has1 ? *(const float4*)(xrow(p, row1) + (i * 64 + lane) * 4) : make_float4(0.f, 0.f, 0.f, 0.f);
    }
#pragma unroll
    for (int i = 0; i < 4; ++i) {
      sa += va[i].x + va[i].y + va[i].z + va[i].w;
      sb += vb[i].x + vb[i].y + vb[i].z + vb[i].w;
    }
    const float ma = wave_sum(sa) * (1.f / 1024.f), mb = wave_sum(sb) * (1.f / 1024.f);
    float qa = 0.f, qb = 0.f;
#pragma unroll
    for (int i = 0; i < 4; ++i) {
      va[i].x -= ma; va[i].y -= ma; va[i].z -= ma; va[i].w -= ma;
      vb[i].x -= mb; vb[i].y -= mb; vb[i].z -= mb; vb[i].w -= mb;
      qa += va[i].x * va[i].x + va[i].y * va[i].y + va[i].z * va[i].z + va[i].w * va[i].w;
      qb += vb[i].x * vb[i].x + vb[i].y * vb[i].y + vb[i].z * vb[i].z + vb[i].w * vb[i].w;
    }
    const float ra = rsqrtf(wave_sum(qa) * (1.f / 1024.f) + 1e-5f), rb = rsqrtf(wave_sum(qb) * (1.f / 1024.f) + 1e-5f);
#pragma unroll
    for (int rr = 0; rr < 2; ++rr) {
      if (rr == 1 && !has1) break;
      const int row = rr ? row1 : row0;
      const float rstd = rr ? rb : ra;
      float* dst = xrow(p, row);
      if (write_act && lane == 0) ((float2*)(p.ws + O_ST))[row] = make_float2(rr ? mb : ma, rstd);
      const float* m = (const float*)(p.ws + O_MOD) + (size_t)mod_layer * 17 * 6144 + rowb(row) * 6144 + sh_chunk * 1024;
#pragma unroll
      for (int i = 0; i < 4; ++i) {
        int col = (i * 64 + lane) * 4;
        float4 v = rr ? vb[i] : va[i];
        float4 gg = *(const float4*)(g + col);
        float4 bv = *(const float4*)(bb + col);
        float4 y;
        y.x = v.x * rstd * gg.x + bv.x; y.y = v.y * rstd * gg.y + bv.y;
        y.z = v.z * rstd * gg.z + bv.z; y.w = v.w * rstd * gg.w + bv.w;
        if (!write_act) *(float4*)(dst + col) = y;
        if (write_act) {
          float4 sh = *(const float4*)(m + col);
          float4 sc = *(const float4*)(m + 1024 + col);
          uint2 o;
          o.x = pack2(y.x * (1.f + sc.x) + sh.x, y.y * (1.f + sc.y) + sh.y);
          o.y = pack2(y.z * (1.f + sc.z) + sh.z, y.w * (1.f + sc.w) + sh.w);
          *(uint2*)(act + (size_t)row * AP + col) = o;
        }
      }
    }
  }
}

DI void gemm_phase(const Params& p, int layer, int mode, int nrows, char* lds_all) {
  int tid_ = threadIdx.x;
  asm volatile("" : "+v"(tid_));
  const int tid = tid_;
  const float* Cs = (const float*)lds_all;
  int ntn, K, lda, ldb;
  const u16 *A, *Bt;
  if (mode == 0) { ntn = 11; K = 1024; lda = AP; ldb = WP; A = (const u16*)(p.ws + O_ACT); Bt = (const u16*)(p.ws + O_WIN + layer * SZ_WIN); }
  else if (mode == 1) { ntn = 4; K = 1024; lda = AP; ldb = WP; A = (const u16*)(p.ws + O_ACT); Bt = (const u16*)(p.ws + O_WOUT + layer * SZ_WOUT); }
  else if (mode == 2) { ntn = 16; K = 1024; lda = AP; ldb = WP; A = (const u16*)(p.ws + O_ACT); Bt = (const u16*)(p.ws + O_WFF1 + layer * SZ_WFF); }
  else { ntn = 4; K = 4096; lda = HP; ldb = WP2; A = (const u16*)(p.ws + O_Z); Bt = (const u16*)(p.ws + O_WFF2 + layer * SZ_WFF); }
  const int ntm = nrows >> 8;
  const float* mod = (const float*)(p.ws + O_MOD) + (size_t)layer * 17 * 6144;
  const bool swz = (gridDim.x & 7) == 0;
  const int xcd = swz ? (blockIdx.x & 7) : 0, nx = swz ? 8 : 1;
  const int jb = swz ? (blockIdx.x >> 3) : blockIdx.x, nj = swz ? (gridDim.x >> 3) : gridDim.x;
  const int per = 2 * ntn, nsr = ntm >> 1;
  for (int i = jb;; i += nj) {
    const int srl = i / per, rem = i - srl * per;
    const int sr = xcd + nx * srl;
    if (sr >= nsr) break;
    const int tn = rem >> 1, tm = sr * 2 + (rem & 1);
    const int m0 = tm * 256, n0 = tn * 256;
    gemm_tile512(A + (size_t)m0 * lda, lda, Bt + (size_t)n0 * ldb, ldb, K, lds_all, [&](int half) {
      for (int idx = tid; idx < 128 * 64; idx += 512) {
        const int rr = idx >> 6, c4 = (idx & 63) * 4;
        const int row = m0 + half * 128 + rr, col = n0 + c4;
        float4 v = *(const float4*)(Cs + rr * CSW + c4);
        if (mode == 0) {
          uint2 o;
          o.x = pack2(v.x, v.y); o.y = pack2(v.z, v.w);
          *(uint2*)((u16*)(p.ws + O_Z) + (size_t)row * ZW + col) = o;
          if (n0 == C_BAB && c4 < 16) *(float4*)((float*)(p.ws + O_GRAW) + (size_t)row * 16 + c4) = v;
        } else if (mode == 2) {
          float a = fmaxf(v.x, 0.f), b = fmaxf(v.y, 0.f), c = fmaxf(v.z, 0.f), d = fmaxf(v.w, 0.f);
          uint2 o;
          o.x = pack2(a * a, b * b); o.y = pack2(c * c, d * d);
          *(uint2*)((u16*)(p.ws + O_Z) + (size_t)row * HP + col) = o;
        } else {
          const float* gate = mod + rowb(row) * 6144 + (mode == 1 ? 2 : 5) * 1024 + col;
          float4 gt = *(const float4*)gate;
          const float* res = (mode == 1 && layer == 0) ? xrow0(p, row) : xrow(p, row);
          float4 xr = *(const float4*)(res + col);
          if (!(mode == 1 && layer == 0)) {
            const float2 st = ((const float2*)(p.ws + O_ST))[row];
            const float* lg_ = (mode == 3) ? p.ln1_g + layer * DM : p.ln2_g + (layer - 1) * DM;
            const float* lb_ = (mode == 3) ? p.ln1_b + layer * DM : p.ln2_b + (layer - 1) * DM;
            const float4 lg4 = *(const float4*)(lg_ + col), lb4 = *(const float4*)(lb_ + col);
            xr.x = (xr.x - st.x) * st.y * lg4.x + lb4.x; xr.y = (xr.y - st.x) * st.y * lg4.y + lb4.y;
            xr.z = (xr.z - st.x) * st.y * lg4.z + lb4.z; xr.w = (xr.w - st.x) * st.y * lg4.w + lb4.w;
          }
          float4 o;
          o.x = DN_ALPHA * xr.x + gt.x * v.x; o.y = DN_ALPHA * xr.y + gt.y * v.y;
          o.z = DN_ALPHA * xr.z + gt.z * v.z; o.w = DN_ALPHA * xr.w + gt.w * v.w;
          *(float4*)(xrow(p, row) + col) = o;
        }
      }
    });
  }
}

DI void prep_swa(const Params& p, int tile) {
  int tid_ = VTID;
  asm volatile("" : "+v"(tid_));
  const int tid = tid_;
  const u16* Z = (const u16*)(p.ws + O_Z);
  const float4* tab = (const float4*)(p.ws + O_TAB);
  u16* QA = (u16*)(p.ws + O_QA);
  u16* KA = (u16*)(p.ws + O_KA);
  const int m0 = tile * 64;
  for (int jb = 0; jb < 6; jb += 3) {
    u32x4 x1[3], x2[3];
    float4 tb[3][4];
#pragma unroll
    for (int u = 0; u < 3; ++u) {
      const int id = tid + 256 * (jb + u), ri = id / 24, rem = id % 24, slot = rem >> 2, i8 = rem & 3;
      const int row = m0 + ri;
      const int base = slot < 4 ? C_AQ + slot * 64 : C_AK + (slot - 4) * 64;
      x1[u] = ldg16(Z + (size_t)row * ZW + base + i8 * 8);
      x2[u] = ldg16(Z + (size_t)row * ZW + base + 32 + i8 * 8);
      const int pos = row < NLAT ? (row & 4095) : 0;
#pragma unroll
      for (int e = 0; e < 4; ++e) tb[u][e] = tab[(pos * 64 + i8 * 8) / 2 + e];
    }
#pragma unroll
    for (int u = 0; u < 3; ++u) {
      const int id = tid + 256 * (jb + u), ri = id / 24, rem = id % 24, slot = rem >> 2, i8 = rem & 3;
      const int row = m0 + ri;
      const bool lat = row < NLAT;
      int b, pos;
      if (lat) { b = row >> 12; pos = row & 4095; } else { b = (row - NLAT) >> 8; pos = TT + ((row - NLAT) & 255); }
      float a1[8], a2[8], o1[8], o2[8];
      unpack8(x1[u], a1); unpack8(x2[u], a2);
      const float qs = slot < 4 ? 0.125f * LOG2E : 1.f;
#pragma unroll
      for (int e = 0; e < 4; ++e) {
        float c0 = lat ? tb[u][e].x : 1.f, s0 = lat ? tb[u][e].y : 0.f, c1 = lat ? tb[u][e].z : 1.f, s1 = lat ? tb[u][e].w : 0.f;
        o1[2 * e] = (a1[2 * e] * c0 - a2[2 * e] * s0) * qs;
        o2[2 * e] = (a1[2 * e] * s0 + a2[2 * e] * c0) * qs;
        o1[2 * e + 1] = (a1[2 * e + 1] * c1 - a2[2 * e + 1] * s1) * qs;
        o2[2 * e + 1] = (a1[2 * e + 1] * s1 + a2[2 * e + 1] * c1) * qs;
      }
      u16* d = slot < 4 ? QA + ((size_t)(b * 4 + slot) * NPOS + pos) * 64 : KA + ((size_t)(b * 2 + slot - 4) * NPOS + pos) * 64;
      *(u32x4*)(d + i8 * 8) = pack8(o1);
      *(u32x4*)(d + 32 + i8 * 8) = pack8(o2);
    }
  }
}

DI void prep_ret(const Params& p, int tile) {
  int tid_ = VTID;
  asm volatile("" : "+v"(tid_));
  const int tid = tid_;
  const u16* Z = (const u16*)(p.ws + O_Z);
  const float4* tab = (const float4*)(p.ws + O_TAB);
  u16* QC = (u16*)(p.ws + O_QC);
  u16* KC = (u16*)(p.ws + O_KC);
  const int m0 = tile * 64;
  u32x4 x1[4], x2[4];
  float4 tb[4][4];
#pragma unroll
  for (int u = 0; u < 4; ++u) {
    const int id = tid + 256 * u, ri = id >> 4, rem = id & 15, slot = rem >> 1, i8 = rem & 1;
    const int row = m0 + ri;
    const int base = C_CQ + slot * 32;
    x1[u] = ldg16(Z + (size_t)row * ZW + base + i8 * 8);
    x2[u] = ldg16(Z + (size_t)row * ZW + base + 16 + i8 * 8);
    const int pos = row < NLAT ? (row & 4095) : 0;
#pragma unroll
    for (int e = 0; e < 4; ++e) tb[u][e] = tab[(pos * 64 + 32 + i8 * 8) / 2 + e];
  }
#pragma unroll
  for (int u = 0; u < 4; ++u) {
    const int id = tid + 256 * u, ri = id >> 4, rem = id & 15, slot = rem >> 1, i8 = rem & 1;
    const int row = m0 + ri;
    const bool lat = row < NLAT;
    float a1[8], a2[8], o1[8], o2[8];
    unpack8(x1[u], a1); unpack8(x2[u], a2);
    const float qs = slot < 4 ? 0.17677669529663687f : 1.f;
#pragma unroll
    for (int e = 0; e < 4; ++e) {
      float c0 = lat ? tb[u][e].x : 1.f, s0 = lat ? tb[u][e].y : 0.f, c1 = lat ? tb[u][e].z : 1.f, s1 = lat ? tb[u][e].w : 0.f;
      o1[2 * e] = (a1[2 * e] * c0 - a2[2 * e] * s0) * qs;
      o2[2 * e] = (a1[2 * e] * s0 + a2[2 * e] * c0) * qs;
      o1[2 * e + 1] = (a1[2 * e + 1] * c1 - a2[2 * e + 1] * s1) * qs;
      o2[2 * e + 1] = (a1[2 * e + 1] * s1 + a2[2 * e + 1] * c1) * qs;
    }
    u16* d = slot < 4 ? QC + (size_t)row * 128 + slot * 32 : KC + (size_t)row * 128 + (slot - 4) * 32;
    *(u32x4*)(d + i8 * 8) = pack8(o1);
    *(u32x4*)(d + 16 + i8 * 8) = pack8(o2);
  }
}

DI void prep_dn(const Params& p, int layer, int tile, char* lds) {
  int tid_ = VTID;
  asm volatile("" : "+v"(tid_));
  const int tid = tid_;
  const u16* Z = (const u16*)(p.ws + O_Z);
  u16* QKVB = (u16*)(p.ws + O_QKVB);
  float* cw = (float*)lds;
  const int m0 = tile * 64;
  __syncthreads();
  for (int e = tid; e < 3840; e += 256) cw[e] = p.dn_conv_w[(size_t)layer * 3840 + e];
  __syncthreads();
  for (int jb = 0; jb < 24; jb += 4) {
    u32x4 xr[4][5];
#pragma unroll
    for (int u = 0; u < 4; ++u) {
      const int id = tid + 256 * (jb + u), ri = id / 96, ch8 = id % 96;
      const int row = m0 + ri;
      int tpos, seqn;
      if (row < NLAT) { tpos = row & 4095; seqn = TT; } else { tpos = (row - NLAT) & 255; seqn = LC; }
      const u16* zc = Z + (size_t)row * ZW + C_BQKV + ch8 * 8;
#pragma unroll
      for (int j = 0; j < 5; ++j) {
        const int tp = tpos + j - 2;
        u32x4 zz = {0u, 0u, 0u, 0u};
        xr[u][j] = (tp >= 0 && tp < seqn) ? ldg16(zc + (j - 2) * ZW) : zz;
      }
    }
#pragma unroll
    for (int u = 0; u < 4; ++u) {
      const int id = tid + 256 * (jb + u), ri = id / 96, ch8 = id % 96;
      const int row = m0 + ri;
      float acc[8];
#pragma unroll
      for (int e = 0; e < 8; ++e) acc[e] = 0.f;
#pragma unroll
      for (int j = 0; j < 5; ++j) {
        float x[8];
        unpack8(xr[u][j], x);
        const float4 w0 = *(const float4*)(cw + j * 768 + ch8 * 8), w1 = *(const float4*)(cw + j * 768 + ch8 * 8 + 4);
        acc[0] += x[0] * w0.x; acc[1] += x[1] * w0.y; acc[2] += x[2] * w0.z; acc[3] += x[3] * w0.w;
        acc[4] += x[4] * w1.x; acc[5] += x[5] * w1.y; acc[6] += x[6] * w1.z; acc[7] += x[7] * w1.w;
      }
      float ss = 0.f;
#pragma unroll
      for (int e = 0; e < 8; ++e) { acc[e] = siluf(acc[e]); ss += acc[e] * acc[e]; }
      ss += __shfl_xor(ss, 1); ss += __shfl_xor(ss, 2); ss += __shfl_xor(ss, 4);
      const int grp = ch8 >> 3;
      const float sc = grp < 8 ? rsqrtf(ss + 1e-6f) * (grp < 4 ? 0.125f : 1.f) : 1.f;
#pragma unroll
      for (int e = 0; e < 8; ++e) acc[e] *= sc;
      *(u32x4*)(QKVB + (size_t)row * 768 + ch8 * 8) = pack8(acc);
    }
  }
  const float* graw = (const float*)(p.ws + O_GRAW);
  float* g2 = (float*)(p.ws + O_G2);
  for (int e = tid; e < 64 * 8; e += 256) {
    int ri = e >> 3, dh = e & 7, dir = dh >> 2, hh = dh & 3;
    int row = m0 + ri;
    float ra = graw[(size_t)row * 16 + dir * 8 + hh], rb = graw[(size_t)row * 16 + dir * 8 + 4 + hh];
    float xx = ra + p.dn_dt_bias[layer * 8 + dh];
    float sp = xx > 20.f ? xx : log1pf(expf(xx));
    float lg = -expf(p.dn_a_log[layer * 8 + dh]) * sp;
    float beta = 1.f / (1.f + expf(-rb));
    g2[(size_t)row * 16 + dh] = lg;
    g2[(size_t)row * 16 + 8 + dh] = beta;
  }
}

DI void prep_mla(const Params& p, int layer, int tm, int which, int nt, char* lds) {
  int tid_ = VTID;
  asm volatile("" : "+v"(tid_));
  const int tid = tid_;
  const u16* Z = (const u16*)(p.ws + O_Z);
  const int m0 = tm * 256;
  float* rs = (float*)(lds + 128 * CSL * 4);
  const int KK = which == 0 ? 256 : 128;
  const int cbase = which == 0 ? C_DCQ : C_DCKV;
  __syncthreads();
  {
    const u16* src = Z + (size_t)(m0 + tid) * ZW + cbase;
    float s = 0.f;
    for (int i = 0; i < KK / 8; i += 4) {
      u32x4 u0 = ldg16(src + i * 8), u1 = ldg16(src + i * 8 + 8), u2 = ldg16(src + i * 8 + 16), u3 = ldg16(src + i * 8 + 24);
      float f[8];
      unpack8(u0, f);
#pragma unroll
      for (int e = 0; e < 8; ++e) s += f[e] * f[e];
      unpack8(u1, f);
#pragma unroll
      for (int e = 0; e < 8; ++e) s += f[e] * f[e];
      unpack8(u2, f);
#pragma unroll
      for (int e = 0; e < 8; ++e) s += f[e] * f[e];
      unpack8(u3, f);
#pragma unroll
      for (int e = 0; e < 8; ++e) s += f[e] * f[e];
    }
    rs[tid] = rsqrtf(s / (float)KK + 1e-6f);
  }
  const u16* Bt = which == 0 ? (const u16*)(p.ws + O_WUQ + layer * SZ_WUQ) + (size_t)nt * 128 * 256
                             : (const u16*)(p.ws + O_WUKV + layer * SZ_WUKV) + (size_t)nt * 128 * 128;
  const float* Cs = (const float*)lds;
  const float2* tab = (const float2*)(p.ws + O_TAB);
  gemm_tile(Z + (size_t)m0 * ZW + cbase, ZW, Bt, KK, KK, lds, [&](int half) {
    if (which == 0) {
      u16* QD = (u16*)(p.ws + O_QD);
      const float qs = 0.10206207261596575f * LOG2E;
      for (int idx = tid; idx < 128 * 32; idx += 256) {
        const int rr = idx >> 5, c4 = (idx & 31) * 4;
        const int row = m0 + half * 128 + rr;
        const float sc = rs[half * 128 + rr] * qs;
        float o[4];
#pragma unroll
        for (int j = 0; j < 4; ++j) {
          int cl = c4 + j, c = nt * 128 + cl, d = c % 96;
          float v = Cs[rr * CSL + cl];
          if (d >= 64 && row < NLAT) {
            int i = d - 64;
            if (i < 16) {
              float2 t = tab[(row & 4095) * 64 + 48 + i];
              float x2 = Cs[rr * CSL + cl + 16];
              v = v * t.x - x2 * t.y;
            } else {
              float2 t = tab[(row & 4095) * 64 + 48 + i - 16];
              float x1 = Cs[rr * CSL + cl - 16];
              v = x1 * t.y + v * t.x;
            }
          }
          o[j] = v * sc;
        }
        uint2 w;
        w.x = pack2(o[0], o[1]); w.y = pack2(o[2], o[3]);
        *(uint2*)(QD + (size_t)row * 384 + nt * 128 + c4) = w;
      }
    } else {
      u16* KVD = (u16*)(p.ws + O_KVD);
      for (int idx = tid; idx < 128 * 32; idx += 256) {
        const int rr = idx >> 5, c4 = (idx & 31) * 4;
        const int row = m0 + half * 128 + rr;
        const float sc = rs[half * 128 + rr];
        float4 v = *(const float4*)(Cs + rr * CSL + c4);
        uint2 w;
        w.x = pack2(v.x * sc, v.y * sc); w.y = pack2(v.z * sc, v.w * sc);
        *(uint2*)(KVD + (size_t)row * KVP + nt * 128 + c4) = w;
      }
    }
  });
  if (which == 1 && nt == 0) {
    u16* KR = (u16*)(p.ws + O_KR);
    for (int e = tid; e < 256 * 16; e += 256) {
      int rr = e >> 4, i = e & 15, row = m0 + rr;
      float cs = 1.f, sn = 0.f;
      if (row < NLAT) { float2 t = tab[(row & 4095) * 64 + 48 + i]; cs = t.x; sn = t.y; }
      float x1 = bf2f(Z[(size_t)row * ZW + C_DKR + i]), x2 = bf2f(Z[(size_t)row * ZW + C_DKR + 16 + i]);
      KR[(size_t)row * 32 + i] = f2bf(x1 * cs - x2 * sn);
      KR[(size_t)row * 32 + 16 + i] = f2bf(x1 * sn + x2 * cs);
    }
  }
}

DI void prep_phase(const Params& p, int layer, char* lds) {
  const int total = 3264 + 816 + 1088;
  for (int t = VB; t < total; t += VG) {
    if (t < 1088) prep_swa(p, t);
    else if (t < 2176) prep_ret(p, t - 1088);
    else if (t < 3264) prep_dn(p, layer, t - 2176, lds);
    else if (t < 3264 + 816) { int q = t - 3264; prep_mla(p, layer, q / 3, 0, q % 3, lds); }
    else { int q = t - 3264 - 816; prep_mla(p, layer, q / 4, 1, q % 4, lds); }
  }
}

struct Seg {
  const u16* k; const u16* k2; const u16* v;
  int ldk, ldk2, ldv, n, pos0, masked;
};

template <int DQK>
DI void attn_tile(const u16* __restrict__ q, int ldq, int qpos0, const Seg& s0, const Seg& s1, int nseg, bool has_sink,
                  float sinkl2, u16* __restrict__ out, int ldo, char* lds) {
  constexpr int KST = DQK + 8;
  constexpr int CPK = DQK / 8;
  constexpr int NKS = DQK / 16;
  constexpr int VST = 96;
  u16* Ks = (u16*)lds;
  u16* Vs = Ks + 64 * KST;
  int ltid_ = threadIdx.x;
  asm volatile("" : "+v"(ltid_));
  const int ltid = ltid_;
  const int tid = ltid & 255, wave = tid >> 6, lane = tid & 63, r = lane & 31, h = lane >> 5;
  const int qi = wave * 32 + r;
  bf16x8 qf[NKS];
#pragma unroll
  for (int ks = 0; ks < NKS; ++ks) qf[ks] = *(const bf16x8*)(q + (size_t)qi * ldq + ks * 16 + 8 * h);
  const int nt0 = s0.n >> 6;
  const int NT = nt0 + (nseg > 1 ? (s1.n >> 6) : 0);
  uint4 kreg0, kreg1 = make_uint4(0, 0, 0, 0), vreg0;
  uint4 krgB0, krgB1 = make_uint4(0, 0, 0, 0), vrgB0;
  const int kkey0 = ltid / CPK, kpart0 = ltid % CPK;
  const int kkey1 = (ltid + 512) / CPK, kpart1 = (ltid + 512) % CPK;
  const bool k1 = (CPK == 12) && (ltid < 256);
  const int vkey = ltid >> 3, vpart = ltid & 7;
  typedef __attribute__((address_space(3))) const char* lds_cptr;
  typedef short v4i16_t __attribute__((ext_vector_type(4)));
  const lds_cptr vp0 = (lds_cptr)Vs + (4 * h + ((lane & 15) >> 2)) * (VST * 2) + ((lane >> 4) & 1) * 32 + (lane & 3) * 8;
#define ATT_VTR(p) __builtin_bit_cast(s16x4, __builtin_amdgcn_ds_read_tr16_b64_v4i16((__attribute__((address_space(3))) v4i16_t*)(p)))
#define ATT_KSRC(sg, off, key, part) \
  (((part) < 8) ? (sg).k + (size_t)((off) + (key)) * (sg).ldk + (part) * 8 : (sg).k2 + (size_t)((off) + (key)) * (sg).ldk2 + ((part) - 8) * 8)
#define ATT_LOADX(i, K0, K1, V0)                                                            \
  {                                                                                         \
    const Seg& sgl = ((i) < nt0) ? s0 : s1;                                                 \
    const int offl = (((i) < nt0) ? (i) : (i) - nt0) << 6;                                  \
    K0 = *(const uint4*)ATT_KSRC(sgl, offl, kkey0, kpart0);                                 \
    if (k1) K1 = *(const uint4*)ATT_KSRC(sgl, offl, kkey1, kpart1);                         \
    V0 = *(const uint4*)(sgl.v + (size_t)(offl + vkey) * sgl.ldv + vpart * 8);              \
  }
  f32x16 o0 = zero16(), o1 = zero16();
  float m = -1e30f, l = 0.f;
#define ATT_STOREX(K0, K1, V0)                                               \
  {                                                                           \
    *(uint4*)(Ks + kkey0 * KST + kpart0 * 8) = K0;                            \
    if (k1) *(uint4*)(Ks + kkey1 * KST + kpart1 * 8) = K1;                    \
    *(uint4*)(Vs + vkey * VST + vpart * 8) = V0;                              \
  }
  auto compute = [&](int i) {
    const Seg& sg = (i < nt0) ? s0 : s1;
    const int off = ((i < nt0) ? i : i - nt0) << 6;
    f32x16 sa = zero16(), sb = zero16();
#pragma unroll
    for (int ks = 0; ks < NKS; ++ks) {
      bf16x8 a0 = *(const bf16x8*)(Ks + r * KST + ks * 16 + 8 * h);
      bf16x8 a1 = *(const bf16x8*)(Ks + (32 + r) * KST + ks * 16 + 8 * h);
      sa = MFMA(a0, qf[ks], sa);
      sb = MFMA(a1, qf[ks], sb);
    }
    if (sg.masked) {
      const int qpos = qpos0 + qi;
      const int kb = sg.pos0 + off;
#pragma unroll
      for (int g = 0; g < 16; ++g) {
        int d0 = kb + crow(g, h) - qpos, d1 = d0 + 32;
        if (d0 > 128 || d0 < -128) sa[g] = -INFINITY;
        if (d1 > 128 || d1 < -128) sb[g] = -INFINITY;
      }
    }
    float mx = sa[0];
#pragma unroll
    for (int g = 1; g < 16; ++g) mx = fmaxf(mx, sa[g]);
#pragma unroll
    for (int g = 0; g < 16; ++g) mx = fmaxf(mx, sb[g]);
    mx = fmaxf(mx, __shfl_xor(mx, 32));
    const float mn = fmaxf(m, mx);
    const float alpha = __builtin_amdgcn_exp2f(m - mn);
    m = mn;
    float ps = 0.f;
#pragma unroll
    for (int g = 0; g < 16; ++g) { sa[g] = __builtin_amdgcn_exp2f(sa[g] - mn); ps += sa[g]; }
#pragma unroll
    for (int g = 0; g < 16; ++g) { sb[g] = __builtin_amdgcn_exp2f(sb[g] - mn); ps += sb[g]; }
    l = l * alpha + ps;
#pragma unroll
    for (int g = 0; g < 16; ++g) { o0[g] *= alpha; o1[g] *= alpha; }
#pragma unroll
    for (int kt = 0; kt < 2; ++kt) {
#pragma unroll
      for (int s = 0; s < 2; ++s) {
        const f32x16& sv = kt == 0 ? sa : sb;
        uint4 pu;
        pu.x = pack2(sv[8 * s + 0], sv[8 * s + 1]); pu.y = pack2(sv[8 * s + 2], sv[8 * s + 3]);
        pu.z = pack2(sv[8 * s + 4], sv[8 * s + 5]); pu.w = pack2(sv[8 * s + 6], sv[8 * s + 7]);
        bf16x8 pf = __builtin_bit_cast(bf16x8, pu);
        const lds_cptr vp = vp0 + (kt * 32 + 16 * s) * (VST * 2);
        {
          s16x4 lo = ATT_VTR(vp);
          s16x4 hi = ATT_VTR(vp + 8 * VST * 2);
          bf16x8 vf = __builtin_shufflevector(lo, hi, 0, 1, 2, 3, 4, 5, 6, 7);
          o0 = MFMA(vf, pf, o0);
        }
        {
          s16x4 lo = ATT_VTR(vp + 64);
          s16x4 hi = ATT_VTR(vp + 8 * VST * 2 + 64);
          bf16x8 vf = __builtin_shufflevector(lo, hi, 0, 1, 2, 3, 4, 5, 6, 7);
          o1 = MFMA(vf, pf, o1);
        }
      }
    }
  };
  ATT_LOADX(0, kreg0, kreg1, vreg0);
  ATT_LOADX(1, krgB0, krgB1, vrgB0);
  for (int i = 0; i < NT; i += 2) {
    __syncthreads();
    ATT_STOREX(kreg0, kreg1, vreg0);
    __syncthreads();
    if (i + 2 < NT) ATT_LOADX(i + 2, kreg0, kreg1, vreg0);
    compute(i);
    __syncthreads();
    ATT_STOREX(krgB0, krgB1, vrgB0);
    __syncthreads();
    if (i + 3 < NT) ATT_LOADX(i + 3, krgB0, krgB1, vrgB0);
    compute(i + 1);
  }
  float lt = l + __shfl_xor(l, 32);
  if (has_sink) lt += __builtin_amdgcn_exp2f(sinkl2 - m);
  const float inv = 1.f / lt;
#pragma unroll
  for (int g = 0; g < 4; ++g) {
    uint2 w;
    w.x = pack2(o0[4 * g] * inv, o0[4 * g + 1] * inv); w.y = pack2(o0[4 * g + 2] * inv, o0[4 * g + 3] * inv);
    *(uint2*)(out + (size_t)qi * ldo + 8 * g + 4 * h) = w;
    w.x = pack2(o1[4 * g] * inv, o1[4 * g + 1] * inv); w.y = pack2(o1[4 * g + 2] * inv, o1[4 * g + 3] * inv);
    *(uint2*)(out + (size_t)qi * ldo + 32 + 8 * g + 4 * h) = w;
  }
}

DI void mla_attn(const Params& p, int idx, char* lds) {
  const u16* QD = (const u16*)(p.ws + O_QD);
  const u16* KVD = (const u16*)(p.ws + O_KVD);
  const u16* KR = (const u16*)(p.ws + O_KR);
  u16* act = (u16*)(p.ws + O_ACT);
  Seg lat, cx;
  int b, hh, row0;
  bool is_ctx = idx >= 2048;
  if (!is_ctx) { b = idx >> 7; hh = (idx >> 5) & 3; row0 = b * TT + (idx & 31) * 128; }
  else { int q = idx - 2048; b = q >> 3; hh = (q >> 1) & 3; row0 = NLAT + b * LC + (q & 1) * 128; }
  const size_t lr = (size_t)b * TT, cr = (size_t)NLAT + b * LC;
  lat.k = KVD + lr * KVP + hh * 128; lat.ldk = KVP; lat.k2 = KR + lr * 32; lat.ldk2 = 32; lat.v = KVD + lr * KVP + hh * 128 + 64;
  lat.ldv = KVP; lat.n = TT; lat.pos0 = 0; lat.masked = 0;
  cx.k = KVD + cr * KVP + hh * 128; cx.ldk = KVP; cx.k2 = KR + cr * 32; cx.ldk2 = 32; cx.v = KVD + cr * KVP + hh * 128 + 64;
  cx.ldv = KVP; cx.n = LC; cx.pos0 = 0; cx.masked = 0;
  const u16* q = QD + (size_t)row0 * 384 + hh * 96;
  u16* o = act + (size_t)row0 * AP + 768 + hh * 64;
  if (!is_ctx) attn_tile<96>(q, 384, 0, lat, cx, 2, false, 0.f, o, AP, lds);
  else attn_tile<96>(q, 384, 0, cx, cx, 1, false, 0.f, o, AP, lds);
}

DI void swa_attn(const Params& p, int layer, int idx, char* lds) {
  const u16* QA = (const u16*)(p.ws + O_QA);
  const u16* KA = (const u16*)(p.ws + O_KA);
  const u16* Z = (const u16*)(p.ws + O_Z);
  u16* act = (u16*)(p.ws + O_ACT);
  Seg loc, cx;
  int b, hh, row0, pos0q;
  bool is_ctx = idx >= 2048;
  int nb = 0;
  if (!is_ctx) { b = idx >> 7; hh = ((idx >> 6) & 1) * 2 + (idx & 1); nb = (idx >> 1) & 31; pos0q = nb * 128; row0 = b * TT + pos0q; }
  else { int q = idx - 2048; b = q >> 3; hh = (q >> 1) & 3; pos0q = TT + (q & 1) * 128; row0 = NLAT + b * LC + (q & 1) * 128; }
  const int hk = hh >> 1;
  const u16* kbase = KA + (size_t)(b * 2 + hk) * NPOS * 64;
  cx.k = kbase + (size_t)TT * 64; cx.ldk = 64; cx.k2 = cx.k; cx.ldk2 = 64;
  cx.v = Z + ((size_t)NLAT + b * LC) * ZW + C_AV + hk * 64; cx.ldv = ZW; cx.n = LC; cx.pos0 = 0; cx.masked = 0;
  const float sinkl2 = p.swa_sink[layer * 4 + hh] * LOG2E;
  const u16* q = QA + ((size_t)(b * 4 + hh) * NPOS + pos0q) * 64;
  u16* o = act + (size_t)row0 * AP + hh * 64;
  if (!is_ctx) {
    int ks = nb * 128 - 128; if (ks < 0) ks = 0;
    int ke = nb * 128 + 256; if (ke > TT) ke = TT;
    loc.k = kbase + (size_t)ks * 64; loc.ldk = 64; loc.k2 = loc.k; loc.ldk2 = 64;
    loc.v = Z + ((size_t)b * TT + ks) * ZW + C_AV + hk * 64; loc.ldv = ZW; loc.n = ke - ks; loc.pos0 = ks; loc.masked = 1;
    attn_tile<64>(q, 64, pos0q, loc, cx, 2, true, sinkl2, o, AP, lds);
  } else {
    attn_tile<64>(q, 64, 0, cx, cx, 1, true, sinkl2, o, AP, lds);
  }
}

constexpr int LS = 72;
template <int KS>
DI f32x16 mm64(const u16* A, int lda, const u16* Bt, int ldb, int wm, int wn, int r, int h) {
  f32x16 acc = zero16();
#pragma unroll
  for (int s = 0; s < KS; ++s) {
    bf16x8 a = *(const bf16x8*)(A + (wm * 32 + r) * lda + s * 16 + 8 * h);
    bf16x8 b = *(const bf16x8*)(Bt + (wn * 32 + r) * ldb + s * 16 + 8 * h);
    acc = MFMA(a, b, acc);
  }
  return acc;
}
DI void st_straight(u16* D, int ld, const f32x16& v, int wm, int wn, int r, int h) {
#pragma unroll
  for (int g = 0; g < 16; ++g) D[(wm * 32 + crow(g, h)) * ld + wn * 32 + r] = f2bf(v[g]);
}
DI void st_transp(u16* D, int ld, const f32x16& v, int wm, int wn, int r, int h) {
#pragma unroll
  for (int g = 0; g < 4; ++g) {
    uint2 w;
    w.x = pack2(v[4 * g], v[4 * g + 1]); w.y = pack2(v[4 * g + 2], v[4 * g + 3]);
    *(uint2*)(D + (wn * 32 + r) * ld + wm * 32 + 8 * g + 4 * h) = w;
  }
}

template <int KS>
DI f32x16 mm64t(const u16* AT, int lda, const u16* Bt, int ldb, int wm, int wn, int r, int h, int lane) {
  typedef __attribute__((address_space(3))) const char* lds_cptr;
  typedef short v4i16_t __attribute__((ext_vector_type(4)));
  const lds_cptr base = (lds_cptr)AT + ((lane & 15) >> 2) * (lda * 2) + (wm * 32 + ((lane >> 4) & 1) * 16) * 2 + (lane & 3) * 8;
  f32x16 acc = zero16();
#pragma unroll
  for (int s = 0; s < KS; ++s) {
    s16x4 lo = __builtin_bit_cast(s16x4, __builtin_amdgcn_ds_read_tr16_b64_v4i16((__attribute__((address_space(3))) v4i16_t*)(base + (16 * s + 8 * h) * (lda * 2))));
    s16x4 hi = __builtin_bit_cast(s16x4, __builtin_amdgcn_ds_read_tr16_b64_v4i16((__attribute__((address_space(3))) v4i16_t*)(base + (16 * s + 8 * h + 4) * (lda * 2))));
    bf16x8 a = __builtin_shufflevector(lo, hi, 0, 1, 2, 3, 4, 5, 6, 7);
    bf16x8 b = *(const bf16x8*)(Bt + (wn * 32 + r) * ldb + s * 16 + 8 * h);
    acc = MFMA(a, b, acc);
  }
  return acc;
}

template <int KS, bool ATR, bool BTR>
DI f32x16 mm64x(const u16* A, int lda, const u16* B, int ldb, int wm, int wn, int r, int h, int lane) {
  typedef __attribute__((address_space(3))) const char* lds_cptr;
  typedef short v4i16_t __attribute__((ext_vector_type(4)));
  const int sub = ((lane & 15) >> 2), cb = ((lane >> 4) & 1) * 16, pb = (lane & 3) * 8;
  const lds_cptr abase = (lds_cptr)A + sub * (lda * 2) + (wm * 32 + cb) * 2 + pb;
  const lds_cptr bbase = (lds_cptr)B + sub * (ldb * 2) + (wn * 32 + cb) * 2 + pb;
  f32x16 acc = zero16();
#pragma unroll
  for (int s = 0; s < KS; ++s) {
    bf16x8 a, b;
    if (ATR) {
      s16x4 lo = __builtin_bit_cast(s16x4, __builtin_amdgcn_ds_read_tr16_b64_v4i16((__attribute__((address_space(3))) v4i16_t*)(abase + (16 * s + 8 * h) * (lda * 2))));
      s16x4 hi = __builtin_bit_cast(s16x4, __builtin_amdgcn_ds_read_tr16_b64_v4i16((__attribute__((address_space(3))) v4i16_t*)(abase + (16 * s + 8 * h + 4) * (lda * 2))));
      a = __builtin_shufflevector(lo, hi, 0, 1, 2, 3, 4, 5, 6, 7);
    } else {
      a = *(const bf16x8*)(A + (wm * 32 + r) * lda + s * 16 + 8 * h);
    }
    if (BTR) {
      s16x4 lo = __builtin_bit_cast(s16x4, __builtin_amdgcn_ds_read_tr16_b64_v4i16((__attribute__((address_space(3))) v4i16_t*)(bbase + (16 * s + 8 * h) * (ldb * 2))));
      s16x4 hi = __builtin_bit_cast(s16x4, __builtin_amdgcn_ds_read_tr16_b64_v4i16((__attribute__((address_space(3))) v4i16_t*)(bbase + (16 * s + 8 * h + 4) * (ldb * 2))));
      b = __builtin_shufflevector(lo, hi, 0, 1, 2, 3, 4, 5, 6, 7);
    } else {
      b = *(const bf16x8*)(B + (wn * 32 + r) * ldb + s * 16 + 8 * h);
    }
    acc = MFMA(a, b, acc);
  }
  return acc;
}
DI void st8s(u16* dst, const uint4& v, float f) {
  uint4 o;
  o.x = pack2(bflo(v.x) * f, bfhi(v.x) * f); o.y = pack2(bflo(v.y) * f, bfhi(v.y) * f);
  o.z = pack2(bflo(v.z) * f, bfhi(v.z) * f); o.w = pack2(bflo(v.w) * f, bfhi(v.w) * f);
  *(uint4*)dst = o;
}

DI void dn_chain(const Params& p, int chain, char* lds) {
  int tid_ = VTID;
  asm volatile("" : "+v"(tid_));
  const int tid = tid_, wave = tid >> 6, lane = tid & 63, r = lane & 31, h = lane >> 5;
  const int wm = wave >> 1, wn = wave & 1;
  const int b = chain >> 3, hh = (chain >> 1) & 3, dir = chain & 1;
  u16* kA = (u16*)lds;
  u16* St = kA + 64 * LS;
  u16* R1 = St + 64 * LS;
  u16* R2 = R1 + 64 * LS;
  u16* R3 = R2 + 64 * LS;
  u16* R4 = R3 + 64 * LS;
  u16* R5 = R4 + 64 * LS;
  float* gc = (float*)(R5 + 64 * LS);
  float* bt = gc + 64;
  const u16* QKVB = (const u16*)(p.ws + O_QKVB);
  const float* G2 = (const float*)(p.ws + O_G2);
  u16* OUT = dir ? (u16*)(p.ws + O_OB) : (u16*)(p.ws + O_ACT) + 256;
  const int opitch = dir ? 256 : AP;
  __syncthreads();
  for (int e = tid; e < 64 * LS / 2; e += 256) ((u32*)St)[e] = 0u;
  f32x16 S = zero16();
  const int lc = tid >> 3, lp = (tid & 7) * 8;
  auto rowof = [&](int n, int c) -> int {
    int cn, base, len;
    if (n < 4) { cn = n; base = NLAT + b * LC; len = LC; } else { cn = n - 4; base = b * TT; len = TT; }
    int pos = cn * 64 + c;
    return base + (dir ? len - 1 - pos : pos);
  };
  uint4 pk0, pk1, pq0, pq1, pv0, pv1;
  float pg = 0.f, pb = 0.f;
#define DN_LOAD(n)                                                                      \
  {                                                                                     \
    const u16* s0_ = QKVB + (size_t)rowof((n), lc) * 768 + hh * 64 + lp;                \
    const u16* s1_ = QKVB + (size_t)rowof((n), lc + 32) * 768 + hh * 64 + lp;           \
    pq0 = *(const uint4*)s0_; pk0 = *(const uint4*)(s0_ + 256); pv0 = *(const uint4*)(s0_ + 512); \
    pq1 = *(const uint4*)s1_; pk1 = *(const uint4*)(s1_ + 256); pv1 = *(const uint4*)(s1_ + 512); \
    if (tid < 64) {                                                                     \
      const float* g_ = G2 + (size_t)rowof((n), tid) * 16 + dir * 4 + hh;               \
      pg = g_[0]; pb = g_[8];                                                           \
    }                                                                                   \
  }
  DN_LOAD(0);
  for (int n = 0; n < 68; ++n) {
    const uint4 ck0 = pk0, ck1 = pk1, cq0 = pq0, cq1 = pq1, cv0 = pv0, cv1 = pv1;
    float cgv = pg, cbv = pb;
    __syncthreads();
    if (tid < 64) {
      float v = cgv;
#pragma unroll
      for (int o = 1; o < 64; o <<= 1) { float t = __shfl_up(v, o); if (lane >= o) v += t; }
      gc[tid] = v; bt[tid] = cbv;
    }
    *(uint4*)(kA + lc * LS + lp) = ck0;
    *(uint4*)(kA + (lc + 32) * LS + lp) = ck1;
    if (n + 1 < 68) DN_LOAD(n + 1);
    __syncthreads();
    const float gl = gc[63];
    f32x16 T;
    {
      f32x16 kk = mm64<4>(kA, LS, kA, LS, wm, wn, r, h);
      const int s = wn * 32 + r;
      const float gs = gc[s];
#pragma unroll
      for (int g = 0; g < 16; ++g) {
        int c = wm * 32 + crow(g, h);
        float v = (s < c) ? bt[c] * kk[g] * __expf(gc[c] - gs) : 0.f;
        kk[g] = v;
        T[g] = (c == s) ? 1.f : (((c >> 1) == (s >> 1)) ? -v : 0.f);
      }
      st_transp(R1, LS, kk, wm, wn, r, h);
      st_transp(R2, LS, T, wm, wn, r, h);
    }
    __syncthreads();
    for (int k = 1; k < 6; ++k) {
      f32x16 M = mm64t<4>(R1, LS, R2, LS, wm, wn, r, h, lane);
      st_transp(R4, LS, M, wm, wn, r, h);
      __syncthreads();
      f32x16 X = mm64t<4>(R2, LS, R4, LS, wm, wn, r, h, lane);
      {
        const int s = wn * 32 + r;
#pragma unroll
        for (int g = 0; g < 16; ++g) {
          int c = wm * 32 + crow(g, h);
          if ((c >> (k + 1)) == (s >> (k + 1)) && (c >> k) != (s >> k)) T[g] -= X[g];
        }
      }
      __syncthreads();
      st_transp(R2, LS, T, wm, wn, r, h);
      __syncthreads();
    }
    {
      const float fb0 = bt[lc], fk0 = fb0 * __expf(gc[lc]);
      const float fb1 = bt[lc + 32], fk1 = fb1 * __expf(gc[lc + 32]);
      st8s(R1 + lc * LS + lp, ck0, fk0);
      st8s(R1 + (lc + 32) * LS + lp, ck1, fk1);
      st8s(R3 + lc * LS + lp, cv0, fb0);
      st8s(R3 + (lc + 32) * LS + lp, cv1, fb1);
    }
    __syncthreads();
    f32x16 W = mm64x<4, true, true>(R2, LS, R1, LS, wm, wn, r, h, lane);
    f32x16 U = mm64x<4, true, true>(R2, LS, R3, LS, wm, wn, r, h, lane);
    st_transp(R4, LS, W, wm, wn, r, h);
    __syncthreads();
    {
      f32x16 ws = mm64t<4>(R4, LS, St, LS, wm, wn, r, h, lane);
#pragma unroll
      for (int g = 0; g < 16; ++g) U[g] -= ws[g];
      st_transp(R1, LS, U, wm, wn, r, h);
    }
    *(uint4*)(R2 + lc * LS + lp) = cq0;
    *(uint4*)(R2 + (lc + 32) * LS + lp) = cq1;
    st8s(R5 + lc * LS + lp, ck0, __expf(gl - gc[lc]));
    st8s(R5 + (lc + 32) * LS + lp, ck1, __expf(gl - gc[lc + 32]));
    __syncthreads();
    {
      f32x16 qk = mm64<4>(R2, LS, kA, LS, wm, wn, r, h);
      const int s = wn * 32 + r;
      const float gs = gc[s];
#pragma unroll
      for (int g = 0; g < 16; ++g) {
        int c = wm * 32 + crow(g, h);
        qk[g] = (s <= c) ? qk[g] * __expf(gc[c] - gs) : 0.f;
      }
      st_transp(R3, LS, qk, wm, wn, r, h);
    }
    __syncthreads();
    {
      f32x16 o1 = mm64<4>(R2, LS, St, LS, wm, wn, r, h);
      f32x16 o2 = mm64t<4>(R3, LS, R1, LS, wm, wn, r, h, lane);
      f32x16 sn = mm64x<4, true, false>(R5, LS, R1, LS, wm, wn, r, h, lane);
      const float egl = __expf(gl);
#pragma unroll
      for (int g = 0; g < 16; ++g) {
        int c = wm * 32 + crow(g, h);
        float ov = o1[g] * __expf(gc[c]) + o2[g];
        OUT[(size_t)rowof(n, c) * opitch + hh * 64 + wn * 32 + r] = f2bf(ov);
        S[g] = S[g] * egl + sn[g];
      }
    }
    __syncthreads();
    st_transp(St, LS, S, wm, wn, r, h);
  }
}

DI void ret_chain(const Params& p, int layer, int chain, char* lds) {
  int tid_ = VTID;
  asm volatile("" : "+v"(tid_));
  const int tid = tid_, wave = tid >> 6, lane = tid & 63, r = lane & 31, h = lane >> 5;
  const int wm = wave >> 1, wn = wave & 1;
  const int b = chain >> 3, hh = (chain >> 1) & 3, dir = chain & 1;
  constexpr int L4 = 40;
  u16* qA = (u16*)lds;
  u16* kA = qA + 64 * L4;
  u16* ks = kA + 64 * L4;
  u16* vs = ks + 64 * LS;
  u16* QK = vs + 64 * LS;
  u16* Rt = QK + 64 * LS;
  const u16* QC = (const u16*)(p.ws + O_QC);
  const u16* KC = (const u16*)(p.ws + O_KC);
  const u16* Z = (const u16*)(p.ws + O_Z);
  u16* OUT = dir ? (u16*)(p.ws + O_ORB) : (u16*)(p.ws + O_ACT) + 512;
  const int opitch = dir ? 256 : AP;
  const int lc = tid >> 2, lp4 = (tid & 3) * 8;
  const int vc = tid >> 3, vp = (tid & 7) * 8;
  const float lg = log1pf(-expf(p.ret_l1m[layer * 8 + dir * 4 + hh]));
  f32x16 R = zero16();
  auto rowof = [&](int n, int c) -> int {
    int cn, base, len;
    if (n < 4) { cn = n; base = NLAT + b * LC; len = LC; } else { cn = n - 4; base = b * TT; len = TT; }
    int pos = cn * 64 + c;
    return base + (dir ? len - 1 - pos : pos);
  };
  uint4 pq, pk, pv0, pv1;
#define RET_LOAD(n)                                                                                   \
  {                                                                                                   \
    const int row_ = rowof((n), lc);                                                                  \
    pq = *(const uint4*)(QC + (size_t)row_ * 128 + hh * 32 + lp4);                                    \
    pk = *(const uint4*)(KC + (size_t)row_ * 128 + hh * 32 + lp4);                                    \
    pv0 = *(const uint4*)(Z + (size_t)rowof((n), vc) * ZW + C_CV + hh * 64 + vp);                     \
    pv1 = *(const uint4*)(Z + (size_t)rowof((n), vc + 32) * ZW + C_CV + hh * 64 + vp);                \
  }
  RET_LOAD(0);
  for (int n = 0; n < 68; ++n) {
    __syncthreads();
    *(uint4*)(qA + lc * L4 + lp4) = pq;
    *(uint4*)(kA + lc * L4 + lp4) = pk;
    st8s(ks + lc * L4 + lp4, pk, __expf((float)(63 - lc) * lg));
    *(uint4*)(vs + vc * LS + vp) = pv0;
    *(uint4*)(vs + (vc + 32) * LS + vp) = pv1;
    if (wm == 0) st_transp(Rt, L4, R, wm, wn, r, h);
    if (n + 1 < 68) RET_LOAD(n + 1);
    __syncthreads();
    {
      f32x16 qk = mm64<2>(qA, L4, kA, L4, wm, wn, r, h);
      const int s = wn * 32 + r;
#pragma unroll
      for (int g = 0; g < 16; ++g) {
        int c = wm * 32 + crow(g, h);
        qk[g] = (s <= c) ? qk[g] * __expf((float)(c - s) * lg) : 0.f;
      }
      st_transp(QK, LS, qk, wm, wn, r, h);
    }
    __syncthreads();
    {
      f32x16 o1 = mm64x<4, true, true>(QK, LS, vs, LS, wm, wn, r, h, lane);
      f32x16 o2 = mm64<2>(qA, L4, Rt, L4, wm, wn, r, h);
      const float gch = __expf(64.f * lg);
#pragma unroll
      for (int g = 0; g < 16; ++g) {
        int c = wm * 32 + crow(g, h);
        float ov = o1[g] + __expf((float)(c + 1) * lg) * o2[g];
        OUT[(size_t)rowof(n, c) * opitch + hh * 64 + wn * 32 + r] = f2bf(ov);
      }
      if (wm == 0) {
        f32x16 rn = mm64x<4, true, true>(ks, L4, vs, LS, wm, wn, r, h, lane);
#pragma unroll
        for (int g = 0; g < 16; ++g) R[g] = R[g] * gch + rn[g];
      }
    }
  }
}

DI void pair_finalize(const Params& p, int layer, int kind, int b, int hh) {
  int ltid_ = threadIdx.x;
  asm volatile("" : "+v"(ltid_));
  const int ltid = ltid_;
  const u16* Z = (const u16*)(p.ws + O_Z);
  const u16* BW = (const u16*)(p.ws + (kind ? O_ORB : O_OB));
  u16* act = (u16*)(p.ws + O_ACT);
  const int acol = kind ? 512 : 256, zcol = kind ? C_CG : C_BZ;
  const float* gp = kind ? p.ret_norm_g + layer * 256 + hh * 64 + (ltid & 7) * 8 : p.dn_norm_g + layer * 64 + (ltid & 7) * 8;
  const float4 g0 = *(const float4*)gp, g1 = *(const float4*)(gp + 4);
  const float gg[8] = {g0.x, g0.y, g0.z, g0.w, g1.x, g1.y, g1.z, g1.w};
  const int c8 = hh * 8 + (ltid & 7);
  __syncthreads();
#pragma unroll 1
  for (int j0 = 0; j0 < 68; j0 += 4) {
    u32x4 a[4], bw[4], z[4];
#pragma unroll
    for (int u = 0; u < 4; ++u) {
      const int rr = (ltid + 512 * (j0 + u)) >> 3;
      const int row = rr < TT ? b * TT + rr : NLAT + b * LC + (rr - TT);
      a[u] = ldg16(act + (size_t)row * AP + acol + c8 * 8);
      bw[u] = ldg16(BW + (size_t)row * 256 + c8 * 8);
      z[u] = ldg16(Z + (size_t)row * ZW + zcol + c8 * 8);
    }
#pragma unroll
    for (int u = 0; u < 4; ++u) {
      const int rr = (ltid + 512 * (j0 + u)) >> 3;
      const int row = rr < TT ? b * TT + rr : NLAT + b * LC + (rr - TT);
      float fa[8], fb[8], fz[8], o[8];
      unpack8(a[u], fa); unpack8(bw[u], fb); unpack8(z[u], fz);
      float sm = 0.f;
#pragma unroll
      for (int e = 0; e < 8; ++e) { o[e] = fa[e] + fb[e]; sm += o[e]; }
      sm += __shfl_xor(sm, 1); sm += __shfl_xor(sm, 2); sm += __shfl_xor(sm, 4);
      const float mean = kind ? sm * (1.f / 64.f) : 0.f;
      float ss = 0.f;
#pragma unroll
      for (int e = 0; e < 8; ++e) { o[e] -= mean; ss += o[e] * o[e]; }
      ss += __shfl_xor(ss, 1); ss += __shfl_xor(ss, 2); ss += __shfl_xor(ss, 4);
      const float rn = rsqrtf(ss * (1.f / 64.f) + 1e-6f);
#pragma unroll
      for (int e = 0; e < 8; ++e) o[e] = o[e] * rn * gg[e] * siluf(fz[e]);
      *(u32x4*)(act + (size_t)row * AP + acol + c8 * 8) = pack8(o);
    }
  }
}

DI void mixer_phase(const Params& p, int layer, char* lds, char* lds_all, int* s_tile) {
  int* cnt = (int*)(p.ws + O_CNT) + layer;
  const int nattn = layer == 0 ? 2176 : 2048;
  const int nwork = 128 + 128 + 2 * nattn;
  const int total = nwork + (layer == 0 ? 5352 : 0);
  for (;;) {
    __syncthreads();
    if (threadIdx.x == 0) *s_tile = atomicAdd(cnt, 1);
    __syncthreads();
    const int t = 2 * (*s_tile) + VHALF;
    if (t >= total) break;
    if (t < 128) { dn_chain(p, t, lds); pair_finalize(p, layer, 0, t >> 3, (t >> 1) & 3); }
    else if (t < 256) { ret_chain(p, layer, t - 128, lds); pair_finalize(p, layer, 1, (t - 128) >> 3, ((t - 128) >> 1) & 3); }
    else if (t < 256 + nattn) mla_attn(p, t - 256, lds_all);
    else if (t < nwork) swa_attn(p, layer, t - 256 - nattn, lds_all);
    else wtile_deferred(p, t - nwork, lds);
  }
}

DI void dn_finalize(const Params& p, int layer, int nrows) {
  int tid_ = VTID;
  asm volatile("" : "+v"(tid_));
  const int tid = tid_;
  const u16* OB = (const u16*)(p.ws + O_OB);
  const u16* Z = (const u16*)(p.ws + O_Z);
  u16* act = (u16*)(p.ws + O_ACT);
  const int ntask = nrows * 32, stride = VG * 256;
  for (int id0 = VB * 256 + tid; id0 < ntask; id0 += 4 * stride) {
    u32x4 a[4], b[4], z[4];
#pragma unroll
    for (int u = 0; u < 4; ++u) {
      const int id = id0 + u * stride;
      const bool ok = id < ntask;
      const int row = ok ? (id >> 5) : 0, c8 = id & 31;
      a[u] = ldg16(act + (size_t)row * AP + 256 + c8 * 8);
      b[u] = ldg16(OB + (size_t)row * 256 + c8 * 8);
      z[u] = ldg16(Z + (size_t)row * ZW + C_BZ + c8 * 8);
    }
#pragma unroll
    for (int u = 0; u < 4; ++u) {
      const int id = id0 + u * stride;
      const int row = id >> 5, c8 = id & 31;
      float fa[8], fb[8], fz[8], o[8];
      unpack8(a[u], fa); unpack8(b[u], fb); unpack8(z[u], fz);
      float ss = 0.f;
#pragma unroll
      for (int e = 0; e < 8; ++e) { o[e] = fa[e] + fb[e]; ss += o[e] * o[e]; }
      ss += __shfl_xor(ss, 1); ss += __shfl_xor(ss, 2); ss += __shfl_xor(ss, 4);
      const float rn = rsqrtf(ss * (1.f / 64.f) + 1e-6f);
      const float4 g0 = *(const float4*)(p.dn_norm_g + layer * 64 + (c8 & 7) * 8), g1 = *(const float4*)(p.dn_norm_g + layer * 64 + (c8 & 7) * 8 + 4);
      const float gg[8] = {g0.x, g0.y, g0.z, g0.w, g1.x, g1.y, g1.z, g1.w};
#pragma unroll
      for (int e = 0; e < 8; ++e) o[e] = o[e] * rn * gg[e] * siluf(fz[e]);
      if (id < ntask) *(u32x4*)(act + (size_t)row * AP + 256 + c8 * 8) = pack8(o);
    }
  }
  const u16* ORB = (const u16*)(p.ws + O_ORB);
  for (int id0 = VB * 256 + tid; id0 < ntask; id0 += 4 * stride) {
    u32x4 a[4], b[4], z[4];
#pragma unroll
    for (int u = 0; u < 4; ++u) {
      const int id = id0 + u * stride;
      const bool ok = id < ntask;
      const int row = ok ? (id >> 5) : 0, c8 = id & 31;
      a[u] = ldg16(act + (size_t)row * AP + 512 + c8 * 8);
      b[u] = ldg16(ORB + (size_t)row * 256 + c8 * 8);
      z[u] = ldg16(Z + (size_t)row * ZW + C_CG + c8 * 8);
    }
#pragma unroll
    for (int u = 0; u < 4; ++u) {
      const int id = id0 + u * stride;
      const int row = id >> 5, c8 = id & 31;
      float fa[8], fb[8], fz[8], o[8];
      unpack8(a[u], fa); unpack8(b[u], fb); unpack8(z[u], fz);
      float sm = 0.f;
#pragma unroll
      for (int e = 0; e < 8; ++e) { o[e] = fa[e] + fb[e]; sm += o[e]; }
      sm += __shfl_xor(sm, 1); sm += __shfl_xor(sm, 2); sm += __shfl_xor(sm, 4);
      const float mean = sm * (1.f / 64.f);
      float ss = 0.f;
#pragma unroll
      for (int e = 0; e < 8; ++e) { o[e] -= mean; ss += o[e] * o[e]; }
      ss += __shfl_xor(ss, 1); ss += __shfl_xor(ss, 2); ss += __shfl_xor(ss, 4);
      const float rn = rsqrtf(ss * (1.f / 64.f) + 1e-6f);
      const float4 g0 = *(const float4*)(p.ret_norm_g + layer * 256 + c8 * 8), g1 = *(const float4*)(p.ret_norm_g + layer * 256 + c8 * 8 + 4);
      const float gg[8] = {g0.x, g0.y, g0.z, g0.w, g1.x, g1.y, g1.z, g1.w};
#pragma unroll
      for (int e = 0; e < 8; ++e) o[e] = o[e] * rn * gg[e] * siluf(fz[e]);
      if (id < ntask) *(u32x4*)(act + (size_t)row * AP + 512 + c8 * 8) = pack8(o);
    }
  }
}

DI void gbar(const Params& p, unsigned& target) {
  unsigned* bar = (unsigned*)(p.ws + O_CNT + 128);
  target += gridDim.x;
  __syncthreads();
  if (threadIdx.x == 0) {
    __builtin_amdgcn_fence(__ATOMIC_RELEASE, "agent");
    __hip_atomic_fetch_add(bar, 1u, __ATOMIC_RELAXED, __HIP_MEMORY_SCOPE_AGENT);
    while (__hip_atomic_load(bar, __ATOMIC_RELAXED, __HIP_MEMORY_SCOPE_AGENT) < target) __builtin_amdgcn_s_sleep(2);
    __builtin_amdgcn_fence(__ATOMIC_ACQUIRE, "agent");
  }
  __syncthreads();
}

__global__ void __launch_bounds__(512, 2) fwd_megakernel(Params p) {
  __shared__ __attribute__((aligned(16))) char lds_all[2 * LDS_BYTES];
  __shared__ int s_tile;
  char* lds = lds_all + VHALF * LDS_BYTES;
  cg::grid_group grid = cg::this_grid();
  if (p.ws == nullptr) grid.sync();
  unsigned bt = 0;
  phase0a(p, lds);
  gbar(p, bt);
  modulate_rows(p, 0, ROWS);
  gbar(p, bt);
  for (int layer = 0; layer < 2; ++layer) {
    const int nrows = layer == 0 ? ROWS : NLAT;
    gemm_phase(p, layer, 0, ROWS, lds_all);
    gbar(p, bt);
    prep_phase(p, layer, lds);
    gbar(p, bt);
    mixer_phase(p, layer, lds, lds_all, &s_tile);
    gbar(p, bt);
    gemm_phase(p, layer, 1, nrows, lds_all);
    gbar(p, bt);
    ln_rows(p, p.ln1_g + layer * DM, p.ln1_b + layer * DM, nrows, layer, 3, true);
    gbar(p, bt);
    gemm_phase(p, layer, 2, nrows, lds_all);
    gbar(p, bt);
    gemm_phase(p, layer, 3, nrows, lds_all);
    gbar(p, bt);
    ln_rows(p, p.ln2_g + layer * DM, p.ln2_b + layer * DM, nrows, layer == 0 ? 1 : 0, 0, layer == 0);
    if (layer == 0) gbar(p, bt);
  }
}

extern "C" void kernel_launch(void* const* d_in, const int* in_sizes, int n_in, void* d_out, int out_size, void* d_ws,
                              size_t ws_size, hipStream_t stream) {
  static int grid_blocks = 0;
  if (!grid_blocks) {
    int dev = 0, cus = 0, per_cu = 0;
    hipGetDevice(&dev);
    hipDeviceGetAttribute(&cus, hipDeviceAttributeMultiprocessorCount, dev);
    hipOccupancyMaxActiveBlocksPerMultiprocessor(&per_cu, fwd_megakernel, 512, 0);
    if (per_cu < 1) per_cu = 1;
    if (per_cu > 1) per_cu = 1;
    grid_blocks = cus * per_cu;
    if (ws_size < WS_END) fprintf(stderr, "kernel_launch: workspace too small: %zu < %zu\n", ws_size, (size_t)WS_END);
  }
  Params p{};
  const float** f = (const float**)&p;
  for (int i = 0; i < 25; ++i) f[i] = (const float*)d_in[i];
  p.out = (float*)d_out;
  p.ws = (unsigned char*)d_ws;
  hipMemsetAsync((char*)d_ws + O_CNT, 0, 256, stream);
  void* args[] = {&p};
  hipError_t e = hipLaunchCooperativeKernel((void*)fwd_megakernel, dim3(grid_blocks), dim3(512), args, 0, stream);
  if (e != hipSuccess) fprintf(stderr, "cooperative launch failed: %s (grid %d)\n", hipGetErrorString(e), grid_blocks);
}
```

```cpp
#include <hip/hip_runtime.h>
#include <hip/hip_cooperative_groups.h>
#include <cstdio>
namespace cg = cooperative_groups;

#define DI __device__ __forceinline__
typedef unsigned short u16;
typedef unsigned int u32;
using bf16x8 = __attribute__((ext_vector_type(8))) short;
using s16x4 = __attribute__((ext_vector_type(4))) short;
using f32x16 = __attribute__((ext_vector_type(16))) float;
typedef __bf16 bfv2 __attribute__((ext_vector_type(2)));
typedef float flv2 __attribute__((ext_vector_type(2)));
#define MFMA(a, b, c) __builtin_amdgcn_mfma_f32_32x32x16_bf16((a), (b), (c), 0, 0, 0)
#define VHALF ((int)__builtin_amdgcn_readfirstlane((int)(threadIdx.x >> 8)))
#define VTID ((int)(threadIdx.x & 255))
#define VB ((int)(blockIdx.x * 2 + VHALF))
#define VG ((int)(gridDim.x * 2))

constexpr int NB = 16, TT = 4096, LC = 256, DM = 1024, NLAT = NB * TT, NCTX = NB * LC, ROWS = NLAT + NCTX;
constexpr int ZW = 2816, DFF = 4096, NPOS = TT + LC;
constexpr int AP = 1152;
constexpr int WP = 1152;
constexpr int WP2 = 4224;
constexpr int HP = 4224;
constexpr int KVP = 576;
constexpr float LOG2E = 1.4426950408889634f;
constexpr float DN_ALPHA = 1.4142135623730951f;
constexpr int C_AQ = 0, C_AK = 256, C_AV = 384, C_BQKV = 512, C_BZ = 1280, C_BAB = 1536, C_CQ = 1552, C_CK = 1680,
              C_CV = 1808, C_CG = 2064, C_DCQ = 2320, C_DCKV = 2576, C_DKR = 2704;

constexpr size_t al256(size_t x) { return (x + 255) & ~size_t(255); }
constexpr size_t SZ_WIN = (size_t)ZW * WP * 2, SZ_WOUT = (size_t)DM * WP * 2, SZ_WFF = (size_t)DFF * WP * 2,
                 SZ_WUQ = 384 * 256 * 2, SZ_WUKV = 512 * 128 * 2;
constexpr size_t O_WIN = 0;
constexpr size_t O_WOUT = O_WIN + 2 * SZ_WIN;
constexpr size_t O_WFF1 = O_WOUT + 2 * SZ_WOUT;
constexpr size_t O_WFF2 = O_WFF1 + 2 * SZ_WFF;
constexpr size_t O_WUQ = O_WFF2 + 2 * SZ_WFF;
constexpr size_t O_WUKV = O_WUQ + 2 * SZ_WUQ;
constexpr size_t O_MOD = O_WUKV + 2 * SZ_WUKV;
constexpr size_t O_TAB = al256(O_MOD + 2 * 17 * 6144 * 4);
constexpr size_t O_CNT = O_TAB + (size_t)TT * 64 * 8;
constexpr size_t O_GRAW = O_CNT + 256;
constexpr size_t O_G2 = O_GRAW + (size_t)ROWS * 16 * 4;
constexpr size_t O_XC = O_G2 + (size_t)ROWS * 16 * 4;
constexpr size_t O_ACT = O_XC + (size_t)NCTX * DM * 4;
constexpr size_t O_Z = O_ACT + (size_t)ROWS * AP * 2;
constexpr size_t O_QA = O_Z + (size_t)ROWS * ZW * 2;
constexpr size_t O_KA = O_QA + (size_t)NB * 4 * NPOS * 64 * 2;
constexpr size_t O_QD = O_KA + (size_t)NB * 2 * NPOS * 64 * 2;
constexpr size_t O_KVD = O_QD + (size_t)ROWS * 384 * 2;
constexpr size_t O_KR = O_KVD + (size_t)ROWS * KVP * 2;
constexpr size_t O_QKVB = O_KR + (size_t)ROWS * 32 * 2;
constexpr size_t O_OB = O_QKVB + (size_t)ROWS * 768 * 2;
constexpr size_t O_QC = O_OB + (size_t)ROWS * 256 * 2;
constexpr size_t O_KC = O_QC + (size_t)ROWS * 128 * 2;
constexpr size_t O_ORB = O_KC + (size_t)ROWS * 128 * 2;
constexpr size_t O_ST = O_ORB + (size_t)ROWS * 256 * 2;
constexpr size_t WS_END = O_ST + (size_t)ROWS * 8;
static_assert(O_Z + (size_t)ROWS * HP * 2 <= WS_END, "hid alias");
static_assert((size_t)DM * WP2 * 2 <= SZ_WFF, "ff2 weights");
static_assert(WS_END <= (size_t)1073741824, "workspace");

constexpr int LDS_BYTES = 73728;

struct Params {
  const float *x, *c, *ctx, *c_ctx, *ada_w, *ada_b, *w_in, *swa_sink, *dn_conv_w, *dn_a_log, *dn_dt_bias, *dn_norm_g,
      *ret_l1m, *ret_norm_g, *mla_q_norm, *mla_w_uq, *mla_kv_norm, *mla_w_ukv, *w_out, *ln1_g, *ln1_b, *w_ff1, *w_ff2,
      *ln2_g, *ln2_b;
  float* out;
  unsigned char* ws;
};

DI u16 f2bf(float x) { return __builtin_bit_cast(u16, (__bf16)x); }
DI float bf2f(u16 v) { return __uint_as_float(((u32)v) << 16); }
DI u32 pack2(float a, float b) {
  flv2 f = {a, b};
  bfv2 v = __builtin_convertvector(f, bfv2);
  return __builtin_bit_cast(u32, v);
}
DI float bflo(u32 u) { return __uint_as_float(u << 16); }
DI float bfhi(u32 u) { return __uint_as_float(u & 0xffff0000u); }
DI int crow(int reg, int h) { return (reg & 3) + 8 * (reg >> 2) + 4 * h; }
DI float wave_sum(float v) {
#pragma unroll
  for (int o = 32; o >= 1; o >>= 1) v += __shfl_xor(v, o);
  return v;
}
DI float siluf(float x) { return x / (1.f + __expf(-x)); }
DI f32x16 zero16() {
  f32x16 z;
#pragma unroll
  for (int i = 0; i < 16; ++i) z[i] = 0.f;
  return z;
}

DI void scat8s(u16* base, int stride, const uint4& v, float f) {
  base[0 * stride] = f2bf(bflo(v.x) * f); base[1 * stride] = f2bf(bfhi(v.x) * f);
  base[2 * stride] = f2bf(bflo(v.y) * f); base[3 * stride] = f2bf(bfhi(v.y) * f);
  base[4 * stride] = f2bf(bflo(v.z) * f); base[5 * stride] = f2bf(bfhi(v.z) * f);
  base[6 * stride] = f2bf(bflo(v.w) * f); base[7 * stride] = f2bf(bfhi(v.w) * f);
}
DI void scat8r(u16* base, int stride, const uint4& v) {
  base[0 * stride] = (u16)(v.x & 0xffffu); base[1 * stride] = (u16)(v.x >> 16);
  base[2 * stride] = (u16)(v.y & 0xffffu); base[3 * stride] = (u16)(v.y >> 16);
  base[4 * stride] = (u16)(v.z & 0xffffu); base[5 * stride] = (u16)(v.z >> 16);
  base[6 * stride] = (u16)(v.w & 0xffffu); base[7 * stride] = (u16)(v.w >> 16);
}
DI float sumsq8(const uint4& u) {
  float s = 0.f, a;
  a = bflo(u.x); s += a * a; a = bfhi(u.x); s += a * a;
  a = bflo(u.y); s += a * a; a = bfhi(u.y); s += a * a;
  a = bflo(u.z); s += a * a; a = bfhi(u.z); s += a * a;
  a = bflo(u.w); s += a * a; a = bfhi(u.w); s += a * a;
  return s;
}
typedef u32 u32x4 __attribute__((ext_vector_type(4)));
DI u32x4 ldg16(const u16* p) { return *(const u32x4*)p; }
DI void unpack8(const u32x4& u, float* f) {
  f[0] = bflo(u[0]); f[1] = bfhi(u[0]); f[2] = bflo(u[1]); f[3] = bfhi(u[1]);
  f[4] = bflo(u[2]); f[5] = bfhi(u[2]); f[6] = bflo(u[3]); f[7] = bfhi(u[3]);
}
DI u32x4 pack8(const float* f) {
  u32x4 o;
  o[0] = pack2(f[0], f[1]); o[1] = pack2(f[2], f[3]); o[2] = pack2(f[4], f[5]); o[3] = pack2(f[6], f[7]);
  return o;
}
DI float* xrow(const Params& p, int row) {
  return row < NLAT ? p.out + (size_t)row * DM : (float*)(p.ws + O_XC) + (size_t)(row - NLAT) * DM;
}
DI const float* xrow0(const Params& p, int row) {
  return row < NLAT ? p.x + (size_t)row * DM : p.ctx + (size_t)(row - NLAT) * DM;
}
DI int rowb(int row) { return row < NLAT ? (row >> 12) : 16; }

constexpr int CSL = 132;
constexpr int GS = 72;
template <typename Epi>
DI void gemm_tile(const u16* __restrict__ A, int lda, const u16* __restrict__ Bt, int ldb, int K, char* lds, Epi epi) {
  u16* As = (u16*)lds;
  u16* Bs = As + 256 * GS;
  float* Cs = (float*)lds;
  int tid_ = VTID;
  asm volatile("" : "+v"(tid_));
  const int tid = tid_, wave = tid >> 6, lane = tid & 63, r = lane & 31, h = lane >> 5;
  const int wm = wave >> 1, wn = wave & 1;
  f32x16 acc[4][2];
#pragma unroll
  for (int i = 0; i < 4; ++i)
#pragma unroll
    for (int j = 0; j < 2; ++j) acc[i][j] = zero16();
  const int lrow = tid >> 3, lcol = (tid & 7) * 8;
  const u16* Ap = A + (size_t)lrow * lda + lcol;
  const u16* Bp = Bt + (size_t)lrow * ldb + lcol;
  u16* Aw = As + lrow * GS + lcol;
  u16* Bw = Bs + lrow * GS + lcol;
  u32x4 ra[8], rb[4];
#define GT_LOAD(k0)                                                                 \
  {                                                                                 \
    _Pragma("unroll") for (int i_ = 0; i_ < 8; ++i_) ra[i_] = ldg16(Ap + (size_t)(i_ * 32) * lda + (k0)); \
    _Pragma("unroll") for (int i_ = 0; i_ < 4; ++i_) rb[i_] = ldg16(Bp + (size_t)(i_ * 32) * ldb + (k0)); \
  }
#define GT_STORE()                                                                  \
  {                                                                                 \
    _Pragma("unroll") for (int i_ = 0; i_ < 8; ++i_) *(u32x4*)(Aw + i_ * 32 * GS) = ra[i_]; \
    _Pragma("unroll") for (int i_ = 0; i_ < 4; ++i_) *(u32x4*)(Bw + i_ * 32 * GS) = rb[i_]; \
  }
#define GT_COMPUTE()                                                                              \
  _Pragma("unroll") for (int ks = 0; ks < 4; ++ks) {                                              \
    bf16x8 fa[4], fb[2];                                                                          \
    _Pragma("unroll") for (int i_ = 0; i_ < 4; ++i_)                                              \
      fa[i_] = *(const bf16x8*)(As + (wm * 128 + i_ * 32 + r) * GS + ks * 16 + 8 * h);            \
    _Pragma("unroll") for (int j_ = 0; j_ < 2; ++j_)                                              \
      fb[j_] = *(const bf16x8*)(Bs + (wn * 64 + j_ * 32 + r) * GS + ks * 16 + 8 * h);             \
    _Pragma("unroll") for (int i_ = 0; i_ < 4; ++i_)                                              \
      _Pragma("unroll") for (int j_ = 0; j_ < 2; ++j_) acc[i_][j_] = MFMA(fa[i_], fb[j_], acc[i_][j_]); \
  }
  const int nk = K >> 6;
  GT_LOAD(0);
  for (int kt = 0; kt + 1 < nk; ++kt) {
    __syncthreads();
    GT_STORE();
    __syncthreads();
    GT_LOAD((kt + 1) << 6);
    GT_COMPUTE();
  }
  __syncthreads();
  GT_STORE();
  __syncthreads();
  GT_COMPUTE();
#pragma unroll 1
  for (int half = 0; half < 2; ++half) {
    __syncthreads();
    if (wm == half) {
#pragma unroll
      for (int i = 0; i < 4; ++i)
#pragma unroll
        for (int j = 0; j < 2; ++j)
#pragma unroll
          for (int g = 0; g < 16; ++g) Cs[(i * 32 + crow(g, h)) * CSL + wn * 64 + j * 32 + r] = acc[i][j][g];
    }
    __syncthreads();
    epi(half);
  }
}

constexpr int CSW = 264;
template <typename Epi>
DI void gemm_tile512(const u16* __restrict__ A, int lda, const u16* __restrict__ Bt, int ldb, int K, char* lds_all, Epi epi) {
  constexpr int STG = 2 * 256 * GS;
  u16* S0 = (u16*)lds_all;
  float* Cs = (float*)lds_all;
  int tid_ = threadIdx.x;
  asm volatile("" : "+v"(tid_));
  const int tid = tid_, wave = tid >> 6, lane = tid & 63, r = lane & 31, h = lane >> 5;
  const int wm = wave >> 2, wn = wave & 3;
  f32x16 acc[4][2];
#pragma unroll
  for (int i = 0; i < 4; ++i)
#pragma unroll
    for (int j = 0; j < 2; ++j) acc[i][j] = zero16();
  const int lrow = tid >> 3, lcol = (tid & 7) * 8;
  const u16* Ap = A + (size_t)lrow * lda + lcol;
  const u16* Bp = Bt + (size_t)lrow * ldb + lcol;
  u16* Sw = S0 + lrow * GS + lcol;
  u32x4 ra[4], rb[4];
#define G5_LOAD(k0)                                                                 \
  {                                                                                 \
    _Pragma("unroll") for (int i_ = 0; i_ < 4; ++i_) ra[i_] = ldg16(Ap + (size_t)(i_ * 64) * lda + (k0)); \
    _Pragma("unroll") for (int i_ = 0; i_ < 4; ++i_) rb[i_] = ldg16(Bp + (size_t)(i_ * 64) * ldb + (k0)); \
  }
#define G5_STORE(s)                                                                 \
  {                                                                                 \
    _Pragma("unroll") for (int i_ = 0; i_ < 4; ++i_) *(u32x4*)(Sw + (s) * STG + i_ * 64 * GS) = ra[i_]; \
    _Pragma("unroll") for (int i_ = 0; i_ < 4; ++i_) *(u32x4*)(Sw + (s) * STG + 256 * GS + i_ * 64 * GS) = rb[i_]; \
  }
#define G5_COMPUTE(s)                                                                             \
  {                                                                                               \
    __builtin_amdgcn_iglp_opt(1);         \
    const u16* As_ = S0 + (s) * STG;                                                              \
    const u16* Bs_ = As_ + 256 * GS;                                                              \
    _Pragma("unroll") for (int ks = 0; ks < 4; ++ks) {                                            \
      bf16x8 fa[4], fb[2];                                                                        \
      _Pragma("unroll") for (int i_ = 0; i_ < 4; ++i_)                                            \
        fa[i_] = *(const bf16x8*)(As_ + (wm * 128 + i_ * 32 + r) * GS + ks * 16 + 8 * h);         \
      _Pragma("unroll") for (int j_ = 0; j_ < 2; ++j_)                                            \
        fb[j_] = *(const bf16x8*)(Bs_ + (wn * 64 + j_ * 32 + r) * GS + ks * 16 + 8 * h);          \
      _Pragma("unroll") for (int i_ = 0; i_ < 4; ++i_)                                            \
        _Pragma("unroll") for (int j_ = 0; j_ < 2; ++j_) acc[i_][j_] = MFMA(fa[i_], fb[j_], acc[i_][j_]); \
    }                                                                                             \
  }
  const int nk = K >> 6;
  __syncthreads();
  G5_LOAD(0);
  G5_STORE(0);
  G5_LOAD(64);
  __syncthreads();
  for (int kt = 0; kt + 2 < nk; ++kt) {
    const int cur = kt & 1;
    G5_COMPUTE(cur);
    G5_STORE(cur ^ 1);
    G5_LOAD((kt + 2) << 6);
    __syncthreads();
  }
  {
    const int cur = (nk - 2) & 1;
    G5_COMPUTE(cur);
    G5_STORE(cur ^ 1);
    __syncthreads();
    G5_COMPUTE(cur ^ 1);
  }
#pragma unroll 1
  for (int half = 0; half < 2; ++half) {
    __syncthreads();
    if (wm == half) {
#pragma unroll
      for (int i = 0; i < 4; ++i)
#pragma unroll
        for (int j = 0; j < 2; ++j)
#pragma unroll
          for (int g = 0; g < 16; ++g) Cs[(i * 32 + crow(g, h)) * CSW + wn * 64 + j * 32 + r] = acc[i][j][g];
    }
    __syncthreads();
    epi(half);
  }
}

DI void wtrans_tile(const float* __restrict__ src, int K, int N, u16* __restrict__ dst, int ldw, int tk, int tn,
                    const float* __restrict__ kscale, char* lds) {
  float* t = (float*)lds;
  int tid_ = VTID;
  asm volatile("" : "+v"(tid_));
  const int tid = tid_, j = tid & 63, i0 = tid >> 6;
  const int k0 = tk * 64, n0 = tn * 64;
  __syncthreads();
#pragma unroll
  for (int q = 0; q < 16; ++q) {
    int i = i0 + 4 * q;
    float v = (n0 + j < N) ? src[(size_t)(k0 + i) * N + n0 + j] : 0.f;
    if (kscale) v *= kscale[k0 + i];
    t[i * 65 + j] = v;
  }
  __syncthreads();
#pragma unroll 4
  for (int q = 0; q < 16; ++q) {
    int jj = i0 + 4 * q;
    dst[(size_t)(n0 + jj) * ldw + k0 + j] = f2bf(t[j * 65 + jj]);
  }
}

DI void ada_tile(const Params& p, int layer, int cg64, char* lds) {
  float* sc = (float*)lds;
  int tid_ = VTID;
  asm volatile("" : "+v"(tid_));
  const int tid = tid_;
  __syncthreads();
  for (int e = tid; e < 17 * 1024; e += 256) {
    int bi = e >> 10, k = e & 1023;
    float v = bi < 16 ? p.c[bi * 1024 + k] : p.c_ctx[k];
    sc[e] = siluf(v);
  }
  __syncthreads();
  const int col = tid & 63, kq = tid >> 6;
  const int n = cg64 * 64 + col;
  const float* w = p.ada_w + (size_t)layer * 1024 * 6144 + n;
  float acc[17];
#pragma unroll
  for (int i = 0; i < 17; ++i) acc[i] = 0.f;
#pragma unroll 8
  for (int kk = 0; kk < 256; ++kk) {
    int k = kq * 256 + kk;
    float wv = w[(size_t)k * 6144];
#pragma unroll
    for (int i = 0; i < 17; ++i) acc[i] += sc[i * 1024 + k] * wv;
  }
  __syncthreads();
  float* red = (float*)lds;
#pragma unroll
  for (int i = 0; i < 17; ++i) red[(kq * 17 + i) * 64 + col] = acc[i];
  __syncthreads();
  float* mod = (float*)(p.ws + O_MOD) + (size_t)layer * 17 * 6144;
  for (int e = tid; e < 17 * 64; e += 256) {
    int bi = e >> 6, cc = e & 63;
    float s = red[(0 * 17 + bi) * 64 + cc] + red[(1 * 17 + bi) * 64 + cc] + red[(2 * 17 + bi) * 64 + cc] +
              red[(3 * 17 + bi) * 64 + cc];
    int nn = cg64 * 64 + cc;
    mod[bi * 6144 + nn] = s + p.ada_b[layer * 6144 + nn];
  }
}

DI void wtile(const Params& p, int layer, int q, char* lds) {
  if (q < 704) {
    wtrans_tile(p.w_in + (size_t)layer * 1024 * 2736, 1024, 2736, (u16*)(p.ws + O_WIN + layer * SZ_WIN), WP, q / 44, q % 44,
                nullptr, lds);
  } else if (q < 960) {
    q -= 704;
    wtrans_tile(p.w_out + (size_t)layer * 1024 * 1024, 1024, 1024, (u16*)(p.ws + O_WOUT + layer * SZ_WOUT), WP, q / 16, q % 16,
                nullptr, lds);
  } else if (q < 1984) {
    q -= 960;
    wtrans_tile(p.w_ff1 + (size_t)layer * 1024 * 4096, 1024, 4096, (u16*)(p.ws + O_WFF1 + layer * SZ_WFF), WP, q / 64, q % 64,
                nullptr, lds);
  } else if (q < 3008) {
    q -= 1984;
    wtrans_tile(p.w_ff2 + (size_t)layer * 4096 * 1024, 4096, 1024, (u16*)(p.ws + O_WFF2 + layer * SZ_WFF), WP2, q / 16, q % 16,
                nullptr, lds);
  } else if (q < 3032) {
    q -= 3008;
    wtrans_tile(p.mla_w_uq + (size_t)layer * 256 * 384, 256, 384, (u16*)(p.ws + O_WUQ + layer * SZ_WUQ), 256, q / 6, q % 6,
                p.mla_q_norm + layer * 256, lds);
  } else {
    q -= 3032;
    wtrans_tile(p.mla_w_ukv + (size_t)layer * 128 * 512, 128, 512, (u16*)(p.ws + O_WUKV + layer * SZ_WUKV), 128, q / 8, q % 8,
                p.mla_kv_norm + layer * 128, lds);
  }
}
DI void wtile_deferred(const Params& p, int d, char* lds) {
  if (d < 2304) wtile(p, 0, 704 + d, lds);
  else wtile(p, 1, d - 2304, lds);
}

DI void phase0a(const Params& p, char* lds) {
  int tid_ = VTID;
  asm volatile("" : "+v"(tid_));
  const int tid = tid_;
  for (int t = VB; t < 1192; t += VG) {
    if (t < 744) {
      wtile(p, 0, t < 704 ? t : 3008 + (t - 704), lds);
    } else if (t < 936) {
      int q = t - 744;
      ada_tile(p, q / 96, q % 96, lds);
    } else {
      int q = t - 936;
      float2* tab = (float2*)(p.ws + O_TAB);
      for (int e = q * 1024 + tid; e < (q + 1) * 1024; e += 256) {
        int tok = e >> 6, i = e & 63;
        float ang;
        if (i < 32) {
          int f = i & 15;
          float inv = powf(10000.f, -(float)(2 * f) / 32.f);
          ang = (float)(i < 16 ? (tok >> 6) : (tok & 63)) * inv;
        } else if (i < 48) {
          int f = i - 32;
          float inv = powf(10000.f, -(float)(2 * f) / 32.f);
          ang = (float)tok * inv;
        } else {
          int f = (i - 48) & 7;
          float inv = powf(10000.f, -(float)(2 * f) / 16.f);
          ang = (float)((i - 48) < 8 ? (tok >> 6) : (tok & 63)) * inv;
        }
        float sn, cs;
        sincosf(ang, &sn, &cs);
        tab[e] = make_float2(cs, sn);
      }
    }
  }
}

DI void modulate_rows(const Params& p, int layer_mod, int nrows) {
  int tid_ = VTID;
  asm volatile("" : "+v"(tid_));
  const int tid = tid_, wave = tid >> 6, lane = tid & 63;
  const float* mod = (const float*)(p.ws + O_MOD) + (size_t)layer_mod * 17 * 6144;
  u16* act = (u16*)(p.ws + O_ACT);
  const int stride = VG * 4;
  for (int row0 = VB * 4 + wave; row0 < nrows; row0 += 2 * stride) {
    const int row1 = row0 + stride;
    const bool has1 = row1 < nrows;
    float4 va[4], vb[4];
#pragma unroll
    for (int i = 0; i < 4; ++i) {
      va[i] = *(const float4*)(xrow0(p, row0) + (i * 64 + lane) * 4);
      vb[i] = has1 ? *(const float4*)(xrow0(p, row1) + (i * 64 + lane) * 4) : make_float4(0.f, 0.f, 0.f, 0.f);
    }
#pragma unroll
    for (int rr = 0; rr < 2; ++rr) {
      if (rr == 1 && !has1) break;
      const int row = rr ? row1 : row0;
      const float* m = mod + rowb(row) * 6144;
#pragma unroll
      for (int i = 0; i < 4; ++i) {
        int col = (i * 64 + lane) * 4;
        float4 v = rr ? vb[i] : va[i];
        float4 sh = *(const float4*)(m + col);
        float4 sc = *(const float4*)(m + 1024 + col);
        uint2 o;
        o.x = pack2(v.x * (1.f + sc.x) + sh.x, v.y * (1.f + sc.y) + sh.y);
        o.y = pack2(v.z * (1.f + sc.z) + sh.z, v.w * (1.f + sc.w) + sh.w);
        *(uint2*)(act + (size_t)row * AP + col) = o;
      }
    }
  }
}

DI void ln_rows(const Params& p, const float* g, const float* bb, int nrows, int mod_layer, int sh_chunk, bool write_act) {
  int tid_ = VTID;
  asm volatile("" : "+v"(tid_));
  const int tid = tid_, wave = tid >> 6, lane = tid & 63;
  u16* act = (u16*)(p.ws + O_ACT);
  const int stride = VG * 4;
  for (int row0 = VB * 4 + wave; row0 < nrows; row0 += 2 * stride) {
    const int row1 = row0 + stride;
    const bool has1 = row1 < nrows;
    float4 va[4], vb[4];
    float sa = 0.f, sb = 0.f;
#pragma unroll
    for (int i = 0; i < 4; ++i) {
      va[i] = *(const float4*)(xrow(p, row0) + (i * 64 + lane) * 4);
      vb[i] = has1 ? *(const float4*)(xrow(p, row1) + (i * 64 + lane) * 4) : make_float4(0.f, 0.f, 0.f, 0.f);
    }
#pragma unroll
    for (int i = 0; i < 4; ++i) {
      sa += va[i].x + va[i].y + va[i].z + va[i].w;
      sb += vb[i].x + vb[i].y + vb[i].z + vb[i].w;
    }
    const float ma = wave_sum(sa) * (1.f / 1024.f), mb = wave_sum(sb) * (1.f / 1024.f);
    float qa = 0.f, qb = 0.f;
#pragma unroll
    for (int i = 0; i < 4; ++i) {
      va[i].x -= ma; va[i].y -= ma; va[i].z -= ma; va[i].w -= ma;
      vb[i].x -= mb; vb[i].y -= mb; vb[i].z -= mb; vb[i].w -= mb;
      qa += va[i].x * va[i].x + va[i].y * va[i].y + va[i].z * va[i].z + va[i].w * va[i].w;
      qb += vb[i].x * vb[i].x + vb[i].y * vb[i].y + vb[i].z * vb[i].z + vb[i].w * vb[i].w;
    }
    const float ra = rsqrtf(wave_sum(qa) * (1.f / 1024.f) + 1e-5f), rb = rsqrtf(wave_sum(qb) * (1.f / 1024.f) + 1e-5f);
#pragma unroll
    for (int rr = 0; rr < 2; ++rr) {
      if (rr == 1 && !has1) break;
      const int row = rr ? row1 : row0;
      const float rstd = rr ? rb : ra;
      float* dst = xrow(p, row);
      if (write_act && lane == 0) ((float2*)(p.ws + O_ST))[row] = make_float2(rr ? mb : ma, rstd);
      const float* m = (const float*)(p.ws + O_MOD) + (size_t)mod_layer * 17 * 6144 + rowb(row) * 6144 + sh_chunk * 1024;
#pragma unroll
      for (int i = 0; i < 4; ++i) {
        int col = (i * 64 + lane) * 4;
        float4 v = rr ? vb[i] : va[i];
        float4 gg = *(const float4*)(g + col);
        float4 bv = *(const float4*)(bb + col);
        float4 y;
        y.x = v.x * rstd * gg.x + bv.x; y.y = v.y * rstd * gg.y + bv.y;
        y.z = v.z * rstd * gg.z + bv.z; y.w = v.w * rstd * gg.w + bv.w;
        if (!write_act) *(float4*)(dst + col) = y;
        if (write_act) {
          float4 sh = *(const float4*)(m + col);
          float4 sc = *(const float4*)(m + 1024 + col);
          uint2 o;
          o.x = pack2(y.x * (1.f + sc.x) + sh.x, y.y * (1.f + sc.y) + sh.y);
          o.y = pack2(y.z * (1.f + sc.z) + sh.z, y.w * (1.f + sc.w) + sh.w);
          *(uint2*)(act + (size_t)row * AP + col) = o;
        }
      }
    }
  }
}

DI void gemm_phase(const Params& p, int layer, int mode, int nrows, char* lds_all) {
  int tid_ = threadIdx.x;
  asm volatile("" : "+v"(tid_));
  const int tid = tid_;
  const float* Cs = (const float*)lds_all;
  int ntn, K, lda, ldb;
  const u16 *A, *Bt;
  if (mode == 0) { ntn = 11; K = 1024; lda = AP; ldb = WP; A = (const u16*)(p.ws + O_ACT); Bt = (const u16*)(p.ws + O_WIN + layer * SZ_WIN); }
  else if (mode == 1) { ntn = 4; K = 1024; lda = AP; ldb = WP; A = (const u16*)(p.ws + O_ACT); Bt = (const u16*)(p.ws + O_WOUT + layer * SZ_WOUT); }
  else if (mode == 2) { ntn = 16; K = 1024; lda = AP; ldb = WP; A = (const u16*)(p.ws + O_ACT); Bt = (const u16*)(p.ws + O_WFF1 + layer * SZ_WFF); }
  else { ntn = 4; K = 4096; lda = HP; ldb = WP2; A = (const u16*)(p.ws + O_Z); Bt = (const u16*)(p.ws + O_WFF2 + layer * SZ_WFF); }
  const int ntm = nrows >> 8;
  const float* mod = (const float*)(p.ws + O_MOD) + (size_t)layer * 17 * 6144;
  const bool swz = (gridDim.x & 7) == 0;
  const int xcd = swz ? (blockIdx.x & 7) : 0, nx = swz ? 8 : 1;
  const int jb = swz ? (blockIdx.x >> 3) : blockIdx.x, nj = swz ? (gridDim.x >> 3) : gridDim.x;
  const int per = 2 * ntn, nsr = ntm >> 1;
  for (int i = jb;; i += nj) {
    const int srl = i / per, rem = i - srl * per;
    const int sr = xcd + nx * srl;
    if (sr >= nsr) break;
    const int tn = rem >> 1, tm = sr * 2 + (rem & 1);
    const int m0 = tm * 256, n0 = tn * 256;
    gemm_tile512(A + (size_t)m0 * lda, lda, Bt + (size_t)n0 * ldb, ldb, K, lds_all, [&](int half) {
      for (int idx = tid; idx < 128 * 64; idx += 512) {
        const int rr = idx >> 6, c4 = (idx & 63) * 4;
        const int row = m0 + half * 128 + rr, col = n0 + c4;
        float4 v = *(const float4*)(Cs + rr * CSW + c4);
        if (mode == 0) {
          uint2 o;
          o.x = pack2(v.x, v.y); o.y = pack2(v.z, v.w);
          *(uint2*)((u16*)(p.ws + O_Z) + (size_t)row * ZW + col) = o;
          if (n0 == C_BAB && c4 < 16) *(float4*)((float*)(p.ws + O_GRAW) + (size_t)row * 16 + c4) = v;
        } else if (mode == 2) {
          float a = fmaxf(v.x, 0.f), b = fmaxf(v.y, 0.f), c = fmaxf(v.z, 0.f), d = fmaxf(v.w, 0.f);
          uint2 o;
          o.x = pack2(a * a, b * b); o.y = pack2(c * c, d * d);
          *(uint2*)((u16*)(p.ws + O_Z) + (size_t)row * HP + col) = o;
        } else {
          const float* gate = mod + rowb(row) * 6144 + (mode == 1 ? 2 : 5) * 1024 + col;
          float4 gt = *(const float4*)gate;
          const float* res = (mode == 1 && layer == 0) ? xrow0(p, row) : xrow(p, row);
          float4 xr = *(const float4*)(res + col);
          if (!(mode == 1 && layer == 0)) {
            const float2 st = ((const float2*)(p.ws + O_ST))[row];
            const float* lg_ = (mode == 3) ? p.ln1_g + layer * DM : p.ln2_g + (layer - 1) * DM;
            const float* lb_ = (mode == 3) ? p.ln1_b + layer * DM : p.ln2_b + (layer - 1) * DM;
            const float4 lg4 = *(const float4*)(lg_ + col), lb4 = *(const float4*)(lb_ + col);
            xr.x = (xr.x - st.x) * st.y * lg4.x + lb4.x; xr.y = (xr.y - st.x) * st.y * lg4.y + lb4.y;
            xr.z = (xr.z - st.x) * st.y * lg4.z + lb4.z; xr.w = (xr.w - st.x) * st.y * lg4.w + lb4.w;
          }
          float4 o;
          o.x = DN_ALPHA * xr.x + gt.x * v.x; o.y = DN_ALPHA * xr.y + gt.y * v.y;
          o.z = DN_ALPHA * xr.z + gt.z * v.z; o.w = DN_ALPHA * xr.w + gt.w * v.w;
          *(float4*)(xrow(p, row) + col) = o;
        }
      }
    });
  }
}

DI void prep_swa(const Params& p, int tile) {
  int tid_ = VTID;
  asm volatile("" : "+v"(tid_));
  const int tid = tid_;
  const u16* Z = (const u16*)(p.ws + O_Z);
  const float4* tab = (const float4*)(p.ws + O_TAB);
  u16* QA = (u16*)(p.ws + O_QA);
  u16* KA = (u16*)(p.ws + O_KA);
  const int m0 = tile * 64;
  for (int jb = 0; jb < 6; jb += 3) {
    u32x4 x1[3], x2[3];
    float4 tb[3][4];
#pragma unroll
    for (int u = 0; u < 3; ++u) {
      const int id = tid + 256 * (jb + u), ri = id / 24, rem = id % 24, slot = rem >> 2, i8 = rem & 3;
      const int row = m0 + ri;
      const int base = slot < 4 ? C_AQ + slot * 64 : C_AK + (slot - 4) * 64;
      x1[u] = ldg16(Z + (size_t)row * ZW + base + i8 * 8);
      x2[u] = ldg16(Z + (size_t)row * ZW + base + 32 + i8 * 8);
      const int pos = row < NLAT ? (row & 4095) : 0;
#pragma unroll
      for (int e = 0; e < 4; ++e) tb[u][e] = tab[(pos * 64 + i8 * 8) / 2 + e];
    }
#pragma unroll
    for (int u = 0; u < 3; ++u) {
      const int id = tid + 256 * (jb + u), ri = id / 24, rem = id % 24, slot = rem >> 2, i8 = rem & 3;
      const int row = m0 + ri;
      const bool lat = row < NLAT;
      int b, pos;
      if (lat) { b = row >> 12; pos = row & 4095; } else { b = (row - NLAT) >> 8; pos = TT + ((row - NLAT) & 255); }
      float a1[8], a2[8], o1[8], o2[8];
      unpack8(x1[u], a1); unpack8(x2[u], a2);
      const float qs = slot < 4 ? 0.125f * LOG2E : 1.f;
#pragma unroll
      for (int e = 0; e < 4; ++e) {
        float c0 = lat ? tb[u][e].x : 1.f, s0 = lat ? tb[u][e].y : 0.f, c1 = lat ? tb[u][e].z : 1.f, s1 = lat ? tb[u][e].w : 0.f;
        o1[2 * e] = (a1[2 * e] * c0 - a2[2 * e] * s0) * qs;
        o2[2 * e] = (a1[2 * e] * s0 + a2[2 * e] * c0) * qs;
        o1[2 * e + 1] = (a1[2 * e + 1] * c1 - a2[2 * e + 1] * s1) * qs;
        o2[2 * e + 1] = (a1[2 * e + 1] * s1 + a2[2 * e + 1] * c1) * qs;
      }
      u16* d = slot < 4 ? QA + ((size_t)(b * 4 + slot) * NPOS + pos) * 64 : KA + ((size_t)(b * 2 + slot - 4) * NPOS + pos) * 64;
      *(u32x4*)(d + i8 * 8) = pack8(o1);
      *(u32x4*)(d + 32 + i8 * 8) = pack8(o2);
    }
  }
}

DI void prep_ret(const Params& p, int tile) {
  int tid_ = VTID;
  asm volatile("" : "+v"(tid_));
  const int tid = tid_;
  const u16* Z = (const u16*)(p.ws + O_Z);
  const float4* tab = (const float4*)(p.ws + O_TAB);
  u16* QC = (u16*)(p.ws + O_QC);
  u16* KC = (u16*)(p.ws + O_KC);
  const int m0 = tile * 64;
  u32x4 x1[4], x2[4];
  float4 tb[4][4];
#pragma unroll
  for (int u = 0; u < 4; ++u) {
    const int id = tid + 256 * u, ri = id >> 4, rem = id & 15, slot = rem >> 1, i8 = rem & 1;
    const int row = m0 + ri;
    const int base = C_CQ + slot * 32;
    x1[u] = ldg16(Z + (size_t)row * ZW + base + i8 * 8);
    x2[u] = ldg16(Z + (size_t)row * ZW + base + 16 + i8 * 8);
    const int pos = row < NLAT ? (row & 4095) : 0;
#pragma unroll
    for (int e = 0; e < 4; ++e) tb[u][e] = tab[(pos * 64 + 32 + i8 * 8) / 2 + e];
  }
#pragma unroll
  for (int u = 0; u < 4; ++u) {
    const int id = tid + 256 * u, ri = id >> 4, rem = id & 15, slot = rem >> 1, i8 = rem & 1;
    const int row = m0 + ri;
    const bool lat = row < NLAT;
    float a1[8], a2[8], o1[8], o2[8];
    unpack8(x1[u], a1); unpack8(x2[u], a2);
    const float qs = slot < 4 ? 0.17677669529663687f : 1.f;
#pragma unroll
    for (int e = 0; e < 4; ++e) {
      float c0 = lat ? tb[u][e].x : 1.f, s0 = lat ? tb[u][e].y : 0.f, c1 = lat ? tb[u][e].z : 1.f, s1 = lat ? tb[u][e].w : 0.f;
      o1[2 * e] = (a1[2 * e] * c0 - a2[2 * e] * s0) * qs;
      o2[2 * e] = (a1[2 * e] * s0 + a2[2 * e] * c0) * qs;
      o1[2 * e + 1] = (a1[2 * e + 1] * c1 - a2[2 * e + 1] * s1) * qs;
      o2[2 * e + 1] = (a1[2 * e + 1] * s1 + a2[2 * e + 1] * c1) * qs;
    }
    u16* d = slot < 4 ? QC + (size_t)row * 128 + slot * 32 : KC + (size_t)row * 128 + (slot - 4) * 32;
    *(u32x4*)(d + i8 * 8) = pack8(o1);
    *(u32x4*)(d + 16 + i8 * 8) = pack8(o2);
  }
}

DI void prep_dn(const Params& p, int layer, int tile, char* lds) {
  int tid_ = VTID;
  asm volatile("" : "+v"(tid_));
  const int tid = tid_;
  const u16* Z = (const u16*)(p.ws + O_Z);
  u16* QKVB = (u16*)(p.ws + O_QKVB);
  float* cw = (float*)lds;
  const int m0 = tile * 64;
  __syncthreads();
  for (int e = tid; e < 3840; e += 256) cw[e] = p.dn_conv_w[(size_t)layer * 3840 + e];
  __syncthreads();
  for (int jb = 0; jb < 24; jb += 4) {
    u32x4 xr[4][5];
#pragma unroll
    for (int u = 0; u < 4; ++u) {
      const int id = tid + 256 * (jb + u), ri = id / 96, ch8 = id % 96;
      const int row = m0 + ri;
      int tpos, seqn;
      if (row < NLAT) { tpos = row & 4095; seqn = TT; } else { tpos = (row - NLAT) & 255; seqn = LC; }
      const u16* zc = Z + (size_t)row * ZW + C_BQKV + ch8 * 8;
#pragma unroll
      for (int j = 0; j < 5; ++j) {
        const int tp = tpos + j - 2;
        u32x4 zz = {0u, 0u, 0u, 0u};
        xr[u][j] = (tp >= 0 && tp < seqn) ? ldg16(zc + (j - 2) * ZW) : zz;
      }
    }
#pragma unroll
    for (int u = 0; u < 4; ++u) {
      const int id = tid + 256 * (jb + u), ri = id / 96, ch8 = id % 96;
      const int row = m0 + ri;
      float acc[8];
#pragma unroll
      for (int e = 0; e < 8; ++e) acc[e] = 0.f;
#pragma unroll
      for (int j = 0; j < 5; ++j) {
        float x[8];
        unpack8(xr[u][j], x);
        const float4 w0 = *(const float4*)(cw + j * 768 + ch8 * 8), w1 = *(const float4*)(cw + j * 768 + ch8 * 8 + 4);
        acc[0] += x[0] * w0.x; acc[1] += x[1] * w0.y; acc[2] += x[2] * w0.z; acc[3] += x[3] * w0.w;
        acc[4] += x[4] * w1.x; acc[5] += x[5] * w1.y; acc[6] += x[6] * w1.z; acc[7] += x[7] * w1.w;
      }
      float ss = 0.f;
#pragma unroll
      for (int e = 0; e < 8; ++e) { acc[e] = siluf(acc[e]); ss += acc[e] * acc[e]; }
      ss += __shfl_xor(ss, 1); ss += __shfl_xor(ss, 2); ss += __shfl_xor(ss, 4);
      const int grp = ch8 >> 3;
      const float sc = grp < 8 ? rsqrtf(ss + 1e-6f) * (grp < 4 ? 0.125f : 1.f) : 1.f;
#pragma unroll
      for (int e = 0; e < 8; ++e) acc[e] *= sc;
      *(u32x4*)(QKVB + (size_t)row * 768 + ch8 * 8) = pack8(acc);
    }
  }
  const float* graw = (const float*)(p.ws + O_GRAW);
  float* g2 = (float*)(p.ws + O_G2);
  for (int e = tid; e < 64 * 8; e += 256) {
    int ri = e >> 3, dh = e & 7, dir = dh >> 2, hh = dh & 3;
    int row = m0 + ri;
    float ra = graw[(size_t)row * 16 + dir * 8 + hh], rb = graw[(size_t)row * 16 + dir * 8 + 4 + hh];
    float xx = ra + p.dn_dt_bias[layer * 8 + dh];
    float sp = xx > 20.f ? xx : log1pf(expf(xx));
    float lg = -expf(p.dn_a_log[layer * 8 + dh]) * sp;
    float beta = 1.f / (1.f + expf(-rb));
    g2[(size_t)row * 16 + dh] = lg;
    g2[(size_t)row * 16 + 8 + dh] = beta;
  }
}

DI void prep_mla(const Params& p, int layer, int tm, int which, int nt, char* lds) {
  int tid_ = VTID;
  asm volatile("" : "+v"(tid_));
  const int tid = tid_;
  const u16* Z = (const u16*)(p.ws + O_Z);
  const int m0 = tm * 256;
  float* rs = (float*)(lds + 128 * CSL * 4);
  const int KK = which == 0 ? 256 : 128;
  const int cbase = which == 0 ? C_DCQ : C_DCKV;
  __syncthreads();
  {
    const u16* src = Z + (size_t)(m0 + tid) * ZW + cbase;
    float s = 0.f;
    for (int i = 0; i < KK / 8; i += 4) {
      u32x4 u0 = ldg16(src + i * 8), u1 = ldg16(src + i * 8 + 8), u2 = ldg16(src + i * 8 + 16), u3 = ldg16(src + i * 8 + 24);
      float f[8];
      unpack8(u0, f);
#pragma unroll
      for (int e = 0; e < 8; ++e) s += f[e] * f[e];
      unpack8(u1, f);
#pragma unroll
      for (int e = 0; e < 8; ++e) s += f[e] * f[e];
      unpack8(u2, f);
#pragma unroll
      for (int e = 0; e < 8; ++e) s += f[e] * f[e];
      unpack8(u3, f);
#pragma unroll
      for (int e = 0; e < 8; ++e) s += f[e] * f[e];
    }
    rs[tid] = rsqrtf(s / (float)KK + 1e-6f);
  }
  const u16* Bt = which == 0 ? (const u16*)(p.ws + O_WUQ + layer * SZ_WUQ) + (size_t)nt * 128 * 256
                             : (const u16*)(p.ws + O_WUKV + layer * SZ_WUKV) + (size_t)nt * 128 * 128;
  const float* Cs = (const float*)lds;
  const float2* tab = (const float2*)(p.ws + O_TAB);
  gemm_tile(Z + (size_t)m0 * ZW + cbase, ZW, Bt, KK, KK, lds, [&](int half) {
    if (which == 0) {
      u16* QD = (u16*)(p.ws + O_QD);
      const float qs = 0.10206207261596575f * LOG2E;
      for (int idx = tid; idx < 128 * 32; idx += 256) {
        const int rr = idx >> 5, c4 = (idx & 31) * 4;
        const int row = m0 + half * 128 + rr;
        const float sc = rs[half * 128 + rr] * qs;
        float o[4];
#pragma unroll
        for (int j = 0; j < 4; ++j) {
          int cl = c4 + j, c = nt * 128 + cl, d = c % 96;
          float v = Cs[rr * CSL + cl];
          if (d >= 64 && row < NLAT) {
            int i = d - 64;
            if (i < 16) {
              float2 t = tab[(row & 4095) * 64 + 48 + i];
              float x2 = Cs[rr * CSL + cl + 16];
              v = v * t.x - x2 * t.y;
            } else {
              float2 t = tab[(row & 4095) * 64 + 48 + i - 16];
              float x1 = Cs[rr * CSL + cl - 16];
              v = x1 * t.y + v * t.x;
            }
          }
          o[j] = v * sc;
        }
        uint2 w;
        w.x = pack2(o[0], o[1]); w.y = pack2(o[2], o[3]);
        *(uint2*)(QD + (size_t)row * 384 + nt * 128 + c4) = w;
      }
    } else {
      u16* KVD = (u16*)(p.ws + O_KVD);
      for (int idx = tid; idx < 128 * 32; idx += 256) {
        const int rr = idx >> 5, c4 = (idx & 31) * 4;
        const int row = m0 + half * 128 + rr;
        const float sc = rs[half * 128 + rr];
        float4 v = *(const float4*)(Cs + rr * CSL + c4);
        uint2 w;
        w.x = pack2(v.x * sc, v.y * sc); w.y = pack2(v.z * sc, v.w * sc);
        *(uint2*)(KVD + (size_t)row * KVP + nt * 128 + c4) = w;
      }
    }
  });
  if (which == 1 && nt == 0) {
    u16* KR = (u16*)(p.ws + O_KR);
    for (int e = tid; e < 256 * 16; e += 256) {
      int rr = e >> 4, i = e & 15, row = m0 + rr;
      float cs = 1.f, sn = 0.f;
      if (row < NLAT) { float2 t = tab[(row & 4095) * 64 + 48 + i]; cs = t.x; sn = t.y; }
      float x1 = bf2f(Z[(size_t)row * ZW + C_DKR + i]), x2 = bf2f(Z[(size_t)row * ZW + C_DKR + 16 + i]);
      KR[(size_t)row * 32 + i] = f2bf(x1 * cs - x2 * sn);
      KR[(size_t)row * 32 + 16 + i] = f2bf(x1 * sn + x2 * cs);
    }
  }
}

DI void prep_phase(const Params& p, int layer, char* lds) {
  const int total = 3264 + 816 + 1088;
  for (int t = VB; t < total; t += VG) {
    if (t < 1088) prep_swa(p, t);
    else if (t < 2176) prep_ret(p, t - 1088);
    else if (t < 3264) prep_dn(p, layer, t - 2176, lds);
    else if (t < 3264 + 816) { int q = t - 3264; prep_mla(p, layer, q / 3, 0, q % 3, lds); }
    else { int q = t - 3264 - 816; prep_mla(p, layer, q / 4, 1, q % 4, lds); }
  }
}

struct Seg {
  const u16* k; const u16* k2; const u16* v;
  int ldk, ldk2, ldv, n, pos0, masked;
};

template <int DQK>
DI void attn_tile(const u16* __restrict__ q, int ldq, int qpos0, const Seg& s0, const Seg& s1, int nseg, bool has_sink,
                  float sinkl2, u16* __restrict__ out, int ldo, char* lds) {
  constexpr int KST = DQK + 8;
  constexpr int CPK = DQK / 8;
  constexpr int NKS = DQK / 16;
  constexpr int VST = 96;
  u16* Ks = (u16*)lds;
  u16* Vs = Ks + 64 * KST;
  int ltid_ = threadIdx.x;
  asm volatile("" : "+v"(ltid_));
  const int ltid = ltid_;
  const int tid = ltid & 255, wave = tid >> 6, lane = tid & 63, r = lane & 31, h = lane >> 5;
  const int qi = wave * 32 + r;
  bf16x8 qf[NKS];
#pragma unroll
  for (int ks = 0; ks < NKS; ++ks) qf[ks] = *(const bf16x8*)(q + (size_t)qi * ldq + ks * 16 + 8 * h);
  const int nt0 = s0.n >> 6;
  const int NT = nt0 + (nseg > 1 ? (s1.n >> 6) : 0);
  uint4 kreg0, kreg1 = make_uint4(0, 0, 0, 0), vreg0;
  uint4 krgB0, krgB1 = make_uint4(0, 0, 0, 0), vrgB0;
  const int kkey0 = ltid / CPK, kpart0 = ltid % CPK;
  const int kkey1 = (ltid + 512) / CPK, kpart1 = (ltid + 512) % CPK;
  const bool k1 = (CPK == 12) && (ltid < 256);
  const int vkey = ltid >> 3, vpart = ltid & 7;
  typedef __attribute__((address_space(3))) const char* lds_cptr;
  typedef short v4i16_t __attribute__((ext_vector_type(4)));
  const lds_cptr vp0 = (lds_cptr)Vs + (4 * h + ((lane & 15) >> 2)) * (VST * 2) + ((lane >> 4) & 1) * 32 + (lane & 3) * 8;
#define ATT_VTR(p) __builtin_bit_cast(s16x4, __builtin_amdgcn_ds_read_tr16_b64_v4i16((__attribute__((address_space(3))) v4i16_t*)(p)))
#define ATT_KSRC(sg, off, key, part) \
  (((part) < 8) ? (sg).k + (size_t)((off) + (key)) * (sg).ldk + (part) * 8 : (sg).k2 + (size_t)((off) + (key)) * (sg).ldk2 + ((part) - 8) * 8)
#define ATT_LOADX(i, K0, K1, V0)                                                            \
  {                                                                                         \
    const Seg& sgl = ((i) < nt0) ? s0 : s1;                                                 \
    const int offl = (((i) < nt0) ? (i) : (i) - nt0) << 6;                                  \
    K0 = *(const uint4*)ATT_KSRC(sgl, offl, kkey0, kpart0);                                 \
    if (k1) K1 = *(const uint4*)ATT_KSRC(sgl, offl, kkey1, kpart1);                         \
    V0 = *(const uint4*)(sgl.v + (size_t)(offl + vkey) * sgl.ldv + vpart * 8);              \
  }
  f32x16 o0 = zero16(), o1 = zero16();
  float m = -1e30f, l = 0.f;
#define ATT_STOREX(K0, K1, V0)                                               \
  {                                                                           \
    *(uint4*)(Ks + kkey0 * KST + kpart0 * 8) = K0;                            \
    if (k1) *(uint4*)(Ks + kkey1 * KST + kpart1 * 8) = K1;                    \
    *(uint4*)(Vs + vkey * VST + vpart * 8) = V0;                              \
  }
  auto compute = [&](int i) {
    const Seg& sg = (i < nt0) ? s0 : s1;
    const int off = ((i < nt0) ? i : i - nt0) << 6;
    f32x16 sa = zero16(), sb = zero16();
#pragma unroll
    for (int ks = 0; ks < NKS; ++ks) {
      bf16x8 a0 = *(const bf16x8*)(Ks + r * KST + ks * 16 + 8 * h);
      bf16x8 a1 = *(const bf16x8*)(Ks + (32 + r) * KST + ks * 16 + 8 * h);
      sa = MFMA(a0, qf[ks], sa);
      sb = MFMA(a1, qf[ks], sb);
    }
    if (sg.masked) {
      const int qpos = qpos0 + qi;
      const int kb = sg.pos0 + off;
#pragma unroll
      for (int g = 0; g < 16; ++g) {
        int d0 = kb + crow(g, h) - qpos, d1 = d0 + 32;
        if (d0 > 128 || d0 < -128) sa[g] = -INFINITY;
        if (d1 > 128 || d1 < -128) sb[g] = -INFINITY;
      }
    }
    float mx = sa[0];
#pragma unroll
    for (int g = 1; g < 16; ++g) mx = fmaxf(mx, sa[g]);
#pragma unroll
    for (int g = 0; g < 16; ++g) mx = fmaxf(mx, sb[g]);
    mx = fmaxf(mx, __shfl_xor(mx, 32));
    const float mn = fmaxf(m, mx);
    const float alpha = __builtin_amdgcn_exp2f(m - mn);
    m = mn;
    float ps = 0.f;
#pragma unroll
    for (int g = 0; g < 16; ++g) { sa[g] = __builtin_amdgcn_exp2f(sa[g] - mn); ps += sa[g]; }
#pragma unroll
    for (int g = 0; g < 16; ++g) { sb[g] = __builtin_amdgcn_exp2f(sb[g] - mn); ps += sb[g]; }
    l = l * alpha + ps;
#pragma unroll
    for (int g = 0; g < 16; ++g) { o0[g] *= alpha; o1[g] *= alpha; }
#pragma unroll
    for (int kt = 0; kt < 2; ++kt) {
#pragma unroll
      for (int s = 0; s < 2; ++s) {
        const f32x16& sv = kt == 0 ? sa : sb;
        uint4 pu;
        pu.x = pack2(sv[8 * s + 0], sv[8 * s + 1]); pu.y = pack2(sv[8 * s + 2], sv[8 * s + 3]);
        pu.z = pack2(sv[8 * s + 4], sv[8 * s + 5]); pu.w = pack2(sv[8 * s + 6], sv[8 * s + 7]);
        bf16x8 pf = __builtin_bit_cast(bf16x8, pu);
        const lds_cptr vp = vp0 + (kt * 32 + 16 * s) * (VST * 2);
        {
          s16x4 lo = ATT_VTR(vp);
          s16x4 hi = ATT_VTR(vp + 8 * VST * 2);
          bf16x8 vf = __builtin_shufflevector(lo, hi, 0, 1, 2, 3, 4, 5, 6, 7);
          o0 = MFMA(vf, pf, o0);
        }
        {
          s16x4 lo = ATT_VTR(vp + 64);
          s16x4 hi = ATT_VTR(vp + 8 * VST * 2 + 64);
          bf16x8 vf = __builtin_shufflevector(lo, hi, 0, 1, 2, 3, 4, 5, 6, 7);
          o1 = MFMA(vf, pf, o1);
        }
      }
    }
  };
  ATT_LOADX(0, kreg0, kreg1, vreg0);
  ATT_LOADX(1, krgB0, krgB1, vrgB0);
  for (int i = 0; i < NT; i += 2) {
    __syncthreads();
    ATT_STOREX(kreg0, kreg1, vreg0);
    __syncthreads();
    if (i + 2 < NT) ATT_LOADX(i + 2, kreg0, kreg1, vreg0);
    compute(i);
    __syncthreads();
    ATT_STOREX(krgB0, krgB1, vrgB0);
    __syncthreads();
    if (i + 3 < NT) ATT_LOADX(i + 3, krgB0, krgB1, vrgB0);
    compute(i + 1);
  }
  float lt = l + __shfl_xor(l, 32);
  if (has_sink) lt += __builtin_amdgcn_exp2f(sinkl2 - m);
  const float inv = 1.f / lt;
#pragma unroll
  for (int g = 0; g < 4; ++g) {
    uint2 w;
    w.x = pack2(o0[4 * g] * inv, o0[4 * g + 1] * inv); w.y = pack2(o0[4 * g + 2] * inv, o0[4 * g + 3] * inv);
    *(uint2*)(out + (size_t)qi * ldo + 8 * g + 4 * h) = w;
    w.x = pack2(o1[4 * g] * inv, o1[4 * g + 1] * inv); w.y = pack2(o1[4 * g + 2] * inv, o1[4 * g + 3] * inv);
    *(uint2*)(out + (size_t)qi * ldo + 32 + 8 * g + 4 * h) = w;
  }
}

DI void mla_attn(const Params& p, int idx, char* lds) {
  const u16* QD = (const u16*)(p.ws + O_QD);
  const u16* KVD = (const u16*)(p.ws + O_KVD);
  const u16* KR = (const u16*)(p.ws + O_KR);
  u16* act = (u16*)(p.ws + O_ACT);
  Seg lat, cx;
  int b, hh, row0;
  bool is_ctx = idx >= 2048;
  if (!is_ctx) { b = idx >> 7; hh = (idx >> 5) & 3; row0 = b * TT + (idx & 31) * 128; }
  else { int q = idx - 2048; b = q >> 3; hh = (q >> 1) & 3; row0 = NLAT + b * LC + (q & 1) * 128; }
  const size_t lr = (size_t)b * TT, cr = (size_t)NLAT + b * LC;
  lat.k = KVD + lr * KVP + hh * 128; lat.ldk = KVP; lat.k2 = KR + lr * 32; lat.ldk2 = 32; lat.v = KVD + lr * KVP + hh * 128 + 64;
  lat.ldv = KVP; lat.n = TT; lat.pos0 = 0; lat.masked = 0;
  cx.k = KVD + cr * KVP + hh * 128; cx.ldk = KVP; cx.k2 = KR + cr * 32; cx.ldk2 = 32; cx.v = KVD + cr * KVP + hh * 128 + 64;
  cx.ldv = KVP; cx.n = LC; cx.pos0 = 0; cx.masked = 0;
  const u16* q = QD + (size_t)row0 * 384 + hh * 96;
  u16* o = act + (size_t)row0 * AP + 768 + hh * 64;
  if (!is_ctx) attn_tile<96>(q, 384, 0, lat, cx, 2, false, 0.f, o, AP, lds);
  else attn_tile<96>(q, 384, 0, cx, cx, 1, false, 0.f, o, AP, lds);
}

DI void swa_attn(const Params& p, int layer, int idx, char* lds) {
  const u16* QA = (const u16*)(p.ws + O_QA);
  const u16* KA = (const u16*)(p.ws + O_KA);
  const u16* Z = (const u16*)(p.ws + O_Z);
  u16* act = (u16*)(p.ws + O_ACT);
  Seg loc, cx;
  int b, hh, row0, pos0q;
  bool is_ctx = idx >= 2048;
  int nb = 0;
  if (!is_ctx) { b = idx >> 7; hh = ((idx >> 6) & 1) * 2 + (idx & 1); nb = (idx >> 1) & 31; pos0q = nb * 128; row0 = b * TT + pos0q; }
  else { int q = idx - 2048; b = q >> 3; hh = (q >> 1) & 3; pos0q = TT + (q & 1) * 128; row0 = NLAT + b * LC + (q & 1) * 128; }
  const int hk = hh >> 1;
  const u16* kbase = KA + (size_t)(b * 2 + hk) * NPOS * 64;
  cx.k = kbase + (size_t)TT * 64; cx.ldk = 64; cx.k2 = cx.k; cx.ldk2 = 64;
  cx.v = Z + ((size_t)NLAT + b * LC) * ZW + C_AV + hk * 64; cx.ldv = ZW; cx.n = LC; cx.pos0 = 0; cx.masked = 0;
  const float sinkl2 = p.swa_sink[layer * 4 + hh] * LOG2E;
  const u16* q = QA + ((size_t)(b * 4 + hh) * NPOS + pos0q) * 64;
  u16* o = act + (size_t)row0 * AP + hh * 64;
  if (!is_ctx) {
    int ks = nb * 128 - 128; if (ks < 0) ks = 0;
    int ke = nb * 128 + 256; if (ke > TT) ke = TT;
    loc.k = kbase + (size_t)ks * 64; loc.ldk = 64; loc.k2 = loc.k; loc.ldk2 = 64;
    loc.v = Z + ((size_t)b * TT + ks) * ZW + C_AV + hk * 64; loc.ldv = ZW; loc.n = ke - ks; loc.pos0 = ks; loc.masked = 1;
    attn_tile<64>(q, 64, pos0q, loc, cx, 2, true, sinkl2, o, AP, lds);
  } else {
    attn_tile<64>(q, 64, 0, cx, cx, 1, true, sinkl2, o, AP, lds);
  }
}

constexpr int LS = 72;
template <int KS>
DI f32x16 mm64(const u16* A, int lda, const u16* Bt, int ldb, int wm, int wn, int r, int h) {
  f32x16 acc = zero16();
#pragma unroll
  for (int s = 0; s < KS; ++s) {
    bf16x8 a = *(const bf16x8*)(A + (wm * 32 + r) * lda + s * 16 + 8 * h);
    bf16x8 b = *(const bf16x8*)(Bt + (wn * 32 + r) * ldb + s * 16 + 8 * h);
    acc = MFMA(a, b, acc);
  }
  return acc;
}
DI void st_straight(u16* D, int ld, const f32x16& v, int wm, int wn, int r, int h) {
#pragma unroll
  for (int g = 0; g < 16; ++g) D[(wm * 32 + crow(g, h)) * ld + wn * 32 + r] = f2bf(v[g]);
}
DI void st_transp(u16* D, int ld, const f32x16& v, int wm, int wn, int r, int h) {
#pragma unroll
  for (int g = 0; g < 4; ++g) {
    uint2 w;
    w.x = pack2(v[4 * g], v[4 * g + 1]); w.y = pack2(v[4 * g + 2], v[4 * g + 3]);
    *(uint2*)(D + (wn * 32 + r) * ld + wm * 32 + 8 * g + 4 * h) = w;
  }
}

template <int KS>
DI f32x16 mm64t(const u16* AT, int lda, const u16* Bt, int ldb, int wm, int wn, int r, int h, int lane) {
  typedef __attribute__((address_space(3))) const char* lds_cptr;
  typedef short v4i16_t __attribute__((ext_vector_type(4)));
  const lds_cptr base = (lds_cptr)AT + ((lane & 15) >> 2) * (lda * 2) + (wm * 32 + ((lane >> 4) & 1) * 16) * 2 + (lane & 3) * 8;
  f32x16 acc = zero16();
#pragma unroll
  for (int s = 0; s < KS; ++s) {
    s16x4 lo = __builtin_bit_cast(s16x4, __builtin_amdgcn_ds_read_tr16_b64_v4i16((__attribute__((address_space(3))) v4i16_t*)(base + (16 * s + 8 * h) * (lda * 2))));
    s16x4 hi = __builtin_bit_cast(s16x4, __builtin_amdgcn_ds_read_tr16_b64_v4i16((__attribute__((address_space(3))) v4i16_t*)(base + (16 * s + 8 * h + 4) * (lda * 2))));
    bf16x8 a = __builtin_shufflevector(lo, hi, 0, 1, 2, 3, 4, 5, 6, 7);
    bf16x8 b = *(const bf16x8*)(Bt + (wn * 32 + r) * ldb + s * 16 + 8 * h);
    acc = MFMA(a, b, acc);
  }
  return acc;
}

template <int KS, bool ATR, bool BTR>
DI f32x16 mm64x(const u16* A, int lda, const u16* B, int ldb, int wm, int wn, int r, int h, int lane) {
  typedef __attribute__((address_space(3))) const char* lds_cptr;
  typedef short v4i16_t __attribute__((ext_vector_type(4)));
  const int sub = ((lane & 15) >> 2), cb = ((lane >> 4) & 1) * 16, pb = (lane & 3) * 8;
  const lds_cptr abase = (lds_cptr)A + sub * (lda * 2) + (wm * 32 + cb) * 2 + pb;
  const lds_cptr bbase = (lds_cptr)B + sub * (ldb * 2) + (wn * 32 + cb) * 2 + pb;
  f32x16 acc = zero16();
#pragma unroll
  for (int s = 0; s < KS; ++s) {
    bf16x8 a, b;
    if (ATR) {
      s16x4 lo = __builtin_bit_cast(s16x4, __builtin_amdgcn_ds_read_tr16_b64_v4i16((__attribute__((address_space(3))) v4i16_t*)(abase + (16 * s + 8 * h) * (lda * 2))));
      s16x4 hi = __builtin_bit_cast(s16x4, __builtin_amdgcn_ds_read_tr16_b64_v4i16((__attribute__((address_space(3))) v4i16_t*)(abase + (16 * s + 8 * h + 4) * (lda * 2))));
      a = __builtin_shufflevector(lo, hi, 0, 1, 2, 3, 4, 5, 6, 7);
    } else {
      a = *(const bf16x8*)(A + (wm * 32 + r) * lda + s * 16 + 8 * h);
    }
    if (BTR) {
      s16x4 lo = __builtin_bit_cast(s16x4, __builtin_amdgcn_ds_read_tr16_b64_v4i16((__attribute__((address_space(3))) v4i16_t*)(bbase + (16 * s + 8 * h) * (ldb * 2))));
      s16x4 hi = __builtin_bit_cast(s16x4, __builtin_amdgcn_ds_read_tr16_b64_v4i16((__attribute__((address_space(3))) v4i16_t*)(bbase + (16 * s + 8 * h + 4) * (ldb * 2))));
      b = __builtin_shufflevector(lo, hi, 0, 1, 2, 3, 4, 5, 6, 7);
    } else {
      b = *(const bf16x8*)(B + (wn * 32 + r) * ldb + s * 16 + 8 * h);
    }
    acc = MFMA(a, b, acc);
  }
  return acc;
}
DI void st8s(u16* dst, const uint4& v, float f) {
  uint4 o;
  o.x = pack2(bflo(v.x) * f, bfhi(v.x) * f); o.y = pack2(bflo(v.y) * f, bfhi(v.y) * f);
  o.z = pack2(bflo(v.z) * f, bfhi(v.z) * f); o.w = pack2(bflo(v.w) * f, bfhi(v.w) * f);
  *(uint4*)dst = o;
}

DI void dn_chain(const Params& p, int chain, char* lds) {
  int tid_ = VTID;
  asm volatile("" : "+v"(tid_));
  const int tid = tid_, wave = tid >> 6, lane = tid & 63, r = lane & 31, h = lane >> 5;
  const int wm = wave >> 1, wn = wave & 1;
  const int b = chain >> 3, hh = (chain >> 1) & 3, dir = chain & 1;
  u16* kA = (u16*)lds;
  u16* St = kA + 64 * LS;
  u16* R1 = St + 64 * LS;
  u16* R2 = R1 + 64 * LS;
  u16* R3 = R2 + 64 * LS;
  u16* R4 = R3 + 64 * LS;
  u16* R5 = R4 + 64 * LS;
  float* gc = (float*)(R5 + 64 * LS);
  float* bt = gc + 64;
  const u16* QKVB = (const u16*)(p.ws + O_QKVB);
  const float* G2 = (const float*)(p.ws + O_G2);
  u16* OUT = dir ? (u16*)(p.ws + O_OB) : (u16*)(p.ws + O_ACT) + 256;
  const int opitch = dir ? 256 : AP;
  __syncthreads();
  for (int e = tid; e < 64 * LS / 2; e += 256) ((u32*)St)[e] = 0u;
  f32x16 S = zero16();
  const int lc = tid >> 3, lp = (tid & 7) * 8;
  auto rowof = [&](int n, int c) -> int {
    int cn, base, len;
    if (n < 4) { cn = n; base = NLAT + b * LC; len = LC; } else { cn = n - 4; base = b * TT; len = TT; }
    int pos = cn * 64 + c;
    return base + (dir ? len - 1 - pos : pos);
  };
  uint4 pk0, pk1, pq0, pq1, pv0, pv1;
  float pg = 0.f, pb = 0.f;
#define DN_LOAD(n)                                                                      \
  {                                                                                     \
    const u16* s0_ = QKVB + (size_t)rowof((n), lc) * 768 + hh * 64 + lp;                \
    const u16* s1_ = QKVB + (size_t)rowof((n), lc + 32) * 768 + hh * 64 + lp;           \
    pq0 = *(const uint4*)s0_; pk0 = *(const uint4*)(s0_ + 256); pv0 = *(const uint4*)(s0_ + 512); \
    pq1 = *(const uint4*)s1_; pk1 = *(const uint4*)(s1_ + 256); pv1 = *(const uint4*)(s1_ + 512); \
    if (tid < 64) {                                                                     \
      const float* g_ = G2 + (size_t)rowof((n), tid) * 16 + dir * 4 + hh;               \
      pg = g_[0]; pb = g_[8];                                                           \
    }                                                                                   \
  }
  DN_LOAD(0);
  for (int n = 0; n < 68; ++n) {
    const uint4 ck0 = pk0, ck1 = pk1, cq0 = pq0, cq1 = pq1, cv0 = pv0, cv1 = pv1;
    float cgv = pg, cbv = pb;
    __syncthreads();
    if (tid < 64) {
      float v = cgv;
#pragma unroll
      for (int o = 1; o < 64; o <<= 1) { float t = __shfl_up(v, o); if (lane >= o) v += t; }
      gc[tid] = v; bt[tid] = cbv;
    }
    *(uint4*)(kA + lc * LS + lp) = ck0;
    *(uint4*)(kA + (lc + 32) * LS + lp) = ck1;
    if (n + 1 < 68) DN_LOAD(n + 1);
    __syncthreads();
    const float gl = gc[63];
    f32x16 T;
    {
      f32x16 kk = mm64<4>(kA, LS, kA, LS, wm, wn, r, h);
      const int s = wn * 32 + r;
      const float gs = gc[s];
#pragma unroll
      for (int g = 0; g < 16; ++g) {
        int c = wm * 32 + crow(g, h);
        float v = (s < c) ? bt[c] * kk[g] * __expf(gc[c] - gs) : 0.f;
        kk[g] = v;
        T[g] = (c == s) ? 1.f : (((c >> 1) == (s >> 1)) ? -v : 0.f);
      }
      st_transp(R1, LS, kk, wm, wn, r, h);
      st_transp(R2, LS, T, wm, wn, r, h);
    }
    __syncthreads();
    for (int k = 1; k < 6; ++k) {
      f32x16 M = mm64t<4>(R1, LS, R2, LS, wm, wn, r, h, lane);
      st_transp(R4, LS, M, wm, wn, r, h);
      __syncthreads();
      f32x16 X = mm64t<4>(R2, LS, R4, LS, wm, wn, r, h, lane);
      {
        const int s = wn * 32 + r;
#pragma unroll
        for (int g = 0; g < 16; ++g) {
          int c = wm * 32 + crow(g, h);
          if ((c >> (k + 1)) == (s >> (k + 1)) && (c >> k) != (s >> k)) T[g] -= X[g];
        }
      }
      __syncthreads();
      st_transp(R2, LS, T, wm, wn, r, h);
      __syncthreads();
    }
    {
      const float fb0 = bt[lc], fk0 = fb0 * __expf(gc[lc]);
      const float fb1 = bt[lc + 32], fk1 = fb1 * __expf(gc[lc + 32]);
      st8s(R1 + lc * LS + lp, ck0, fk0);
      st8s(R1 + (lc + 32) * LS + lp, ck1, fk1);
      st8s(R3 + lc * LS + lp, cv0, fb0);
      st8s(R3 + (lc + 32) * LS + lp, cv1, fb1);
    }
    __syncthreads();
    f32x16 W = mm64x<4, true, true>(R2, LS, R1, LS, wm, wn, r, h, lane);
    f32x16 U = mm64x<4, true, true>(R2, LS, R3, LS, wm, wn, r, h, lane);
    st_transp(R4, LS, W, wm, wn, r, h);
    __syncthreads();
    {
      f32x16 ws = mm64t<4>(R4, LS, St, LS, wm, wn, r, h, lane);
#pragma unroll
      for (int g = 0; g < 16; ++g) U[g] -= ws[g];
      st_transp(R1, LS, U, wm, wn, r, h);
    }
    *(uint4*)(R2 + lc * LS + lp) = cq0;
    *(uint4*)(R2 + (lc + 32) * LS + lp) = cq1;
    st8s(R5 + lc * LS + lp, ck0, __expf(gl - gc[lc]));
    st8s(R5 + (lc + 32) * LS + lp, ck1, __expf(gl - gc[lc + 32]));
    __syncthreads();
    {
      f32x16 qk = mm64<4>(R2, LS, kA, LS, wm, wn, r, h);
      const int s = wn * 32 + r;
      const float gs = gc[s];
#pragma unroll
      for (int g = 0; g < 16; ++g) {
        int c = wm * 32 + crow(g, h);
        qk[g] = (s <= c) ? qk[g] * __expf(gc[c] - gs) : 0.f;
      }
      st_transp(R3, LS, qk, wm, wn, r, h);
    }
    __syncthreads();
    {
      f32x16 o1 = mm64<4>(R2, LS, St, LS, wm, wn, r, h);
      f32x16 o2 = mm64t<4>(R3, LS, R1, LS, wm, wn, r, h, lane);
      f32x16 sn = mm64x<4, true, false>(R5, LS, R1, LS, wm, wn, r, h, lane);
      const float egl = __expf(gl);
#pragma unroll
      for (int g = 0; g < 16; ++g) {
        int c = wm * 32 + crow(g, h);
        float ov = o1[g] * __expf(gc[c]) + o2[g];
        OUT[(size_t)rowof(n, c) * opitch + hh * 64 + wn * 32 + r] = f2bf(ov);
        S[g] = S[g] * egl + sn[g];
      }
    }
    __syncthreads();
    st_transp(St, LS, S, wm, wn, r, h);
  }
}

DI void ret_chain(const Params& p, int layer, int chain, char* lds) {
  int tid_ = VTID;
  asm volatile("" : "+v"(tid_));
  const int tid = tid_, wave = tid >> 6, lane = tid & 63, r = lane & 31, h = lane >> 5;
  const int wm = wave >> 1, wn = wave & 1;
  const int b = chain >> 3, hh = (chain >> 1) & 3, dir = chain & 1;
  constexpr int L4 = 40;
  u16* qA = (u16*)lds;
  u16* kA = qA + 64 * L4;
  u16* ks = kA + 64 * L4;
  u16* vs = ks + 64 * LS;
  u16* QK = vs + 64 * LS;
  u16* Rt = QK + 64 * LS;
  const u16* QC = (const u16*)(p.ws + O_QC);
  const u16* KC = (const u16*)(p.ws + O_KC);
  const u16* Z = (const u16*)(p.ws + O_Z);
  u16* OUT = dir ? (u16*)(p.ws + O_ORB) : (u16*)(p.ws + O_ACT) + 512;
  const int opitch = dir ? 256 : AP;
  const int lc = tid >> 2, lp4 = (tid & 3) * 8;
  const int vc = tid >> 3, vp = (tid & 7) * 8;
  const float lg = log1pf(-expf(p.ret_l1m[layer * 8 + dir * 4 + hh]));
  f32x16 R = zero16();
  auto rowof = [&](int n, int c) -> int {
    int cn, base, len;
    if (n < 4) { cn = n; base = NLAT + b * LC; len = LC; } else { cn = n - 4; base = b * TT; len = TT; }
    int pos = cn * 64 + c;
    return base + (dir ? len - 1 - pos : pos);
  };
  uint4 pq, pk, pv0, pv1;
#define RET_LOAD(n)                                                                                   \
  {                                                                                                   \
    const int row_ = rowof((n), lc);                                                                  \
    pq = *(const uint4*)(QC + (size_t)row_ * 128 + hh * 32 + lp4);                                    \
    pk = *(const uint4*)(KC + (size_t)row_ * 128 + hh * 32 + lp4);                                    \
    pv0 = *(const uint4*)(Z + (size_t)rowof((n), vc) * ZW + C_CV + hh * 64 + vp);                     \
    pv1 = *(const uint4*)(Z + (size_t)rowof((n), vc + 32) * ZW + C_CV + hh * 64 + vp);                \
  }
  RET_LOAD(0);
  for (int n = 0; n < 68; ++n) {
    __syncthreads();
    *(uint4*)(qA + lc * L4 + lp4) = pq;
    *(uint4*)(kA + lc * L4 + lp4) = pk;
    st8s(ks + lc * L4 + lp4, pk, __expf((float)(63 - lc) * lg));
    *(uint4*)(vs + vc * LS + vp) = pv0;
    *(uint4*)(vs + (vc + 32) * LS + vp) = pv1;
    if (wm == 0) st_transp(Rt, L4, R, wm, wn, r, h);
    if (n + 1 < 68) RET_LOAD(n + 1);
    __syncthreads();
    {
      f32x16 qk = mm64<2>(qA, L4, kA, L4, wm, wn, r, h);
      const int s = wn * 32 + r;
#pragma unroll
      for (int g = 0; g < 16; ++g) {
        int c = wm * 32 + crow(g, h);
        qk[g] = (s <= c) ? qk[g] * __expf((float)(c - s) * lg) : 0.f;
      }
      st_transp(QK, LS, qk, wm, wn, r, h);
    }
    __syncthreads();
    {
      f32x16 o1 = mm64x<4, true, true>(QK, LS, vs, LS, wm, wn, r, h, lane);
      f32x16 o2 = mm64<2>(qA, L4, Rt, L4, wm, wn, r, h);
      const float gch = __expf(64.f * lg);
#pragma unroll
      for (int g = 0; g < 16; ++g) {
        int c = wm * 32 + crow(g, h);
        float ov = o1[g] + __expf((float)(c + 1) * lg) * o2[g];
        OUT[(size_t)rowof(n, c) * opitch + hh * 64 + wn * 32 + r] = f2bf(ov);
      }
      if (wm == 0) {
        f32x16 rn = mm64x<4, true, true>(ks, L4, vs, LS, wm, wn, r, h, lane);
#pragma unroll
        for (int g = 0; g < 16; ++g) R[g] = R[g] * gch + rn[g];
      }
    }
  }
}

DI void pair_finalize(const Params& p, int layer, int kind, int b, int hh) {
  int ltid_ = threadIdx.x;
  asm volatile("" : "+v"(ltid_));
  const int ltid = ltid_;
  const u16* Z = (const u16*)(p.ws + O_Z);
  const u16* BW = (const u16*)(p.ws + (kind ? O_ORB : O_OB));
  u16* act = (u16*)(p.ws + O_ACT);
  const int acol = kind ? 512 : 256, zcol = kind ? C_CG : C_BZ;
  const float* gp = kind ? p.ret_norm_g + layer * 256 + hh * 64 + (ltid & 7) * 8 : p.dn_norm_g + layer * 64 + (ltid & 7) * 8;
  const float4 g0 = *(const float4*)gp, g1 = *(const float4*)(gp + 4);
  const float gg[8] = {g0.x, g0.y, g0.z, g0.w, g1.x, g1.y, g1.z, g1.w};
  const int c8 = hh * 8 + (ltid & 7);
  __syncthreads();
#pragma unroll 1
  for (int j0 = 0; j0 < 68; j0 += 4) {
    u32x4 a[4], bw[4], z[4];
#pragma unroll
    for (int u = 0; u < 4; ++u) {
      const int rr = (ltid + 512 * (j0 + u)) >> 3;
      const int row = rr < TT ? b * TT + rr : NLAT + b * LC + (rr - TT);
      a[u] = ldg16(act + (size_t)row * AP + acol + c8 * 8);
      bw[u] = ldg16(BW + (size_t)row * 256 + c8 * 8);
      z[u] = ldg16(Z + (size_t)row * ZW + zcol + c8 * 8);
    }
#pragma unroll
    for (int u = 0; u < 4; ++u) {
      const int rr = (ltid + 512 * (j0 + u)) >> 3;
      const int row = rr < TT ? b * TT + rr : NLAT + b * LC + (rr - TT);
      float fa[8], fb[8], fz[8], o[8];
      unpack8(a[u], fa); unpack8(bw[u], fb); unpack8(z[u], fz);
      float sm = 0.f;
#pragma unroll
      for (int e = 0; e < 8; ++e) { o[e] = fa[e] + fb[e]; sm += o[e]; }
      sm += __shfl_xor(sm, 1); sm += __shfl_xor(sm, 2); sm += __shfl_xor(sm, 4);
      const float mean = kind ? sm * (1.f / 64.f) : 0.f;
      float ss = 0.f;
#pragma unroll
      for (int e = 0; e < 8; ++e) { o[e] -= mean; ss += o[e] * o[e]; }
      ss += __shfl_xor(ss, 1); ss += __shfl_xor(ss, 2); ss += __shfl_xor(ss, 4);
      const float rn = rsqrtf(ss * (1.f / 64.f) + 1e-6f);
#pragma unroll
      for (int e = 0; e < 8; ++e) o[e] = o[e] * rn * gg[e] * siluf(fz[e]);
      *(u32x4*)(act + (size_t)row * AP + acol + c8 * 8) = pack8(o);
    }
  }
}

DI void mixer_phase(const Params& p, int layer, char* lds, char* lds_all, int* s_tile) {
  int* cnt = (int*)(p.ws + O_CNT) + layer;
  const int nattn = layer == 0 ? 2176 : 2048;
  const int nwork = 128 + 128 + 2 * nattn;
  const int total = nwork + (layer == 0 ? 5352 : 0);
  for (;;) {
    __syncthreads();
    if (threadIdx.x == 0) *s_tile = atomicAdd(cnt, 1);
    __syncthreads();
    const int t = 2 * (*s_tile) + VHALF;
    if (t >= total) break;
    if (t < 128) { dn_chain(p, t, lds); pair_finalize(p, layer, 0, t >> 3, (t >> 1) & 3); }
    else if (t < 256) { ret_chain(p, layer, t - 128, lds); pair_finalize(p, layer, 1, (t - 128) >> 3, ((t - 128) >> 1) & 3); }
    else if (t < 256 + nattn) mla_attn(p, t - 256, lds_all);
    else if (t < nwork) swa_attn(p, layer, t - 256 - nattn, lds_all);
    else wtile_deferred(p, t - nwork, lds);
  }
}

DI void dn_finalize(const Params& p, int layer, int nrows) {
  int tid_ = VTID;
  asm volatile("" : "+v"(tid_));
  const int tid = tid_;
  const u16* OB = (const u16*)(p.ws + O_OB);
  const u16* Z = (const u16*)(p.ws + O_Z);
  u16* act = (u16*)(p.ws + O_ACT);
  const int ntask = nrows * 32, stride = VG * 256;
  for (int id0 = VB * 256 + tid; id0 < ntask; id0 += 4 * stride) {
    u32x4 a[4], b[4], z[4];
#pragma unroll
    for (int u = 0; u < 4; ++u) {
      const int id = id0 + u * stride;
      const bool ok = id < ntask;
      const int row = ok ? (id >> 5) : 0, c8 = id & 31;
      a[u] = ldg16(act + (size_t)row * AP + 256 + c8 * 8);
      b[u] = ldg16(OB + (size_t)row * 256 + c8 * 8);
      z[u] = ldg16(Z + (size_t)row * ZW + C_BZ + c8 * 8);
    }
#pragma unroll
    for (int u = 0; u < 4; ++u) {
      const int id = id0 + u * stride;
      const int row = id >> 5, c8 = id & 31;
      float fa[8], fb[8], fz[8], o[8];
      unpack8(a[u], fa); unpack8(b[u], fb); unpack8(z[u], fz);
      float ss = 0.f;
#pragma unroll
      for (int e = 0; e < 8; ++e) { o[e] = fa[e] + fb[e]; ss += o[e] * o[e]; }
      ss += __shfl_xor(ss, 1); ss += __shfl_xor(ss, 2); ss += __shfl_xor(ss, 4);
      const float rn = rsqrtf(ss * (1.f / 64.f) + 1e-6f);
      const float4 g0 = *(const float4*)(p.dn_norm_g + layer * 64 + (c8 & 7) * 8), g1 = *(const float4*)(p.dn_norm_g + layer * 64 + (c8 & 7) * 8 + 4);
      const float gg[8] = {g0.x, g0.y, g0.z, g0.w, g1.x, g1.y, g1.z, g1.w};
#pragma unroll
      for (int e = 0; e < 8; ++e) o[e] = o[e] * rn * gg[e] * siluf(fz[e]);
      if (id < ntask) *(u32x4*)(act + (size_t)row * AP + 256 + c8 * 8) = pack8(o);
    }
  }
  const u16* ORB = (const u16*)(p.ws + O_ORB);
  for (int id0 = VB * 256 + tid; id0 < ntask; id0 += 4 * stride) {
    u32x4 a[4], b[4], z[4];
#pragma unroll
    for (int u = 0; u < 4; ++u) {
      const int id = id0 + u * stride;
      const bool ok = id < ntask;
      const int row = ok ? (id >> 5) : 0, c8 = id & 31;
      a[u] = ldg16(act + (size_t)row * AP + 512 + c8 * 8);
      b[u] = ldg16(ORB + (size_t)row * 256 + c8 * 8);
      z[u] = ldg16(Z + (size_t)row * ZW + C_CG + c8 * 8);
    }
#pragma unroll
    for (int u = 0; u < 4; ++u) {
      const int id = id0 + u * stride;
      const int row = id >> 5, c8 = id & 31;
      float fa[8], fb[8], fz[8], o[8];
      unpack8(a[u], fa); unpack8(b[u], fb); unpack8(z[u], fz);
      float sm = 0.f;
#pragma unroll
      for (int e = 0; e < 8; ++e) { o[e] = fa[e] + fb[e]; sm += o[e]; }
      sm += __shfl_xor(sm, 1); sm += __shfl_xor(sm, 2); sm += __shfl_xor(sm, 4);
      const float mean = sm * (1.f / 64.f);
      float ss = 0.f;
#pragma unroll
      for (int e = 0; e < 8; ++e) { o[e] -= mean; ss += o[e] * o[e]; }
      ss += __shfl_xor(ss, 1); ss += __shfl_xor(ss, 2); ss += __shfl_xor(ss, 4);
      const float rn = rsqrtf(ss * (1.f / 64.f) + 1e-6f);
      const float4 g0 = *(const float4*)(p.ret_norm_g + layer * 256 + c8 * 8), g1 = *(const float4*)(p.ret_norm_g + layer * 256 + c8 * 8 + 4);
      const float gg[8] = {g0.x, g0.y, g0.z, g0.w, g1.x, g1.y, g1.z, g1.w};
#pragma unroll
      for (int e = 0; e < 8; ++e) o[e] = o[e] * rn * gg[e] * siluf(fz[e]);
      if (id < ntask) *(u32x4*)(act + (size_t)row * AP + 512 + c8 * 8) = pack8(o);
    }
  }
}

DI void gbar(const Params& p, unsigned& target) {
  unsigned* bar = (unsigned*)(p.ws + O_CNT + 128);
  target += gridDim.x;
  __syncthreads();
  if (threadIdx.x == 0) {
    __builtin_amdgcn_fence(__ATOMIC_RELEASE, "agent");
    __hip_atomic_fetch_add(bar, 1u, __ATOMIC_RELAXED, __HIP_MEMORY_SCOPE_AGENT);
    while (__hip_atomic_load(bar, __ATOMIC_RELAXED, __HIP_MEMORY_SCOPE_AGENT) < target) __builtin_amdgcn_s_sleep(2);
    __builtin_amdgcn_fence(__ATOMIC_ACQUIRE, "agent");
  }
  __syncthreads();
}

__global__ void __launch_bounds__(512, 2) fwd_megakernel(Params p) {
  __shared__ __attribute__((aligned(16))) char lds_all[2 * LDS_BYTES];
  __shared__ int s_tile;
  char* lds = lds_all + VHALF * LDS_BYTES;
  cg::grid_group grid = cg::this_grid();
  if (p.ws == nullptr) grid.sync();
  unsigned bt = 0;
  phase0a(p, lds);
  gbar(p, bt);
  modulate_rows(p, 0, ROWS);
  gbar(p, bt);
  for (int layer = 0; layer < 2; ++layer) {
    const int nrows = layer == 0 ? ROWS : NLAT;
    gemm_phase(p, layer, 0, ROWS, lds_all);
    gbar(p, bt);
    prep_phase(p, layer, lds);
    gbar(p, bt);
    mixer_phase(p, layer, lds, lds_all, &s_tile);
    gbar(p, bt);
    gemm_phase(p, layer, 1, nrows, lds_all);
    gbar(p, bt);
    ln_rows(p, p.ln1_g + layer * DM, p.ln1_b + layer * DM, nrows, layer, 3, true);
    gbar(p, bt);
    gemm_phase(p, layer, 2, nrows, lds_all);
    gbar(p, bt);
    gemm_phase(p, layer, 3, nrows, lds_all);
    gbar(p, bt);
    ln_rows(p, p.ln2_g + layer * DM, p.ln2_b + layer * DM, nrows, layer == 0 ? 1 : 0, 0, layer == 0);
    if (layer == 0) gbar(p, bt);
  }
}

extern "C" void kernel_launch(void* const* d_in, const int* in_sizes, int n_in, void* d_out, int out_size, void* d_ws,
                              size_t ws_size, hipStream_t stream) {
  static int grid_blocks = 0;
  if (!grid_blocks) {
    int dev = 0, cus = 0, per_cu = 0;
    hipGetDevice(&dev);
    hipDeviceGetAttribute(&cus, hipDeviceAttributeMultiprocessorCount, dev);
    hipOccupancyMaxActiveBlocksPerMultiprocessor(&per_cu, fwd_megakernel, 512, 0);
    if (per_cu < 1) per_cu = 1;
    if (per_cu > 1) per_cu = 1;
    grid_blocks = cus * per_cu;
    if (ws_size < WS_END) fprintf(stderr, "kernel_launch: workspace too small: %zu < %zu\n", ws_size, (size_t)WS_END);
  }
  Params p{};
  const float** f = (const float**)&p;
  for (int i = 0; i < 25; ++i) f[i] = (const float*)d_in[i];
  p.out = (float*)d_out;
  p.ws = (unsigned char*)d_ws;
  hipMemsetAsync((char*)d_ws + O_CNT, 0, 256, stream);
  void* args[] = {&p};
  hipError_t e = hipLaunchCooperativeKernel((void*)fwd_megakernel, dim3(grid_blocks), dim3(512), args, 0, stream);
  if (e != hipSuccess) fprintf(stderr, "cooperative launch failed: %s (grid %d)\n", hipGetErrorString(e), grid_blocks);
}
```

```cpp
#include <hip/hip_runtime.h>
#include <hip/hip_cooperative_groups.h>
#include <cstdio>
namespace cg = cooperative_groups;

#define DI __device__ __forceinline__
typedef unsigned short u16;
typedef unsigned int u32;
using bf16x8 = __attribute__((ext_vector_type(8))) short;
using s16x4 = __attribute__((ext_vector_type(4))) short;
using f32x16 = __attribute__((ext_vector_type(16))) float;
typedef __bf16 bfv2 __attribute__((ext_vector_type(2)));
typedef float flv2 __attribute__((ext_vector_type(2)));
#define MFMA(a, b, c) __builtin_amdgcn_mfma_f32_32x32x16_bf16((a), (b), (c), 0, 0, 0)
#define VHALF ((int)__builtin_amdgcn_readfirstlane((int)(threadIdx.x >> 8)))
#define VTID ((int)(threadIdx.x & 255))
#define VB ((int)(blockIdx.x * 2 + VHALF))
#define VG ((int)(gridDim.x * 2))

constexpr int NB = 16, TT = 4096, LC = 256, DM = 1024, NLAT = NB * TT, NCTX = NB * LC, ROWS = NLAT + NCTX;
constexpr int ZW = 2816, DFF = 4096, NPOS = TT + LC;
constexpr int AP = 1152;
constexpr int WP = 1152;
constexpr int WP2 = 4224;
constexpr int HP = 4224;
constexpr int KVP = 576;
constexpr float LOG2E = 1.4426950408889634f;
constexpr float DN_ALPHA = 1.4142135623730951f;
constexpr int C_AQ = 0, C_AK = 256, C_AV = 384, C_BQKV = 512, C_BZ = 1280, C_BAB = 1536, C_CQ = 1552, C_CK = 1680,
              C_CV = 1808, C_CG = 2064, C_DCQ = 2320, C_DCKV = 2576, C_DKR = 2704;

constexpr size_t al256(size_t x) { return (x + 255) & ~size_t(255); }
constexpr size_t SZ_WIN = (size_t)ZW * WP * 2, SZ_WOUT = (size_t)DM * WP * 2, SZ_WFF = (size_t)DFF * WP * 2,
                 SZ_WUQ = 384 * 256 * 2, SZ_WUKV = 512 * 128 * 2;
constexpr size_t O_WIN = 0;
constexpr size_t O_WOUT = O_WIN + 2 * SZ_WIN;
constexpr size_t O_WFF1 = O_WOUT + 2 * SZ_WOUT;
constexpr size_t O_WFF2 = O_WFF1 + 2 * SZ_WFF;
constexpr size_t O_WUQ = O_WFF2 + 2 * SZ_WFF;
constexpr size_t O_WUKV = O_WUQ + 2 * SZ_WUQ;
constexpr size_t O_MOD = O_WUKV + 2 * SZ_WUKV;
constexpr size_t O_TAB = al256(O_MOD + 2 * 17 * 6144 * 4);
constexpr size_t O_CNT = O_TAB + (size_t)TT * 64 * 8;
constexpr size_t O_GRAW = O_CNT + 256;
constexpr size_t O_G2 = O_GRAW + (size_t)ROWS * 16 * 4;
constexpr size_t O_XC = O_G2 + (size_t)ROWS * 16 * 4;
constexpr size_t O_ACT = O_XC + (size_t)NCTX * DM * 4;
constexpr size_t O_Z = O_ACT + (size_t)ROWS * AP * 2;
constexpr size_t O_QA = O_Z + (size_t)ROWS * ZW * 2;
constexpr size_t O_KA = O_QA + (size_t)NB * 4 * NPOS * 64 * 2;
constexpr size_t O_QD = O_KA + (size_t)NB * 2 * NPOS * 64 * 2;
constexpr size_t O_KVD = O_QD + (size_t)ROWS * 384 * 2;
constexpr size_t O_KR = O_KVD + (size_t)ROWS * KVP * 2;
constexpr size_t O_QKVB = O_KR + (size_t)ROWS * 32 * 2;
constexpr size_t O_OB = O_QKVB + (size_t)ROWS * 768 * 2;
constexpr size_t O_QC = O_OB + (size_t)ROWS * 256 * 2;
constexpr size_t O_KC = O_QC + (size_t)ROWS * 128 * 2;
constexpr size_t O_ORB = O_KC + (size_t)ROWS * 128 * 2;
constexpr size_t O_ST = O_ORB + (size_t)ROWS * 256 * 2;
constexpr size_t WS_END = O_ST + (size_t)ROWS * 8;
static_assert(O_Z + (size_t)ROWS * HP * 2 <= WS_END, "hid alias");
static_assert((size_t)DM * WP2 * 2 <= SZ_WFF, "ff2 weights");
static_assert(WS_END <= (size_t)1073741824, "workspace");

constexpr int LDS_BYTES = 73728;

struct Params {
  const float *x, *c, *ctx, *c_ctx, *ada_w, *ada_b, *w_in, *swa_sink, *dn_conv_w, *dn_a_log, *dn_dt_bias, *dn_norm_g,
      *ret_l1m, *ret_norm_g, *mla_q_norm, *mla_w_uq, *mla_kv_norm, *mla_w_ukv, *w_out, *ln1_g, *ln1_b, *w_ff1, *w_ff2,
      *ln2_g, *ln2_b;
  float* out;
  unsigned char* ws;
};

DI u16 f2bf(float x) { return __builtin_bit_cast(u16, (__bf16)x); }
DI float bf2f(u16 v) { return __uint_as_float(((u32)v) << 16); }
DI u32 pack2(float a, float b) {
  flv2 f = {a, b};
  bfv2 v = __builtin_convertvector(f, bfv2);
  return __builtin_bit_cast(u32, v);
}
DI float bflo(u32 u) { return __uint_as_float(u << 16); }
DI float bfhi(u32 u) { return __uint_as_float(u & 0xffff0000u); }
DI int crow(int reg, int h) { return (reg & 3) + 8 * (reg >> 2) + 4 * h; }
DI float wave_sum(float v) {
#pragma unroll
  for (int o = 32; o >= 1; o >>= 1) v += __shfl_xor(v, o);
  return v;
}
DI float siluf(float x) { return x / (1.f + __expf(-x)); }
DI f32x16 zero16() {
  f32x16 z;
#pragma unroll
  for (int i = 0; i < 16; ++i) z[i] = 0.f;
  return z;
}

DI void scat8s(u16* base, int stride, const uint4& v, float f) {
  base[0 * stride] = f2bf(bflo(v.x) * f); base[1 * stride] = f2bf(bfhi(v.x) * f);
  base[2 * stride] = f2bf(bflo(v.y) * f); base[3 * stride] = f2bf(bfhi(v.y) * f);
  base[4 * stride] = f2bf(bflo(v.z) * f); base[5 * stride] = f2bf(bfhi(v.z) * f);
  base[6 * stride] = f2bf(bflo(v.w) * f); base[7 * stride] = f2bf(bfhi(v.w) * f);
}
DI void scat8r(u16* base, int stride, const uint4& v) {
  base[0 * stride] = (u16)(v.x & 0xffffu); base[1 * stride] = (u16)(v.x >> 16);
  base[2 * stride] = (u16)(v.y & 0xffffu); base[3 * stride] = (u16)(v.y >> 16);
  base[4 * stride] = (u16)(v.z & 0xffffu); base[5 * stride] = (u16)(v.z >> 16);
  base[6 * stride] = (u16)(v.w & 0xffffu); base[7 * stride] = (u16)(v.w >> 16);
}
DI float sumsq8(const uint4& u) {
  float s = 0.f, a;
  a = bflo(u.x); s += a * a; a = bfhi(u.x); s += a * a;
  a = bflo(u.y); s += a * a; a = bfhi(u.y); s += a * a;
  a = bflo(u.z); s += a * a; a = bfhi(u.z); s += a * a;
  a = bflo(u.w); s += a * a; a = bfhi(u.w); s += a * a;
  return s;
}
typedef u32 u32x4 __attribute__((ext_vector_type(4)));
DI u32x4 ldg16(const u16* p) { return *(const u32x4*)p; }
DI void unpack8(const u32x4& u, float* f) {
  f[0] = bflo(u[0]); f[1] = bfhi(u[0]); f[2] = bflo(u[1]); f[3] = bfhi(u[1]);
  f[4] = bflo(u[2]); f[5] = bfhi(u[2]); f[6] = bflo(u[3]); f[7] = bfhi(u[3]);
}
DI u32x4 pack8(const float* f) {
  u32x4 o;
  o[0] = pack2(f[0], f[1]); o[1] = pack2(f[2], f[3]); o[2] = pack2(f[4], f[5]); o[3] = pack2(f[6], f[7]);
  return o;
}
DI float* xrow(const Params& p, int row) {
  return row < NLAT ? p.out + (size_t)row * DM : (float*)(p.ws + O_XC) + (size_t)(row - NLAT) * DM;
}
DI const float* xrow0(const Params& p, int row) {
  return row < NLAT ? p.x + (size_t)row * DM : p.ctx + (size_t)(row - NLAT) * DM;
}
DI int rowb(int row) { return row < NLAT ? (row >> 12) : 16; }

constexpr int CSL = 132;
constexpr int GS = 72;
template <typename Epi>
DI void gemm_tile(const u16* __restrict__ A, int lda, const u16* __restrict__ Bt, int ldb, int K, char* lds, Epi epi) {
  u16* As = (u16*)lds;
  u16* Bs = As + 256 * GS;
  float* Cs = (float*)lds;
  int tid_ = VTID;
  asm volatile("" : "+v"(tid_));
  const int tid = tid_, wave = tid >> 6, lane = tid & 63, r = lane & 31, h = lane >> 5;
  const int wm = wave >> 1, wn = wave & 1;
  f32x16 acc[4][2];
#pragma unroll
  for (int i = 0; i < 4; ++i)
#pragma unroll
    for (int j = 0; j < 2; ++j) acc[i][j] = zero16();
  const int lrow = tid >> 3, lcol = (tid & 7) * 8;
  const u16* Ap = A + (size_t)lrow * lda + lcol;
  const u16* Bp = Bt + (size_t)lrow * ldb + lcol;
  u16* Aw = As + lrow * GS + lcol;
  u16* Bw = Bs + lrow * GS + lcol;
  u32x4 ra[8], rb[4];
#define GT_LOAD(k0)                                                                 \
  {                                                                                 \
    _Pragma("unroll") for (int i_ = 0; i_ < 8; ++i_) ra[i_] = ldg16(Ap + (size_t)(i_ * 32) * lda + (k0)); \
    _Pragma("unroll") for (int i_ = 0; i_ < 4; ++i_) rb[i_] = ldg16(Bp + (size_t)(i_ * 32) * ldb + (k0)); \
  }
#define GT_STORE()                                                                  \
  {                                                                                 \
    _Pragma("unroll") for (int i_ = 0; i_ < 8; ++i_) *(u32x4*)(Aw + i_ * 32 * GS) = ra[i_]; \
    _Pragma("unroll") for (int i_ = 0; i_ < 4; ++i_) *(u32x4*)(Bw + i_ * 32 * GS) = rb[i_]; \
  }
#define GT_COMPUTE()                                                                              \
  _Pragma("unroll") for (int ks = 0; ks < 4; ++ks) {                                              \
    bf16x8 fa[4], fb[2];                                                                          \
    _Pragma("unroll") for (int i_ = 0; i_ < 4; ++i_)                                              \
      fa[i_] = *(const bf16x8*)(As + (wm * 128 + i_ * 32 + r) * GS + ks * 16 + 8 * h);            \
    _Pragma("unroll") for (int j_ = 0; j_ < 2; ++j_)                                              \
      fb[j_] = *(const bf16x8*)(Bs + (wn * 64 + j_ * 32 + r) * GS + ks * 16 + 8 * h);             \
    _Pragma("unroll") for (int i_ = 0; i_ < 4; ++i_)                                              \
      _Pragma("unroll") for (int j_ = 0; j_ < 2; ++j_) acc[i_][j_] = MFMA(fa[i_], fb[j_], acc[i_][j_]); \
  }
  const int nk = K >> 6;
  GT_LOAD(0);
  for (int kt = 0; kt + 1 < nk; ++kt) {
    __syncthreads();
    GT_STORE();
    __syncthreads();
    GT_LOAD((kt + 1) << 6);
    GT_COMPUTE();
  }
  __syncthreads();
  GT_STORE();
  __syncthreads();
  GT_COMPUTE();
#pragma unroll 1
  for (int half = 0; half < 2; ++half) {
    __syncthreads();
    if (wm == half) {
#pragma unroll
      for (int i = 0; i < 4; ++i)
#pragma unroll
        for (int j = 0; j < 2; ++j)
#pragma unroll
          for (int g = 0; g < 16; ++g) Cs[(i * 32 + crow(g, h)) * CSL + wn * 64 + j * 32 + r] = acc[i][j][g];
    }
    __syncthreads();
    epi(half);
  }
}

constexpr int CSW = 264;
template <typename Epi>
DI void gemm_tile512(const u16* __restrict__ A, int lda, const u16* __restrict__ Bt, int ldb, int K, char* lds_all, Epi epi) {
  constexpr int STG = 2 * 256 * GS;
  u16* S0 = (u16*)lds_all;
  float* Cs = (float*)lds_all;
  int tid_ = threadIdx.x;
  asm volatile("" : "+v"(tid_));
  const int tid = tid_, wave = tid >> 6, lane = tid & 63, r = lane & 31, h = lane >> 5;
  const int wm = wave >> 2, wn = wave & 3;
  f32x16 acc[4][2];
#pragma unroll
  for (int i = 0; i < 4; ++i)
#pragma unroll
    for (int j = 0; j < 2; ++j) acc[i][j] = zero16();
  const int lrow = tid >> 3, lcol = (tid & 7) * 8;
  const u16* Ap = A + (size_t)lrow * lda + lcol;
  const u16* Bp = Bt + (size_t)lrow * ldb + lcol;
  u16* Sw = S0 + lrow * GS + lcol;
  u32x4 ra[4], rb[4];
#define G5_LOAD(k0)                                                                 \
  {                                                                                 \
    _Pragma("unroll") for (int i_ = 0; i_ < 4; ++i_) ra[i_] = ldg16(Ap + (size_t)(i_ * 64) * lda + (k0)); \
    _Pragma("unroll") for (int i_ = 0; i_ < 4; ++i_) rb[i_] = ldg16(Bp + (size_t)(i_ * 64) * ldb + (k0)); \
  }
#define G5_STORE(s)                                                                 \
  {                                                                                 \
    _Pragma("unroll") for (int i_ = 0; i_ < 4; ++i_) *(u32x4*)(Sw + (s) * STG + i_ * 64 * GS) = ra[i_]; \
    _Pragma("unroll") for (int i_ = 0; i_ < 4; ++i_) *(u32x4*)(Sw + (s) * STG + 256 * GS + i_ * 64 * GS) = rb[i_]; \
  }
#define G5_COMPUTE(s)                                                                             \
  {                                                                                               \
    __builtin_amdgcn_iglp_opt(1);         \
    const u16* As_ = S0 + (s) * STG;                                                              \
    const u16* Bs_ = As_ + 256 * GS;                                                              \
    _Pragma("unroll") for (int ks = 0; ks < 4; ++ks) {                                            \
      bf16x8 fa[4], fb[2];                                                                        \
      _Pragma("unroll") for (int i_ = 0; i_ < 4; ++i_)                                            \
        fa[i_] = *(const bf16x8*)(As_ + (wm * 128 + i_ * 32 + r) * GS + ks * 16 + 8 * h);         \
      _Pragma("unroll") for (int j_ = 0; j_ < 2; ++j_)                                            \
        fb[j_] = *(const bf16x8*)(Bs_ + (wn * 64 + j_ * 32 + r) * GS + ks * 16 + 8 * h);          \
      _Pragma("unroll") for (int i_ = 0; i_ < 4; ++i_)                                            \
        _Pragma("unroll") for (int j_ = 0; j_ < 2; ++j_) acc[i_][j_] = MFMA(fa[i_], fb[j_], acc[i_][j_]); \
    }                                                                                             \
  }
  const int nk = K >> 6;
  __syncthreads();
  G5_LOAD(0);
  G5_STORE(0);
  G5_LOAD(64);
  __syncthreads();
  for (int kt = 0; kt + 2 < nk; ++kt) {
    const int cur = kt & 1;
    G5_COMPUTE(cur);
    G5_STORE(cur ^ 1);
    G5_LOAD((kt + 2) << 6);
    __syncthreads();
  }
  {
    const int cur = (nk - 2) & 1;
    G5_COMPUTE(cur);
    G5_STORE(cur ^ 1);
    __syncthreads();
    G5_COMPUTE(cur ^ 1);
  }
#pragma unroll 1
  for (int half = 0; half < 2; ++half) {
    __syncthreads();
    if (wm == half) {
#pragma unroll
      for (int i = 0; i < 4; ++i)
#pragma unroll
        for (int j = 0; j < 2; ++j)
#pragma unroll
          for (int g = 0; g < 16; ++g) Cs[(i * 32 + crow(g, h)) * CSW + wn * 64 + j * 32 + r] = acc[i][j][g];
    }
    __syncthreads();
    epi(half);
  }
}

DI void wtrans_tile(const float* __restrict__ src, int K, int N, u16* __restrict__ dst, int ldw, int tk, int tn,
                    const float* __restrict__ kscale, char* lds) {
  float* t = (float*)lds;
  int tid_ = VTID;
  asm volatile("" : "+v"(tid_));
  const int tid = tid_, j = tid & 63, i0 = tid >> 6;
  const int k0 = tk * 64, n0 = tn * 64;
  __syncthreads();
#pragma unroll
  for (int q = 0; q < 16; ++q) {
    int i = i0 + 4 * q;
    float v = (n0 + j < N) ? src[(size_t)(k0 + i) * N + n0 + j] : 0.f;
    if (kscale) v *= kscale[k0 + i];
    t[i * 65 + j] = v;
  }
  __syncthreads();
#pragma unroll 4
  for (int q = 0; q < 16; ++q) {
    int jj = i0 + 4 * q;
    dst[(size_t)(n0 + jj) * ldw + k0 + j] = f2bf(t[j * 65 + jj]);
  }
}

DI void ada_tile(const Params& p, int layer, int cg64, char* lds) {
  float* sc = (float*)lds;
  int tid_ = VTID;
  asm volatile("" : "+v"(tid_));
  const int tid = tid_;
  __syncthreads();
  for (int e = tid; e < 17 * 1024; e += 256) {
    int bi = e >> 10, k = e & 1023;
    float v = bi < 16 ? p.c[bi * 1024 + k] : p.c_ctx[k];
    sc[e] = siluf(v);
  }
  __syncthreads();
  const int col = tid & 63, kq = tid >> 6;
  const int n = cg64 * 64 + col;
  const float* w = p.ada_w + (size_t)layer * 1024 * 6144 + n;
  float acc[17];
#pragma unroll
  for (int i = 0; i < 17; ++i) acc[i] = 0.f;
#pragma unroll 8
  for (int kk = 0; kk < 256; ++kk) {
    int k = kq * 256 + kk;
    float wv = w[(size_t)k * 6144];
#pragma unroll
    for (int i = 0; i < 17; ++i) acc[i] += sc[i * 1024 + k] * wv;
  }
  __syncthreads();
  float* red = (float*)lds;
#pragma unroll
  for (int i = 0; i < 17; ++i) red[(kq * 17 + i) * 64 + col] = acc[i];
  __syncthreads();
  float* mod = (float*)(p.ws + O_MOD) + (size_t)layer * 17 * 6144;
  for (int e = tid; e < 17 * 64; e += 256) {
    int bi = e >> 6, cc = e & 63;
    float s = red[(0 * 17 + bi) * 64 + cc] + red[(1 * 17 + bi) * 64 + cc] + red[(2 * 17 + bi) * 64 + cc] +
              red[(3 * 17 + bi) * 64 + cc];
    int nn = cg64 * 64 + cc;
    mod[bi * 6144 + nn] = s + p.ada_b[layer * 6144 + nn];
  }
}

DI void wtile(const Params& p, int layer, int q, char* lds) {
  if (q < 704) {
    wtrans_tile(p.w_in + (size_t)layer * 1024 * 2736, 1024, 2736, (u16*)(p.ws + O_WIN + layer * SZ_WIN), WP, q / 44, q % 44,
                nullptr, lds);
  } else if (q < 960) {
    q -= 704;
    wtrans_tile(p.w_out + (size_t)layer * 1024 * 1024, 1024, 1024, (u16*)(p.ws + O_WOUT + layer * SZ_WOUT), WP, q / 16, q % 16,
                nullptr, lds);
  } else if (q < 1984) {
    q -= 960;
    wtrans_tile(p.w_ff1 + (size_t)layer * 1024 * 4096, 1024, 4096, (u16*)(p.ws + O_WFF1 + layer * SZ_WFF), WP, q / 64, q % 64,
                nullptr, lds);
  } else if (q < 3008) {
    q -= 1984;
    wtrans_tile(p.w_ff2 + (size_t)layer * 4096 * 1024, 4096, 1024, (u16*)(p.ws + O_WFF2 + layer * SZ_WFF), WP2, q / 16, q % 16,
                nullptr, lds);
  } else if (q < 3032) {
    q -= 3008;
    wtrans_tile(p.mla_w_uq + (size_t)layer * 256 * 384, 256, 384, (u16*)(p.ws + O_WUQ + layer * SZ_WUQ), 256, q / 6, q % 6,
                p.mla_q_norm + layer * 256, lds);
  } else {
    q -= 3032;
    wtrans_tile(p.mla_w_ukv + (size_t)layer * 128 * 512, 128, 512, (u16*)(p.ws + O_WUKV + layer * SZ_WUKV), 128, q / 8, q % 8,
                p.mla_kv_norm + layer * 128, lds);
  }
}
DI void wtile_deferred(const Params& p, int d, char* lds) {
  if (d < 2304) wtile(p, 0, 704 + d, lds);
  else wtile(p, 1, d - 2304, lds);
}

DI void phase0a(const Params& p, char* lds) {
  int tid_ = VTID;
  asm volatile("" : "+v"(tid_));
  const int tid = tid_;
  for (int t = VB; t < 1192; t += VG) {
    if (t < 744) {
      wtile(p, 0, t < 704 ? t : 3008 + (t - 704), lds);
    } else if (t < 936) {
      int q = t - 744;
      ada_tile(p, q / 96, q % 96, lds);
    } else {
      int q = t - 936;
      float2* tab = (float2*)(p.ws + O_TAB);
      for (int e = q * 1024 + tid; e < (q + 1) * 1024; e += 256) {
        int tok = e >> 6, i = e & 63;
        float ang;
        if (i < 32) {
          int f = i & 15;
          float inv = powf(10000.f, -(float)(2 * f) / 32.f);
          ang = (float)(i < 16 ? (tok >> 6) : (tok & 63)) * inv;
        } else if (i < 48) {
          int f = i - 32;
          float inv = powf(10000.f, -(float)(2 * f) / 32.f);
          ang = (float)tok * inv;
        } else {
          int f = (i - 48) & 7;
          float inv = powf(10000.f, -(float)(2 * f) / 16.f);
          ang = (float)((i - 48) < 8 ? (tok >> 6) : (tok & 63)) * inv;
        }
        float sn, cs;
        sincosf(ang, &sn, &cs);
        tab[e] = make_float2(cs, sn);
      }
    }
  }
}

DI void modulate_rows(const Params& p, int layer_mod, int nrows) {
  int tid_ = VTID;
  asm volatile("" : "+v"(tid_));
  const int tid = tid_, wave = tid >> 6, lane = tid & 63;
  const float* mod = (const float*)(p.ws + O_MOD) + (size_t)layer_mod * 17 * 6144;
  u16* act = (u16*)(p.ws + O_ACT);
  const int stride = VG * 4;
  for (int row0 = VB * 4 + wave; row0 < nrows; row0 += 2 * stride) {
    const int row1 = row0 + stride;
    const bool has1 = row1 < nrows;
    float4 va[4], vb[4];
#pragma unroll
    for (int i = 0; i < 4; ++i) {
      va[i] = *(const float4*)(xrow0(p, row0) + (i * 64 + lane) * 4);
      vb[i] = has1 ? *(const float4*)(xrow0(p, row1) + (i * 64 + lane) * 4) : make_float4(0.f, 0.f, 0.f, 0.f);
    }
#pragma unroll
    for (int rr = 0; rr < 2; ++rr) {
      if (rr == 1 && !has1) break;
      const int row = rr ? row1 : row0;
      const float* m = mod + rowb(row) * 6144;
#pragma unroll
      for (int i = 0; i < 4; ++i) {
        int col = (i * 64 + lane) * 4;
        float4 v = rr ? vb[i] : va[i];
        float4 sh = *(const float4*)(m + col);
        float4 sc = *(const float4*)(m + 1024 + col);
        uint2 o;
        o.x = pack2(v.x * (1.f + sc.x) + sh.x, v.y * (1.f + sc.y) + sh.y);
        o.y = pack2(v.z * (1.f + sc.z) + sh.z, v.w * (1.f + sc.w) + sh.w);
        *(uint2*)(act + (size_t)row * AP + col) = o;
      }
    }
  }
}

DI void ln_rows(const Params& p, const float* g, const float* bb, int nrows, int mod_layer, int sh_chunk, bool write_act) {
  int tid_ = VTID;
  asm volatile("" : "+v"(tid_));
  const int tid = tid_, wave = tid >> 6, lane = tid & 63;
  u16* act = (u16*)(p.ws + O_ACT);
  const int stride = VG * 4;
  for (int row0 = VB * 4 + wave; row0 < nrows; row0 += 2 * stride) {
    const int row1 = row0 + stride;
    const bool has1 = row1 < nrows;
    float4 va[4], vb[4];
    float sa = 0.f, sb = 0.f;
#pragma unroll
    for (int i = 0; i < 4; ++i) {
      va[i] = *(const float4*)(xrow(p, row0) + (i * 64 + lane) * 4);
      vb[i] = has1 ? *(const float4*)(xrow(p, row1) + (i * 64 + lane) * 4) : make_float4(0.f, 0.f, 0.f, 0.f);
    }
#pragma unroll
    for (int i = 0; i < 4; ++i) {
      sa += va[i].x + va[i].y + va[i].z + va[i].w;
      sb += vb[i].x + vb[i].y + vb[i].z + vb[i].w;
    }
    const float ma = wave_sum(sa) * (1.f / 1024.f), mb = wave_sum(sb) * (1.f / 1024.f);
    float qa = 0.f, qb = 0.f;
#pragma unroll
    for (int i = 0; i < 4; ++i) {
      va[i].x -= ma; va[i].y -= ma; va[i].z -= ma; va[i].w -= ma;
      vb[i].x -= mb; vb[i].y -= mb; vb[i].z -= mb; vb[i].w -= mb;
      qa += va[i].x * va[i].x + va[i].y * va[i].y + va[i].z * va[i].z + va[i].w * va[i].w;
      qb += vb[i].x * vb[i].x + vb[i].y * vb[i].y + vb[i].z * vb[i].z + vb[i].w * vb[i].w;
    }
    const float ra = rsqrtf(wave_sum(qa) * (1.f / 1024.f) + 1e-5f), rb = rsqrtf(wave_sum(qb) * (1.f / 1024.f) + 1e-5f);
#pragma unroll
    for (int rr = 0; rr < 2; ++rr) {
      if (rr == 1 && !has1) break;
      const int row = rr ? row1 : row0;
      const float rstd = rr ? rb : ra;
      float* dst = xrow(p, row);
      if (write_act && lane == 0) ((float2*)(p.ws + O_ST))[row] = make_float2(rr ? mb : ma, rstd);
      const float* m = (const float*)(p.ws + O_MOD) + (size_t)mod_layer * 17 * 6144 + rowb(row) * 6144 + sh_chunk * 1024;
#pragma unroll
      for (int i = 0; i < 4; ++i) {
        int col = (i * 64 + lane) * 4;
        float4 v = rr ? vb[i] : va[i];
        float4 gg = *(const float4*)(g + col);
        float4 bv = *(const float4*)(bb + col);
        float4 y;
        y.x = v.x * rstd * gg.x + bv.x; y.y = v.y * rstd * gg.y + bv.y;
        y.z = v.z * rstd * gg.z + bv.z; y.w = v.w * rstd * gg.w + bv.w;
        if (!write_act) *(float4*)(dst + col) = y;
        if (write_act) {
          float4 sh = *(const float4*)(m + col);
          float4 sc = *(const float4*)(m + 1024 + col);
          uint2 o;
          o.x = pack2(y.x * (1.f + sc.x) + sh.x, y.y * (1.f + sc.y) + sh.y);
          o.y = pack2(y.z * (1.f + sc.z) + sh.z, y.w * (1.f + sc.w) + sh.w);
          *(uint2*)(act + (size_t)row * AP + col) = o;
        }
      }
    }
  }
}

DI void gemm_phase(const Params& p, int layer, int mode, int nrows, char* lds_all) {
  int tid_ = threadIdx.x;
  asm volatile("" : "+v"(tid_));
  const int tid = tid_;
  const float* Cs = (const float*)lds_all;
  int ntn, K, lda, ldb;
  const u16 *A, *Bt;
  if (mode == 0) { ntn = 11; K = 1024; lda = AP; ldb = WP; A = (const u16*)(p.ws + O_ACT); Bt = (const u16*)(p.ws + O_WIN + layer * SZ_WIN); }
  else if (mode == 1) { ntn = 4; K = 1024; lda = AP; ldb = WP; A = (const u16*)(p.ws + O_ACT); Bt = (const u16*)(p.ws + O_WOUT + layer * SZ_WOUT); }
  else if (mode == 2) { ntn = 16; K = 1024; lda = AP; ldb = WP; A = (const u16*)(p.ws + O_ACT); Bt = (const u16*)(p.ws + O_WFF1 + layer * SZ_WFF); }
  else { ntn = 4; K = 4096; lda = HP; ldb = WP2; A = (const u16*)(p.ws + O_Z); Bt = (const u16*)(p.ws + O_WFF2 + layer * SZ_WFF); }
  const int ntm = nrows >> 8;
  const float* mod = (const float*)(p.ws + O_MOD) + (size_t)layer * 17 * 6144;
  const bool swz = (gridDim.x & 7) == 0;
  const int xcd = swz ? (blockIdx.x & 7) : 0, nx = swz ? 8 : 1;
  const int jb = swz ? (blockIdx.x >> 3) : blockIdx.x, nj = swz ? (gridDim.x >> 3) : gridDim.x;
  const int per = 2 * ntn, nsr = ntm >> 1;
  for (int i = jb;; i += nj) {
    const int srl = i / per, rem = i - srl * per;
    const int sr = xcd + nx * srl;
    if (sr >= nsr) break;
    const int tn = rem >> 1, tm = sr * 2 + (rem & 1);
    const int m0 = tm * 256, n0 = tn * 256;
    gemm_tile512(A + (size_t)m0 * lda, lda, Bt + (size_t)n0 * ldb, ldb, K, lds_all, [&](int half) {
      if (mode == 0 || mode == 2) {
        for (int idx = tid; idx < 128 * 32; idx += 512) {
          const int rr = idx >> 5, c8 = (idx & 31) * 8;
          const int row = m0 + half * 128 + rr, col = n0 + c8;
          const float4 v0 = *(const float4*)(Cs + rr * CSW + c8), v1 = *(const float4*)(Cs + rr * CSW + c8 + 4);
          if (mode == 0) {
            uint4 o;
            o.x = pack2(v0.x, v0.y); o.y = pack2(v0.z, v0.w); o.z = pack2(v1.x, v1.y); o.w = pack2(v1.z, v1.w);
            *(uint4*)((u16*)(p.ws + O_Z) + (size_t)row * ZW + col) = o;
            if (n0 == C_BAB && c8 < 16) {
              *(float4*)((float*)(p.ws + O_GRAW) + (size_t)row * 16 + c8) = v0;
              *(float4*)((float*)(p.ws + O_GRAW) + (size_t)row * 16 + c8 + 4) = v1;
            }
          } else {
            const float a0 = fmaxf(v0.x, 0.f), a1 = fmaxf(v0.y, 0.f), a2 = fmaxf(v0.z, 0.f), a3 = fmaxf(v0.w, 0.f);
            const float a4 = fmaxf(v1.x, 0.f), a5 = fmaxf(v1.y, 0.f), a6 = fmaxf(v1.z, 0.f), a7 = fmaxf(v1.w, 0.f);
            uint4 o;
            o.x = pack2(a0 * a0, a1 * a1); o.y = pack2(a2 * a2, a3 * a3); o.z = pack2(a4 * a4, a5 * a5); o.w = pack2(a6 * a6, a7 * a7);
            *(uint4*)((u16*)(p.ws + O_Z) + (size_t)row * HP + col) = o;
          }
        }
      } else
      for (int idx = tid; idx < 128 * 64; idx += 512) {
        const int rr = idx >> 6, c4 = (idx & 63) * 4;
        const int row = m0 + half * 128 + rr, col = n0 + c4;
        float4 v = *(const float4*)(Cs + rr * CSW + c4);
        {
          const float* gate = mod + rowb(row) * 6144 + (mode == 1 ? 2 : 5) * 1024 + col;
          float4 gt = *(const float4*)gate;
          const float* res = (mode == 1 && layer == 0) ? xrow0(p, row) : xrow(p, row);
          float4 xr = *(const float4*)(res + col);
          if (!(mode == 1 && layer == 0)) {
            const float2 st = ((const float2*)(p.ws + O_ST))[row];
            const float* lg_ = (mode == 3) ? p.ln1_g + layer * DM : p.ln2_g + (layer - 1) * DM;
            const float* lb_ = (mode == 3) ? p.ln1_b + layer * DM : p.ln2_b + (layer - 1) * DM;
            const float4 lg4 = *(const float4*)(lg_ + col), lb4 = *(const float4*)(lb_ + col);
            xr.x = (xr.x - st.x) * st.y * lg4.x + lb4.x; xr.y = (xr.y - st.x) * st.y * lg4.y + lb4.y;
            xr.z = (xr.z - st.x) * st.y * lg4.z + lb4.z; xr.w = (xr.w - st.x) * st.y * lg4.w + lb4.w;
          }
          float4 o;
          o.x = DN_ALPHA * xr.x + gt.x * v.x; o.y = DN_ALPHA * xr.y + gt.y * v.y;
          o.z = DN_ALPHA * xr.z + gt.z * v.z; o.w = DN_ALPHA * xr.w + gt.w * v.w;
          *(float4*)(xrow(p, row) + col) = o;
        }
      }
    });
  }
}

DI void prep_swa(const Params& p, int tile) {
  int tid_ = VTID;
  asm volatile("" : "+v"(tid_));
  const int tid = tid_;
  const u16* Z = (const u16*)(p.ws + O_Z);
  const float4* tab = (const float4*)(p.ws + O_TAB);
  u16* QA = (u16*)(p.ws + O_QA);
  u16* KA = (u16*)(p.ws + O_KA);
  const int m0 = tile * 64;
  for (int jb = 0; jb < 6; jb += 3) {
    u32x4 x1[3], x2[3];
    float4 tb[3][4];
#pragma unroll
    for (int u = 0; u < 3; ++u) {
      const int id = tid + 256 * (jb + u), ri = id / 24, rem = id % 24, slot = rem >> 2, i8 = rem & 3;
      const int row = m0 + ri;
      const int base = slot < 4 ? C_AQ + slot * 64 : C_AK + (slot - 4) * 64;
      x1[u] = ldg16(Z + (size_t)row * ZW + base + i8 * 8);
      x2[u] = ldg16(Z + (size_t)row * ZW + base + 32 + i8 * 8);
      const int pos = row < NLAT ? (row & 4095) : 0;
#pragma unroll
      for (int e = 0; e < 4; ++e) tb[u][e] = tab[(pos * 64 + i8 * 8) / 2 + e];
    }
#pragma unroll
    for (int u = 0; u < 3; ++u) {
      const int id = tid + 256 * (jb + u), ri = id / 24, rem = id % 24, slot = rem >> 2, i8 = rem & 3;
      const int row = m0 + ri;
      const bool lat = row < NLAT;
      int b, pos;
      if (lat) { b = row >> 12; pos = row & 4095; } else { b = (row - NLAT) >> 8; pos = TT + ((row - NLAT) & 255); }
      float a1[8], a2[8], o1[8], o2[8];
      unpack8(x1[u], a1); unpack8(x2[u], a2);
      const float qs = slot < 4 ? 0.125f * LOG2E : 1.f;
#pragma unroll
      for (int e = 0; e < 4; ++e) {
        float c0 = lat ? tb[u][e].x : 1.f, s0 = lat ? tb[u][e].y : 0.f, c1 = lat ? tb[u][e].z : 1.f, s1 = lat ? tb[u][e].w : 0.f;
        o1[2 * e] = (a1[2 * e] * c0 - a2[2 * e] * s0) * qs;
        o2[2 * e] = (a1[2 * e] * s0 + a2[2 * e] * c0) * qs;
        o1[2 * e + 1] = (a1[2 * e + 1] * c1 - a2[2 * e + 1] * s1) * qs;
        o2[2 * e + 1] = (a1[2 * e + 1] * s1 + a2[2 * e + 1] * c1) * qs;
      }
      u16* d = slot < 4 ? QA + ((size_t)(b * 4 + slot) * NPOS + pos) * 64 : KA + ((size_t)(b * 2 + slot - 4) * NPOS + pos) * 64;
      *(u32x4*)(d + i8 * 8) = pack8(o1);
      *(u32x4*)(d + 32 + i8 * 8) = pack8(o2);
    }
  }
}

DI void prep_ret(const Params& p, int tile) {
  int tid_ = VTID;
  asm volatile("" : "+v"(tid_));
  const int tid = tid_;
  const u16* Z = (const u16*)(p.ws + O_Z);
  const float4* tab = (const float4*)(p.ws + O_TAB);
  u16* QC = (u16*)(p.ws + O_QC);
  u16* KC = (u16*)(p.ws + O_KC);
  const int m0 = tile * 64;
  u32x4 x1[4], x2[4];
  float4 tb[4][4];
#pragma unroll
  for (int u = 0; u < 4; ++u) {
    const int id = tid + 256 * u, ri = id >> 4, rem = id & 15, slot = rem >> 1, i8 = rem & 1;
    const int row = m0 + ri;
    const int base = C_CQ + slot * 32;
    x1[u] = ldg16(Z + (size_t)row * ZW + base + i8 * 8);
    x2[u] = ldg16(Z + (size_t)row * ZW + base + 16 + i8 * 8);
    const int pos = row < NLAT ? (row & 4095) : 0;
#pragma unroll
    for (int e = 0; e < 4; ++e) tb[u][e] = tab[(pos * 64 + 32 + i8 * 8) / 2 + e];
  }
#pragma unroll
  for (int u = 0; u < 4; ++u) {
    const int id = tid + 256 * u, ri = id >> 4, rem = id & 15, slot = rem >> 1, i8 = rem & 1;
    const int row = m0 + ri;
    const bool lat = row < NLAT;
    float a1[8], a2[8], o1[8], o2[8];
    unpack8(x1[u], a1); unpack8(x2[u], a2);
    const float qs = slot < 4 ? 0.17677669529663687f : 1.f;
#pragma unroll
    for (int e = 0; e < 4; ++e) {
      float c0 = lat ? tb[u][e].x : 1.f, s0 = lat ? tb[u][e].y : 0.f, c1 = lat ? tb[u][e].z : 1.f, s1 = lat ? tb[u][e].w : 0.f;
      o1[2 * e] = (a1[2 * e] * c0 - a2[2 * e] * s0) * qs;
      o2[2 * e] = (a1[2 * e] * s0 + a2[2 * e] * c0) * qs;
      o1[2 * e + 1] = (a1[2 * e + 1] * c1 - a2[2 * e + 1] * s1) * qs;
      o2[2 * e + 1] = (a1[2 * e + 1] * s1 + a2[2 * e + 1] * c1) * qs;
    }
    u16* d = slot < 4 ? QC + (size_t)row * 128 + slot * 32 : KC + (size_t)row * 128 + (slot - 4) * 32;
    *(u32x4*)(d + i8 * 8) = pack8(o1);
    *(u32x4*)(d + 16 + i8 * 8) = pack8(o2);
  }
}

DI void prep_dn(const Params& p, int layer, int tile, char* lds) {
  int tid_ = VTID;
  asm volatile("" : "+v"(tid_));
  const int tid = tid_;
  const u16* Z = (const u16*)(p.ws + O_Z);
  u16* QKVB = (u16*)(p.ws + O_QKVB);
  float* cw = (float*)lds;
  const int m0 = tile * 64;
  __syncthreads();
  for (int e = tid; e < 3840; e += 256) cw[e] = p.dn_conv_w[(size_t)layer * 3840 + e];
  __syncthreads();
  for (int jb = 0; jb < 24; jb += 4) {
    u32x4 xr[4][5];
#pragma unroll
    for (int u = 0; u < 4; ++u) {
      const int id = tid + 256 * (jb + u), ri = id / 96, ch8 = id % 96;
      const int row = m0 + ri;
      int tpos, seqn;
      if (row < NLAT) { tpos = row & 4095; seqn = TT; } else { tpos = (row - NLAT) & 255; seqn = LC; }
      const u16* zc = Z + (size_t)row * ZW + C_BQKV + ch8 * 8;
#pragma unroll
      for (int j = 0; j < 5; ++j) {
        const int tp = tpos + j - 2;
        u32x4 zz = {0u, 0u, 0u, 0u};
        xr[u][j] = (tp >= 0 && tp < seqn) ? ldg16(zc + (j - 2) * ZW) : zz;
      }
    }
#pragma unroll
    for (int u = 0; u < 4; ++u) {
      const int id = tid + 256 * (jb + u), ri = id / 96, ch8 = id % 96;
      const int row = m0 + ri;
      float acc[8];
#pragma unroll
      for (int e = 0; e < 8; ++e) acc[e] = 0.f;
#pragma unroll
      for (int j = 0; j < 5; ++j) {
        float x[8];
        unpack8(xr[u][j], x);
        const float4 w0 = *(const float4*)(cw + j * 768 + ch8 * 8), w1 = *(const float4*)(cw + j * 768 + ch8 * 8 + 4);
        acc[0] += x[0] * w0.x; acc[1] += x[1] * w0.y; acc[2] += x[2] * w0.z; acc[3] += x[3] * w0.w;
        acc[4] += x[4] * w1.x; acc[5] += x[5] * w1.y; acc[6] += x[6] * w1.z; acc[7] += x[7] * w1.w;
      }
      float ss = 0.f;
#pragma unroll
      for (int e = 0; e < 8; ++e) { acc[e] = siluf(acc[e]); ss += acc[e] * acc[e]; }
      ss += __shfl_xor(ss, 1); ss += __shfl_xor(ss, 2); ss += __shfl_xor(ss, 4);
      const int grp = ch8 >> 3;
      const float sc = grp < 8 ? rsqrtf(ss + 1e-6f) * (grp < 4 ? 0.125f : 1.f) : 1.f;
#pragma unroll
      for (int e = 0; e < 8; ++e) acc[e] *= sc;
      *(u32x4*)(QKVB + (size_t)row * 768 + ch8 * 8) = pack8(acc);
    }
  }
  const float* graw = (const float*)(p.ws + O_GRAW);
  float* g2 = (float*)(p.ws + O_G2);
  for (int e = tid; e < 64 * 8; e += 256) {
    int ri = e >> 3, dh = e & 7, dir = dh >> 2, hh = dh & 3;
    int row = m0 + ri;
    float ra = graw[(size_t)row * 16 + dir * 8 + hh], rb = graw[(size_t)row * 16 + dir * 8 + 4 + hh];
    float xx = ra + p.dn_dt_bias[layer * 8 + dh];
    float sp = xx > 20.f ? xx : log1pf(expf(xx));
    float lg = -expf(p.dn_a_log[layer * 8 + dh]) * sp;
    float beta = 1.f / (1.f + expf(-rb));
    g2[(size_t)row * 16 + dh] = lg;
    g2[(size_t)row * 16 + 8 + dh] = beta;
  }
}

DI void prep_mla(const Params& p, int layer, int tm, int which, int nt, char* lds) {
  int tid_ = VTID;
  asm volatile("" : "+v"(tid_));
  const int tid = tid_;
  const u16* Z = (const u16*)(p.ws + O_Z);
  const int m0 = tm * 256;
  float* rs = (float*)(lds + 128 * CSL * 4);
  const int KK = which == 0 ? 256 : 128;
  const int cbase = which == 0 ? C_DCQ : C_DCKV;
  __syncthreads();
  {
    const u16* src = Z + (size_t)(m0 + tid) * ZW + cbase;
    float s = 0.f;
    for (int i = 0; i < KK / 8; i += 4) {
      u32x4 u0 = ldg16(src + i * 8), u1 = ldg16(src + i * 8 + 8), u2 = ldg16(src + i * 8 + 16), u3 = ldg16(src + i * 8 + 24);
      float f[8];
      unpack8(u0, f);
#pragma unroll
      for (int e = 0; e < 8; ++e) s += f[e] * f[e];
      unpack8(u1, f);
#pragma unroll
      for (int e = 0; e < 8; ++e) s += f[e] * f[e];
      unpack8(u2, f);
#pragma unroll
      for (int e = 0; e < 8; ++e) s += f[e] * f[e];
      unpack8(u3, f);
#pragma unroll
      for (int e = 0; e < 8; ++e) s += f[e] * f[e];
    }
    rs[tid] = rsqrtf(s / (float)KK + 1e-6f);
  }
  const u16* Bt = which == 0 ? (const u16*)(p.ws + O_WUQ + layer * SZ_WUQ) + (size_t)nt * 128 * 256
                             : (const u16*)(p.ws + O_WUKV + layer * SZ_WUKV) + (size_t)nt * 128 * 128;
  const float* Cs = (const float*)lds;
  const float2* tab = (const float2*)(p.ws + O_TAB);
  gemm_tile(Z + (size_t)m0 * ZW + cbase, ZW, Bt, KK, KK, lds, [&](int half) {
    if (which == 0) {
      u16* QD = (u16*)(p.ws + O_QD);
      const float qs = 0.10206207261596575f * LOG2E;
      for (int idx = tid; idx < 128 * 32; idx += 256) {
        const int rr = idx >> 5, c4 = (idx & 31) * 4;
        const int row = m0 + half * 128 + rr;
        const float sc = rs[half * 128 + rr] * qs;
        float o[4];
#pragma unroll
        for (int j = 0; j < 4; ++j) {
          int cl = c4 + j, c = nt * 128 + cl, d = c % 96;
          float v = Cs[rr * CSL + cl];
          if (d >= 64 && row < NLAT) {
            int i = d - 64;
            if (i < 16) {
              float2 t = tab[(row & 4095) * 64 + 48 + i];
              float x2 = Cs[rr * CSL + cl + 16];
              v = v * t.x - x2 * t.y;
            } else {
              float2 t = tab[(row & 4095) * 64 + 48 + i - 16];
              float x1 = Cs[rr * CSL + cl - 16];
              v = x1 * t.y + v * t.x;
            }
          }
          o[j] = v * sc;
        }
        uint2 w;
        w.x = pack2(o[0], o[1]); w.y = pack2(o[2], o[3]);
        *(uint2*)(QD + (size_t)row * 384 + nt * 128 + c4) = w;
      }
    } else {
      u16* KVD = (u16*)(p.ws + O_KVD);
      for (int idx = tid; idx < 128 * 32; idx += 256) {
        const int rr = idx >> 5, c4 = (idx & 31) * 4;
        const int row = m0 + half * 128 + rr;
        const float sc = rs[half * 128 + rr];
        float4 v = *(const float4*)(Cs + rr * CSL + c4);
        uint2 w;
        w.x = pack2(v.x * sc, v.y * sc); w.y = pack2(v.z * sc, v.w * sc);
        *(uint2*)(KVD + (size_t)row * KVP + nt * 128 + c4) = w;
      }
    }
  });
  if (which == 1 && nt == 0) {
    u16* KR = (u16*)(p.ws + O_KR);
    for (int e = tid; e < 256 * 16; e += 256) {
      int rr = e >> 4, i = e & 15, row = m0 + rr;
      float cs = 1.f, sn = 0.f;
      if (row < NLAT) { float2 t = tab[(row & 4095) * 64 + 48 + i]; cs = t.x; sn = t.y; }
      float x1 = bf2f(Z[(size_t)row * ZW + C_DKR + i]), x2 = bf2f(Z[(size_t)row * ZW + C_DKR + 16 + i]);
      KR[(size_t)row * 32 + i] = f2bf(x1 * cs - x2 * sn);
      KR[(size_t)row * 32 + 16 + i] = f2bf(x1 * sn + x2 * cs);
    }
  }
}

DI void prep_phase(const Params& p, int layer, char* lds) {
  const int total = 3264 + 816 + 1088;
  for (int t = VB; t < total; t += VG) {
    if (t < 1088) prep_swa(p, t);
    else if (t < 2176) prep_ret(p, t - 1088);
    else if (t < 3264) prep_dn(p, layer, t - 2176, lds);
    else if (t < 3264 + 816) { int q = t - 3264; prep_mla(p, layer, q / 3, 0, q % 3, lds); }
    else { int q = t - 3264 - 816; prep_mla(p, layer, q / 4, 1, q % 4, lds); }
  }
}

struct Seg {
  const u16* k; const u16* k2; const u16* v;
  int ldk, ldk2, ldv, n, pos0, masked;
};

template <int DQK>
DI void attn_tile(const u16* __restrict__ q, int ldq, int qpos0, const Seg& s0, const Seg& s1, int nseg, bool has_sink,
                  float sinkl2, u16* __restrict__ out, int ldo, char* lds) {
  constexpr int KST = DQK + 8;
  constexpr int CPK = DQK / 8;
  constexpr int NKS = DQK / 16;
  constexpr int VST = 96;
  u16* Ks = (u16*)lds;
  u16* Vs = Ks + 64 * KST;
  int ltid_ = threadIdx.x;
  asm volatile("" : "+v"(ltid_));
  const int ltid = ltid_;
  const int tid = ltid & 255, wave = tid >> 6, lane = tid & 63, r = lane & 31, h = lane >> 5;
  const int qi = wave * 32 + r;
  bf16x8 qf[NKS];
#pragma unroll
  for (int ks = 0; ks < NKS; ++ks) qf[ks] = *(const bf16x8*)(q + (size_t)qi * ldq + ks * 16 + 8 * h);
  const int nt0 = s0.n >> 6;
  const int NT = nt0 + (nseg > 1 ? (s1.n >> 6) : 0);
  uint4 kreg0, kreg1 = make_uint4(0, 0, 0, 0), vreg0;
  uint4 krgB0, krgB1 = make_uint4(0, 0, 0, 0), vrgB0;
  const int kkey0 = ltid / CPK, kpart0 = ltid % CPK;
  const int kkey1 = (ltid + 512) / CPK, kpart1 = (ltid + 512) % CPK;
  const bool k1 = (CPK == 12) && (ltid < 256);
  const int vkey = ltid >> 3, vpart = ltid & 7;
  typedef __attribute__((address_space(3))) const char* lds_cptr;
  typedef short v4i16_t __attribute__((ext_vector_type(4)));
  const lds_cptr vp0 = (lds_cptr)Vs + (4 * h + ((lane & 15) >> 2)) * (VST * 2) + ((lane >> 4) & 1) * 32 + (lane & 3) * 8;
#define ATT_VTR(p) __builtin_bit_cast(s16x4, __builtin_amdgcn_ds_read_tr16_b64_v4i16((__attribute__((address_space(3))) v4i16_t*)(p)))
#define ATT_KSRC(sg, off, key, part) \
  (((part) < 8) ? (sg).k + (size_t)((off) + (key)) * (sg).ldk + (part) * 8 : (sg).k2 + (size_t)((off) + (key)) * (sg).ldk2 + ((part) - 8) * 8)
#define ATT_LOADX(i, K0, K1, V0)                                                            \
  {                                                                                         \
    const Seg& sgl = ((i) < nt0) ? s0 : s1;                                                 \
    const int offl = (((i) < nt0) ? (i) : (i) - nt0) << 6;                                  \
    K0 = *(const uint4*)ATT_KSRC(sgl, offl, kkey0, kpart0);                                 \
    if (k1) K1 = *(const uint4*)ATT_KSRC(sgl, offl, kkey1, kpart1);                         \
    V0 = *(const uint4*)(sgl.v + (size_t)(offl + vkey) * sgl.ldv + vpart * 8);              \
  }
  f32x16 o0 = zero16(), o1 = zero16();
  float m = -1e30f, l = 0.f;
#define ATT_STOREX(K0, K1, V0)                                               \
  {                                                                           \
    *(uint4*)(Ks + kkey0 * KST + kpart0 * 8) = K0;                            \
    if (k1) *(uint4*)(Ks + kkey1 * KST + kpart1 * 8) = K1;                    \
    *(uint4*)(Vs + vkey * VST + vpart * 8) = V0;                              \
  }
  auto compute = [&](int i) {
    const Seg& sg = (i < nt0) ? s0 : s1;
    const int off = ((i < nt0) ? i : i - nt0) << 6;
    f32x16 sa = zero16(), sb = zero16();
#pragma unroll
    for (int ks = 0; ks < NKS; ++ks) {
      bf16x8 a0 = *(const bf16x8*)(Ks + r * KST + ks * 16 + 8 * h);
      bf16x8 a1 = *(const bf16x8*)(Ks + (32 + r) * KST + ks * 16 + 8 * h);
      sa = MFMA(a0, qf[ks], sa);
      sb = MFMA(a1, qf[ks], sb);
    }
    if (sg.masked) {
      const int qpos = qpos0 + qi;
      const int kb = sg.pos0 + off;
#pragma unroll
      for (int g = 0; g < 16; ++g) {
        int d0 = kb + crow(g, h) - qpos, d1 = d0 + 32;
        if (d0 > 128 || d0 < -128) sa[g] = -INFINITY;
        if (d1 > 128 || d1 < -128) sb[g] = -INFINITY;
      }
    }
    float mx = sa[0];
#pragma unroll
    for (int g = 1; g < 16; ++g) mx = fmaxf(mx, sa[g]);
#pragma unroll
    for (int g = 0; g < 16; ++g) mx = fmaxf(mx, sb[g]);
    mx = fmaxf(mx, __shfl_xor(mx, 32));
    const float mn = fmaxf(m, mx);
    const float alpha = __builtin_amdgcn_exp2f(m - mn);
    m = mn;
    float ps = 0.f;
#pragma unroll
    for (int g = 0; g < 16; ++g) { sa[g] = __builtin_amdgcn_exp2f(sa[g] - mn); ps += sa[g]; }
#pragma unroll
    for (int g = 0; g < 16; ++g) { sb[g] = __builtin_amdgcn_exp2f(sb[g] - mn); ps += sb[g]; }
    l = l * alpha + ps;
#pragma unroll
    for (int g = 0; g < 16; ++g) { o0[g] *= alpha; o1[g] *= alpha; }
#pragma unroll
    for (int kt = 0; kt < 2; ++kt) {
#pragma unroll
      for (int s = 0; s < 2; ++s) {
        const f32x16& sv = kt == 0 ? sa : sb;
        uint4 pu;
        pu.x = pack2(sv[8 * s + 0], sv[8 * s + 1]); pu.y = pack2(sv[8 * s + 2], sv[8 * s + 3]);
        pu.z = pack2(sv[8 * s + 4], sv[8 * s + 5]); pu.w = pack2(sv[8 * s + 6], sv[8 * s + 7]);
        bf16x8 pf = __builtin_bit_cast(bf16x8, pu);
        const lds_cptr vp = vp0 + (kt * 32 + 16 * s) * (VST * 2);
        {
          s16x4 lo = ATT_VTR(vp);
          s16x4 hi = ATT_VTR(vp + 8 * VST * 2);
          bf16x8 vf = __builtin_shufflevector(lo, hi, 0, 1, 2, 3, 4, 5, 6, 7);
          o0 = MFMA(vf, pf, o0);
        }
        {
          s16x4 lo = ATT_VTR(vp + 64);
          s16x4 hi = ATT_VTR(vp + 8 * VST * 2 + 64);
          bf16x8 vf = __builtin_shufflevector(lo, hi, 0, 1, 2, 3, 4, 5, 6, 7);
          o1 = MFMA(vf, pf, o1);
        }
      }
    }
  };
  ATT_LOADX(0, kreg0, kreg1, vreg0);
  ATT_LOADX(1, krgB0, krgB1, vrgB0);
  for (int i = 0; i < NT; i += 2) {
    __syncthreads();
    ATT_STOREX(kreg0, kreg1, vreg0);
    __syncthreads();
    if (i + 2 < NT) ATT_LOADX(i + 2, kreg0, kreg1, vreg0);
    compute(i);
    __syncthreads();
    ATT_STOREX(krgB0, krgB1, vrgB0);
    __syncthreads();
    if (i + 3 < NT) ATT_LOADX(i + 3, krgB0, krgB1, vrgB0);
    compute(i + 1);
  }
  float lt = l + __shfl_xor(l, 32);
  if (has_sink) lt += __builtin_amdgcn_exp2f(sinkl2 - m);
  const float inv = 1.f / lt;
#pragma unroll
  for (int g = 0; g < 4; ++g) {
    uint2 w;
    w.x = pack2(o0[4 * g] * inv, o0[4 * g + 1] * inv); w.y = pack2(o0[4 * g + 2] * inv, o0[4 * g + 3] * inv);
    *(uint2*)(out + (size_t)qi * ldo + 8 * g + 4 * h) = w;
    w.x = pack2(o1[4 * g] * inv, o1[4 * g + 1] * inv); w.y = pack2(o1[4 * g + 2] * inv, o1[4 * g + 3] * inv);
    *(uint2*)(out + (size_t)qi * ldo + 32 + 8 * g + 4 * h) = w;
  }
}

DI void mla_attn(const Params& p, int idx, char* lds) {
  const u16* QD = (const u16*)(p.ws + O_QD);
  const u16* KVD = (const u16*)(p.ws + O_KVD);
  const u16* KR = (const u16*)(p.ws + O_KR);
  u16* act = (u16*)(p.ws + O_ACT);
  Seg lat, cx;
  int b, hh, row0;
  bool is_ctx = idx >= 2048;
  if (!is_ctx) { b = idx >> 7; hh = (idx >> 5) & 3; row0 = b * TT + (idx & 31) * 128; }
  else { int q = idx - 2048; b = q >> 3; hh = (q >> 1) & 3; row0 = NLAT + b * LC + (q & 1) * 128; }
  const size_t lr = (size_t)b * TT, cr = (size_t)NLAT + b * LC;
  lat.k = KVD + lr * KVP + hh * 128; lat.ldk = KVP; lat.k2 = KR + lr * 32; lat.ldk2 = 32; lat.v = KVD + lr * KVP + hh * 128 + 64;
  lat.ldv = KVP; lat.n = TT; lat.pos0 = 0; lat.masked = 0;
  cx.k = KVD + cr * KVP + hh * 128; cx.ldk = KVP; cx.k2 = KR + cr * 32; cx.ldk2 = 32; cx.v = KVD + cr * KVP + hh * 128 + 64;
  cx.ldv = KVP; cx.n = LC; cx.pos0 = 0; cx.masked = 0;
  const u16* q = QD + (size_t)row0 * 384 + hh * 96;
  u16* o = act + (size_t)row0 * AP + 768 + hh * 64;
  if (!is_ctx) attn_tile<96>(q, 384, 0, lat, cx, 2, false, 0.f, o, AP, lds);
  else attn_tile<96>(q, 384, 0, cx, cx, 1, false, 0.f, o, AP, lds);
}

DI void swa_attn(const Params& p, int layer, int idx, char* lds) {
  const u16* QA = (const u16*)(p.ws + O_QA);
  const u16* KA = (const u16*)(p.ws + O_KA);
  const u16* Z = (const u16*)(p.ws + O_Z);
  u16* act = (u16*)(p.ws + O_ACT);
  Seg loc, cx;
  int b, hh, row0, pos0q;
  bool is_ctx = idx >= 2048;
  int nb = 0;
  if (!is_ctx) { b = idx >> 7; hh = ((idx >> 6) & 1) * 2 + (idx & 1); nb = (idx >> 1) & 31; pos0q = nb * 128; row0 = b * TT + pos0q; }
  else { int q = idx - 2048; b = q >> 3; hh = (q >> 1) & 3; pos0q = TT + (q & 1) * 128; row0 = NLAT + b * LC + (q & 1) * 128; }
  const int hk = hh >> 1;
  const u16* kbase = KA + (size_t)(b * 2 + hk) * NPOS * 64;
  cx.k = kbase + (size_t)TT * 64; cx.ldk = 64; cx.k2 = cx.k; cx.ldk2 = 64;
  cx.v = Z + ((size_t)NLAT + b * LC) * ZW + C_AV + hk * 64; cx.ldv = ZW; cx.n = LC; cx.pos0 = 0; cx.masked = 0;
  const float sinkl2 = p.swa_sink[layer * 4 + hh] * LOG2E;
  const u16* q = QA + ((size_t)(b * 4 + hh) * NPOS + pos0q) * 64;
  u16* o = act + (size_t)row0 * AP + hh * 64;
  if (!is_ctx) {
    int ks = nb * 128 - 128; if (ks < 0) ks = 0;
    int ke = nb * 128 + 256; if (ke > TT) ke = TT;
    loc.k = kbase + (size_t)ks * 64; loc.ldk = 64; loc.k2 = loc.k; loc.ldk2 = 64;
    loc.v = Z + ((size_t)b * TT + ks) * ZW + C_AV + hk * 64; loc.ldv = ZW; loc.n = ke - ks; loc.pos0 = ks; loc.masked = 1;
    attn_tile<64>(q, 64, pos0q, loc, cx, 2, true, sinkl2, o, AP, lds);
  } else {
    attn_tile<64>(q, 64, 0, cx, cx, 1, true, sinkl2, o, AP, lds);
  }
}

constexpr int LS = 72;
template <int KS>
DI f32x16 mm64(const u16* A, int lda, const u16* Bt, int ldb, int wm, int wn, int r, int h) {
  f32x16 acc = zero16();
#pragma unroll
  for (int s = 0; s < KS; ++s) {
    bf16x8 a = *(const bf16x8*)(A + (wm * 32 + r) * lda + s * 16 + 8 * h);
    bf16x8 b = *(const bf16x8*)(Bt + (wn * 32 + r) * ldb + s * 16 + 8 * h);
    acc = MFMA(a, b, acc);
  }
  return acc;
}
DI void st_straight(u16* D, int ld, const f32x16& v, int wm, int wn, int r, int h) {
#pragma unroll
  for (int g = 0; g < 16; ++g) D[(wm * 32 + crow(g, h)) * ld + wn * 32 + r] = f2bf(v[g]);
}
DI void st_transp(u16* D, int ld, const f32x16& v, int wm, int wn, int r, int h) {
#pragma unroll
  for (int g = 0; g < 4; ++g) {
    uint2 w;
    w.x = pack2(v[4 * g], v[4 * g + 1]); w.y = pack2(v[4 * g + 2], v[4 * g + 3]);
    *(uint2*)(D + (wn * 32 + r) * ld + wm * 32 + 8 * g + 4 * h) = w;
  }
}

template <int KS>
DI f32x16 mm64t(const u16* AT, int lda, const u16* Bt, int ldb, int wm, int wn, int r, int h, int lane) {
  typedef __attribute__((address_space(3))) const char* lds_cptr;
  typedef short v4i16_t __attribute__((ext_vector_type(4)));
  const lds_cptr base = (lds_cptr)AT + ((lane & 15) >> 2) * (lda * 2) + (wm * 32 + ((lane >> 4) & 1) * 16) * 2 + (lane & 3) * 8;
  f32x16 acc = zero16();
#pragma unroll
  for (int s = 0; s < KS; ++s) {
    s16x4 lo = __builtin_bit_cast(s16x4, __builtin_amdgcn_ds_read_tr16_b64_v4i16((__attribute__((address_space(3))) v4i16_t*)(base + (16 * s + 8 * h) * (lda * 2))));
    s16x4 hi = __builtin_bit_cast(s16x4, __builtin_amdgcn_ds_read_tr16_b64_v4i16((__attribute__((address_space(3))) v4i16_t*)(base + (16 * s + 8 * h + 4) * (lda * 2))));
    bf16x8 a = __builtin_shufflevector(lo, hi, 0, 1, 2, 3, 4, 5, 6, 7);
    bf16x8 b = *(const bf16x8*)(Bt + (wn * 32 + r) * ldb + s * 16 + 8 * h);
    acc = MFMA(a, b, acc);
  }
  return acc;
}

template <int KS, bool ATR, bool BTR>
DI f32x16 mm64x(const u16* A, int lda, const u16* B, int ldb, int wm, int wn, int r, int h, int lane) {
  typedef __attribute__((address_space(3))) const char* lds_cptr;
  typedef short v4i16_t __attribute__((ext_vector_type(4)));
  const int sub = ((lane & 15) >> 2), cb = ((lane >> 4) & 1) * 16, pb = (lane & 3) * 8;
  const lds_cptr abase = (lds_cptr)A + sub * (lda * 2) + (wm * 32 + cb) * 2 + pb;
  const lds_cptr bbase = (lds_cptr)B + sub * (ldb * 2) + (wn * 32 + cb) * 2 + pb;
  f32x16 acc = zero16();
#pragma unroll
  for (int s = 0; s < KS; ++s) {
    bf16x8 a, b;
    if (ATR) {
      s16x4 lo = __builtin_bit_cast(s16x4, __builtin_amdgcn_ds_read_tr16_b64_v4i16((__attribute__((address_space(3))) v4i16_t*)(abase + (16 * s + 8 * h) * (lda * 2))));
      s16x4 hi = __builtin_bit_cast(s16x4, __builtin_amdgcn_ds_read_tr16_b64_v4i16((__attribute__((address_space(3))) v4i16_t*)(abase + (16 * s + 8 * h + 4) * (lda * 2))));
      a = __builtin_shufflevector(lo, hi, 0, 1, 2, 3, 4, 5, 6, 7);
    } else {
      a = *(const bf16x8*)(A + (wm * 32 + r) * lda + s * 16 + 8 * h);
    }
    if (BTR) {
      s16x4 lo = __builtin_bit_cast(s16x4, __builtin_amdgcn_ds_read_tr16_b64_v4i16((__attribute__((address_space(3))) v4i16_t*)(bbase + (16 * s + 8 * h) * (ldb * 2))));
      s16x4 hi = __builtin_bit_cast(s16x4, __builtin_amdgcn_ds_read_tr16_b64_v4i16((__attribute__((address_space(3))) v4i16_t*)(bbase + (16 * s + 8 * h + 4) * (ldb * 2))));
      b = __builtin_shufflevector(lo, hi, 0, 1, 2, 3, 4, 5, 6, 7);
    } else {
      b = *(const bf16x8*)(B + (wn * 32 + r) * ldb + s * 16 + 8 * h);
    }
    acc = MFMA(a, b, acc);
  }
  return acc;
}
DI void st8s(u16* dst, const uint4& v, float f) {
  uint4 o;
  o.x = pack2(bflo(v.x) * f, bfhi(v.x) * f); o.y = pack2(bflo(v.y) * f, bfhi(v.y) * f);
  o.z = pack2(bflo(v.z) * f, bfhi(v.z) * f); o.w = pack2(bflo(v.w) * f, bfhi(v.w) * f);
  *(uint4*)dst = o;
}

DI void dn_chain(const Params& p, int chain, char* lds) {
  int tid_ = VTID;
  asm volatile("" : "+v"(tid_));
  const int tid = tid_, wave = tid >> 6, lane = tid & 63, r = lane & 31, h = lane >> 5;
  const int wm = wave >> 1, wn = wave & 1;
  const int b = chain >> 3, hh = (chain >> 1) & 3, dir = chain & 1;
  u16* kA = (u16*)lds;
  u16* St = kA + 64 * LS;
  u16* R1 = St + 64 * LS;
  u16* R2 = R1 + 64 * LS;
  u16* R3 = R2 + 64 * LS;
  u16* R4 = R3 + 64 * LS;
  u16* R5 = R4 + 64 * LS;
  float* gc = (float*)(R5 + 64 * LS);
  float* bt = gc + 64;
  const u16* QKVB = (const u16*)(p.ws + O_QKVB);
  const float* G2 = (const float*)(p.ws + O_G2);
  u16* OUT = dir ? (u16*)(p.ws + O_OB) : (u16*)(p.ws + O_ACT) + 256;
  const int opitch = dir ? 256 : AP;
  __syncthreads();
  for (int e = tid; e < 64 * LS / 2; e += 256) ((u32*)St)[e] = 0u;
  f32x16 S = zero16();
  const int lc = tid >> 3, lp = (tid & 7) * 8;
  auto rowof = [&](int n, int c) -> int {
    int cn, base, len;
    if (n < 4) { cn = n; base = NLAT + b * LC; len = LC; } else { cn = n - 4; base = b * TT; len = TT; }
    int pos = cn * 64 + c;
    return base + (dir ? len - 1 - pos : pos);
  };
  uint4 pk0, pk1, pq0, pq1, pv0, pv1;
  float pg = 0.f, pb = 0.f;
#define DN_LOAD(n)                                                                      \
  {                                                                                     \
    const u16* s0_ = QKVB + (size_t)rowof((n), lc) * 768 + hh * 64 + lp;                \
    const u16* s1_ = QKVB + (size_t)rowof((n), lc + 32) * 768 + hh * 64 + lp;           \
    pq0 = *(const uint4*)s0_; pk0 = *(const uint4*)(s0_ + 256); pv0 = *(const uint4*)(s0_ + 512); \
    pq1 = *(const uint4*)s1_; pk1 = *(const uint4*)(s1_ + 256); pv1 = *(const uint4*)(s1_ + 512); \
    if (tid < 64) {                                                                     \
      const float* g_ = G2 + (size_t)rowof((n), tid) * 16 + dir * 4 + hh;               \
      pg = g_[0]; pb = g_[8];                                                           \
    }                                                                                   \
  }
  DN_LOAD(0);
  for (int n = 0; n < 68; ++n) {
    const uint4 ck0 = pk0, ck1 = pk1, cq0 = pq0, cq1 = pq1, cv0 = pv0, cv1 = pv1;
    float cgv = pg, cbv = pb;
    __syncthreads();
    if (tid < 64) {
      float v = cgv;
#pragma unroll
      for (int o = 1; o < 64; o <<= 1) { float t = __shfl_up(v, o); if (lane >= o) v += t; }
      gc[tid] = v; bt[tid] = cbv;
    }
    *(uint4*)(kA + lc * LS + lp) = ck0;
    *(uint4*)(kA + (lc + 32) * LS + lp) = ck1;
    if (n + 1 < 68) DN_LOAD(n + 1);
    __syncthreads();
    const float gl = gc[63];
    f32x16 T;
    {
      f32x16 kk = mm64<4>(kA, LS, kA, LS, wm, wn, r, h);
      const int s = wn * 32 + r;
      const float gs = gc[s];
#pragma unroll
      for (int g = 0; g < 16; ++g) {
        int c = wm * 32 + crow(g, h);
        float v = (s < c) ? bt[c] * kk[g] * __expf(gc[c] - gs) : 0.f;
        kk[g] = v;
        T[g] = (c == s) ? 1.f : (((c >> 1) == (s >> 1)) ? -v : 0.f);
      }
      st_transp(R1, LS, kk, wm, wn, r, h);
      st_transp(R2, LS, T, wm, wn, r, h);
    }
    __syncthreads();
    for (int k = 1; k < 6; ++k) {
      f32x16 M = mm64t<4>(R1, LS, R2, LS, wm, wn, r, h, lane);
      st_transp(R4, LS, M, wm, wn, r, h);
      __syncthreads();
      f32x16 X = mm64t<4>(R2, LS, R4, LS, wm, wn, r, h, lane);
      {
        const int s = wn * 32 + r;
#pragma unroll
        for (int g = 0; g < 16; ++g) {
          int c = wm * 32 + crow(g, h);
          if ((c >> (k + 1)) == (s >> (k + 1)) && (c >> k) != (s >> k)) T[g] -= X[g];
        }
      }
      __syncthreads();
      st_transp(R2, LS, T, wm, wn, r, h);
      __syncthreads();
    }
    {
      const float fb0 = bt[lc], fk0 = fb0 * __expf(gc[lc]);
      const float fb1 = bt[lc + 32], fk1 = fb1 * __expf(gc[lc + 32]);
      st8s(R1 + lc * LS + lp, ck0, fk0);
      st8s(R1 + (lc + 32) * LS + lp, ck1, fk1);
      st8s(R3 + lc * LS + lp, cv0, fb0);
      st8s(R3 + (lc + 32) * LS + lp, cv1, fb1);
    }
    __syncthreads();
    f32x16 W = mm64x<4, true, true>(R2, LS, R1, LS, wm, wn, r, h, lane);
    f32x16 U = mm64x<4, true, true>(R2, LS, R3, LS, wm, wn, r, h, lane);
    st_transp(R4, LS, W, wm, wn, r, h);
    __syncthreads();
    {
      f32x16 ws = mm64t<4>(R4, LS, St, LS, wm, wn, r, h, lane);
#pragma unroll
      for (int g = 0; g < 16; ++g) U[g] -= ws[g];
      st_transp(R1, LS, U, wm, wn, r, h);
    }
    *(uint4*)(R2 + lc * LS + lp) = cq0;
    *(uint4*)(R2 + (lc + 32) * LS + lp) = cq1;
    st8s(R5 + lc * LS + lp, ck0, __expf(gl - gc[lc]));
    st8s(R5 + (lc + 32) * LS + lp, ck1, __expf(gl - gc[lc + 32]));
    __syncthreads();
    {
      f32x16 qk = mm64<4>(R2, LS, kA, LS, wm, wn, r, h);
      const int s = wn * 32 + r;
      const float gs = gc[s];
#pragma unroll
      for (int g = 0; g < 16; ++g) {
        int c = wm * 32 + crow(g, h);
        qk[g] = (s <= c) ? qk[g] * __expf(gc[c] - gs) : 0.f;
      }
      st_transp(R3, LS, qk, wm, wn, r, h);
    }
    __syncthreads();
    {
      f32x16 o1 = mm64<4>(R2, LS, St, LS, wm, wn, r, h);
      f32x16 o2 = mm64t<4>(R3, LS, R1, LS, wm, wn, r, h, lane);
      f32x16 sn = mm64x<4, true, false>(R5, LS, R1, LS, wm, wn, r, h, lane);
      const float egl = __expf(gl);
#pragma unroll
      for (int g = 0; g < 16; ++g) {
        int c = wm * 32 + crow(g, h);
        float ov = o1[g] * __expf(gc[c]) + o2[g];
        OUT[(size_t)rowof(n, c) * opitch + hh * 64 + wn * 32 + r] = f2bf(ov);
        S[g] = S[g] * egl + sn[g];
      }
    }
    __syncthreads();
    st_transp(St, LS, S, wm, wn, r, h);
  }
}

DI void ret_chain(const Params& p, int layer, int chain, char* lds) {
  int tid_ = VTID;
  asm volatile("" : "+v"(tid_));
  const int tid = tid_, wave = tid >> 6, lane = tid & 63, r = lane & 31, h = lane >> 5;
  const int wm = wave >> 1, wn = wave & 1;
  const int b = chain >> 3, hh = (chain >> 1) & 3, dir = chain & 1;
  constexpr int L4 = 40;
  u16* qA = (u16*)lds;
  u16* kA = qA + 64 * L4;
  u16* ks = kA + 64 * L4;
  u16* vs = ks + 64 * LS;
  u16* QK = vs + 64 * LS;
  u16* Rt = QK + 64 * LS;
  const u16* QC = (const u16*)(p.ws + O_QC);
  const u16* KC = (const u16*)(p.ws + O_KC);
  const u16* Z = (const u16*)(p.ws + O_Z);
  u16* OUT = dir ? (u16*)(p.ws + O_ORB) : (u16*)(p.ws + O_ACT) + 512;
  const int opitch = dir ? 256 : AP;
  const int lc = tid >> 2, lp4 = (tid & 3) * 8;
  const int vc = tid >> 3, vp = (tid & 7) * 8;
  const float lg = log1pf(-expf(p.ret_l1m[layer * 8 + dir * 4 + hh]));
  f32x16 R = zero16();
  auto rowof = [&](int n, int c) -> int {
    int cn, base, len;
    if (n < 4) { cn = n; base = NLAT + b * LC; len = LC; } else { cn = n - 4; base = b * TT; len = TT; }
    int pos = cn * 64 + c;
    return base + (dir ? len - 1 - pos : pos);
  };
  uint4 pq, pk, pv0, pv1;
#define RET_LOAD(n)                                                                                   \
  {                                                                                                   \
    const int row_ = rowof((n), lc);                                                                  \
    pq = *(const uint4*)(QC + (size_t)row_ * 128 + hh * 32 + lp4);                                    \
    pk = *(const uint4*)(KC + (size_t)row_ * 128 + hh * 32 + lp4);                                    \
    pv0 = *(const uint4*)(Z + (size_t)rowof((n), vc) * ZW + C_CV + hh * 64 + vp);                     \
    pv1 = *(const uint4*)(Z + (size_t)rowof((n), vc + 32) * ZW + C_CV + hh * 64 + vp);                \
  }
  RET_LOAD(0);
  for (int n = 0; n < 68; ++n) {
    __syncthreads();
    *(uint4*)(qA + lc * L4 + lp4) = pq;
    *(uint4*)(kA + lc * L4 + lp4) = pk;
    st8s(ks + lc * L4 + lp4, pk, __expf((float)(63 - lc) * lg));
    *(uint4*)(vs + vc * LS + vp) = pv0;
    *(uint4*)(vs + (vc + 32) * LS + vp) = pv1;
    if (wm == 0) st_transp(Rt, L4, R, wm, wn, r, h);
    if (n + 1 < 68) RET_LOAD(n + 1);
    __syncthreads();
    {
      f32x16 qk = mm64<2>(qA, L4, kA, L4, wm, wn, r, h);
      const int s = wn * 32 + r;
#pragma unroll
      for (int g = 0; g < 16; ++g) {
        int c = wm * 32 + crow(g, h);
        qk[g] = (s <= c) ? qk[g] * __expf((float)(c - s) * lg) : 0.f;
      }
      st_transp(QK, LS, qk, wm, wn, r, h);
    }
    __syncthreads();
    {
      f32x16 o1 = mm64x<4, true, true>(QK, LS, vs, LS, wm, wn, r, h, lane);
      f32x16 o2 = mm64<2>(qA, L4, Rt, L4, wm, wn, r, h);
      const float gch = __expf(64.f * lg);
#pragma unroll
      for (int g = 0; g < 16; ++g) {
        int c = wm * 32 + crow(g, h);
        float ov = o1[g] + __expf((float)(c + 1) * lg) * o2[g];
        OUT[(size_t)rowof(n, c) * opitch + hh * 64 + wn * 32 + r] = f2bf(ov);
      }
      if (wm == 0) {
        f32x16 rn = mm64x<4, true, true>(ks, L4, vs, LS, wm, wn, r, h, lane);
#pragma unroll
        for (int g = 0; g < 16; ++g) R[g] = R[g] * gch + rn[g];
      }
    }
  }
}

DI void pair_finalize(const Params& p, int layer, int kind, int b, int hh) {
  int ltid_ = threadIdx.x;
  asm volatile("" : "+v"(ltid_));
  const int ltid = ltid_;
  const u16* Z = (const u16*)(p.ws + O_Z);
  const u16* BW = (const u16*)(p.ws + (kind ? O_ORB : O_OB));
  u16* act = (u16*)(p.ws + O_ACT);
  const int acol = kind ? 512 : 256, zcol = kind ? C_CG : C_BZ;
  const float* gp = kind ? p.ret_norm_g + layer * 256 + hh * 64 + (ltid & 7) * 8 : p.dn_norm_g + layer * 64 + (ltid & 7) * 8;
  const float4 g0 = *(const float4*)gp, g1 = *(const float4*)(gp + 4);
  const float gg[8] = {g0.x, g0.y, g0.z, g0.w, g1.x, g1.y, g1.z, g1.w};
  const int c8 = hh * 8 + (ltid & 7);
  __syncthreads();
#pragma unroll 1
  for (int j0 = 0; j0 < 68; j0 += 4) {
    u32x4 a[4], bw[4], z[4];
#pragma unroll
    for (int u = 0; u < 4; ++u) {
      const int rr = (ltid + 512 * (j0 + u)) >> 3;
      const int row = rr < TT ? b * TT + rr : NLAT + b * LC + (rr - TT);
      a[u] = ldg16(act + (size_t)row * AP + acol + c8 * 8);
      bw[u] = ldg16(BW + (size_t)row * 256 + c8 * 8);
      z[u] = ldg16(Z + (size_t)row * ZW + zcol + c8 * 8);
    }
#pragma unroll
    for (int u = 0; u < 4; ++u) {
      const int rr = (ltid + 512 * (j0 + u)) >> 3;
      const int row = rr < TT ? b * TT + rr : NLAT + b * LC + (rr - TT);
      float fa[8], fb[8], fz[8], o[8];
      unpack8(a[u], fa); unpack8(bw[u], fb); unpack8(z[u], fz);
      float sm = 0.f;
#pragma unroll
      for (int e = 0; e < 8; ++e) { o[e] = fa[e] + fb[e]; sm += o[e]; }
      sm += __shfl_xor(sm, 1); sm += __shfl_xor(sm, 2); sm += __shfl_xor(sm, 4);
      const float mean = kind ? sm * (1.f / 64.f) : 0.f;
      float ss = 0.f;
#pragma unroll
      for (int e = 0; e < 8; ++e) { o[e] -= mean; ss += o[e] * o[e]; }
      ss += __shfl_xor(ss, 1); ss += __shfl_xor(ss, 2); ss += __shfl_xor(ss, 4);
      const float rn = rsqrtf(ss * (1.f / 64.f) + 1e-6f);
#pragma unroll
      for (int e = 0; e < 8; ++e) o[e] = o[e] * rn * gg[e] * siluf(fz[e]);
      *(u32x4*)(act + (size_t)row * AP + acol + c8 * 8) = pack8(o);
    }
  }
}

DI void mixer_phase(const Params& p, int layer, char* lds, char* lds_all, int* s_tile) {
  int* cnt = (int*)(p.ws + O_CNT) + layer;
  const int nattn = layer == 0 ? 2176 : 2048;
  const int nwork = 128 + 128 + 2 * nattn;
  const int total = nwork + (layer == 0 ? 5352 : 0);
  for (;;) {
    __syncthreads();
    if (threadIdx.x == 0) *s_tile = atomicAdd(cnt, 1);
    __syncthreads();
    const int t = 2 * (*s_tile) + VHALF;
    if (t >= total) break;
    if (t < 128) { dn_chain(p, t, lds); pair_finalize(p, layer, 0, t >> 3, (t >> 1) & 3); }
    else if (t < 256) { ret_chain(p, layer, t - 128, lds); pair_finalize(p, layer, 1, (t - 128) >> 3, ((t - 128) >> 1) & 3); }
    else if (t < 256 + nattn) mla_attn(p, t - 256, lds_all);
    else if (t < nwork) swa_attn(p, layer, t - 256 - nattn, lds_all);
    else wtile_deferred(p, t - nwork, lds);
  }
}

DI void dn_finalize(const Params& p, int layer, int nrows) {
  int tid_ = VTID;
  asm volatile("" : "+v"(tid_));
  const int tid = tid_;
  const u16* OB = (const u16*)(p.ws + O_OB);
  const u16* Z = (const u16*)(p.ws + O_Z);
  u16* act = (u16*)(p.ws + O_ACT);
  const int ntask = nrows * 32, stride = VG * 256;
  for (int id0 = VB * 256 + tid; id0 < ntask; id0 += 4 * stride) {
    u32x4 a[4], b[4], z[4];
#pragma unroll
    for (int u = 0; u < 4; ++u) {
      const int id = id0 + u * stride;
      const bool ok = id < ntask;
      const int row = ok ? (id >> 5) : 0, c8 = id & 31;
      a[u] = ldg16(act + (size_t)row * AP + 256 + c8 * 8);
      b[u] = ldg16(OB + (size_t)row * 256 + c8 * 8);
      z[u] = ldg16(Z + (size_t)row * ZW + C_BZ + c8 * 8);
    }
#pragma unroll
    for (int u = 0; u < 4; ++u) {
      const int id = id0 + u * stride;
      const int row = id >> 5, c8 = id & 31;
      float fa[8], fb[8], fz[8], o[8];
      unpack8(a[u], fa); unpack8(b[u], fb); unpack8(z[u], fz);
      float ss = 0.f;
#pragma unroll
      for (int e = 0; e < 8; ++e) { o[e] = fa[e] + fb[e]; ss += o[e] * o[e]; }
      ss += __shfl_xor(ss, 1); ss += __shfl_xor(ss, 2); ss += __shfl_xor(ss, 4);
      const float rn = rsqrtf(ss * (1.f / 64.f) + 1e-6f);
      const float4 g0 = *(const float4*)(p.dn_norm_g + layer * 64 + (c8 & 7) * 8), g1 = *(const float4*)(p.dn_norm_g + layer * 64 + (c8 & 7) * 8 + 4);
      const float gg[8] = {g0.x, g0.y, g0.z, g0.w, g1.x, g1.y, g1.z, g1.w};
#pragma unroll
      for (int e = 0; e < 8; ++e) o[e] = o[e] * rn * gg[e] * siluf(fz[e]);
      if (id < ntask) *(u32x4*)(act + (size_t)row * AP + 256 + c8 * 8) = pack8(o);
    }
  }
  const u16* ORB = (const u16*)(p.ws + O_ORB);
  for (int id0 = VB * 256 + tid; id0 < ntask; id0 += 4 * stride) {
    u32x4 a[4], b[4], z[4];
#pragma unroll
    for (int u = 0; u < 4; ++u) {
      const int id = id0 + u * stride;
      const bool ok = id < ntask;
      const int row = ok ? (id >> 5) : 0, c8 = id & 31;
      a[u] = ldg16(act + (size_t)row * AP + 512 + c8 * 8);
      b[u] = ldg16(ORB + (size_t)row * 256 + c8 * 8);
      z[u] = ldg16(Z + (size_t)row * ZW + C_CG + c8 * 8);
    }
#pragma unroll
    for (int u = 0; u < 4; ++u) {
      const int id = id0 + u * stride;
      const int row = id >> 5, c8 = id & 31;
      float fa[8], fb[8], fz[8], o[8];
      unpack8(a[u], fa); unpack8(b[u], fb); unpack8(z[u], fz);
      float sm = 0.f;
#pragma unroll
      for (int e = 0; e < 8; ++e) { o[e] = fa[e] + fb[e]; sm += o[e]; }
      sm += __shfl_xor(sm, 1); sm += __shfl_xor(sm, 2); sm += __shfl_xor(sm, 4);
      const float mean = sm * (1.f / 64.f);
      float ss = 0.f;
#pragma unroll
      for (int e = 0; e < 8; ++e) { o[e] -= mean; ss += o[e] * o[e]; }
      ss += __shfl_xor(ss, 1); ss += __shfl_xor(ss, 2); ss += __shfl_xor(ss, 4);
      const float rn = rsqrtf(ss * (1.f / 64.f) + 1e-6f);
      const float4 g0 = *(const float4*)(p.ret_norm_g + layer * 256 + c8 * 8), g1 = *(const float4*)(p.ret_norm_g + layer * 256 + c8 * 8 + 4);
      const float gg[8] = {g0.x, g0.y, g0.z, g0.w, g1.x, g1.y, g1.z, g1.w};
#pragma unroll
      for (int e = 0; e < 8; ++e) o[e] = o[e] * rn * gg[e] * siluf(fz[e]);
      if (id < ntask) *(u32x4*)(act + (size_t)row * AP + 512 + c8 * 8) = pack8(o);
    }
  }
}

DI void gbar(const Params& p, unsigned& target) {
  unsigned* bar = (unsigned*)(p.ws + O_CNT + 128);
  target += gridDim.x;
  __syncthreads();
  if (threadIdx.x == 0) {
    __builtin_amdgcn_fence(__ATOMIC_RELEASE, "agent");
    __hip_atomic_fetch_add(bar, 1u, __ATOMIC_RELAXED, __HIP_MEMORY_SCOPE_AGENT);
    while (__hip_atomic_load(bar, __ATOMIC_RELAXED, __HIP_MEMORY_SCOPE_AGENT) < target) __builtin_amdgcn_s_sleep(2);
    __builtin_amdgcn_fence(__ATOMIC_ACQUIRE, "agent");
  }
  __syncthreads();
}

__global__ void __launch_bounds__(512, 2) fwd_megakernel(Params p) {
  __shared__ __attribute__((aligned(16))) char lds_all[2 * LDS_BYTES];
  __shared__ int s_tile;
  char* lds = lds_all + VHALF * LDS_BYTES;
  cg::grid_group grid = cg::this_grid();
  if (p.ws == nullptr) grid.sync();
  unsigned bt = 0;
  phase0a(p, lds);
  gbar(p, bt);
  modulate_rows(p, 0, ROWS);
  gbar(p, bt);
  for (int layer = 0; layer < 2; ++layer) {
    const int nrows = layer == 0 ? ROWS : NLAT;
    gemm_phase(p, layer, 0, ROWS, lds_all);
    gbar(p, bt);
    prep_phase(p, layer, lds);
    gbar(p, bt);
    mixer_phase(p, layer, lds, lds_all, &s_tile);
    gbar(p, bt);
    gemm_phase(p, layer, 1, nrows, lds_all);
    gbar(p, bt);
    ln_rows(p, p.ln1_g + layer * DM, p.ln1_b + layer * DM, nrows, layer, 3, true);
    gbar(p, bt);
    gemm_phase(p, layer, 2, nrows, lds_all);
    gbar(p, bt);
    gemm_phase(p, layer, 3, nrows, lds_all);
    gbar(p, bt);
    ln_rows(p, p.ln2_g + layer * DM, p.ln2_b + layer * DM, nrows, layer == 0 ? 1 : 0, 0, layer == 0);
    if (layer == 0) gbar(p, bt);
  }
}

extern "C" void kernel_launch(void* const* d_in, const int* in_sizes, int n_in, void* d_out, int out_size, void* d_ws,
                              size_t ws_size, hipStream_t stream) {
  static int grid_blocks = 0;
  if (!grid_blocks) {
    int dev = 0, cus = 0, per_cu = 0;
    hipGetDevice(&dev);
    hipDeviceGetAttribute(&cus, hipDeviceAttributeMultiprocessorCount, dev);
    hipOccupancyMaxActiveBlocksPerMultiprocessor(&per_cu, fwd_megakernel, 512, 0);
    if (per_cu < 1) per_cu = 1;
    if (per_cu > 1) per_cu = 1;
    grid_blocks = cus * per_cu;
    if (ws_size < WS_END) fprintf(stderr, "kernel_launch: workspace too small: %zu < %zu\n", ws_size, (size_t)WS_END);
  }
  Params p{};
  const float** f = (const float**)&p;
  for (int i = 0; i < 25; ++i) f[i] = (const float*)d_in[i];
  p.out = (float*)d_out;
  p.ws = (unsigned char*)d_ws;
  hipMemsetAsync((char*)d_ws + O_CNT, 0, 256, stream);
  void* args[] = {&p};
  hipError_t e = hipLaunchCooperativeKernel((void*)fwd_megakernel, dim3(grid_blocks), dim3(512), args, 0, stream);
  if (e != hipSuccess) fprintf(stderr, "cooperative launch failed: %s (grid %d)\n", hipGetErrorString(e), grid_blocks);
}
```
